# Optimizing an MI355X kernel written in HIP

```python
import jax, jax.numpy as jnp
from jax import lax
import numpy as np

D_MODEL = 1024
BATCH = 2
SEQ = 8192
DEPTH = 4

GRID_W = 64
CTX_LEN = 256
HEAD_DIM = 64
BLOCK = 128
MLP_GROUPS = 4
MLP_WIDTH = MLP_GROUPS * HEAD_DIM
WIN_HEADS = 4
WIN_KV = 2
WINDOW = 128
GLB_HEADS = 4
GLB_KV = 2
RET_HEADS = 4
RET_VDIM = HEAD_DIM
N_BRANCH = 4
BRANCH_W = 256
ROPE_BASE = 10000.0
D_FF = 2816
N_EXPERTS = 8
TOP_K = 2
D_FF_EXPERT = 1792
N_DENSE = (DEPTH + 1) // 2
N_MOE = DEPTH // 2
EPS = 1e-6
NEG_INF = -1e30
IN_SPLITS = (2 * MLP_WIDTH,
             WIN_HEADS * HEAD_DIM, WIN_KV * HEAD_DIM, WIN_KV * HEAD_DIM,
             GLB_HEADS * HEAD_DIM, GLB_KV * HEAD_DIM, GLB_KV * HEAD_DIM,
             RET_HEADS * HEAD_DIM, RET_HEADS * HEAD_DIM, RET_HEADS * RET_VDIM, RET_HEADS * RET_VDIM,
             N_BRANCH * D_MODEL)
IN_WIDTH = sum(IN_SPLITS)

kernel_name = 'hybrid_parallel_mixer_dit'


def rms_norm(x, g):
    xf = x.astype(jnp.float32)
    y = xf * lax.rsqrt(jnp.mean(xf * xf, axis=-1, keepdims=True) + EPS)
    return (y * g.astype(jnp.float32)).astype(x.dtype)


def group_norm(x, g):
    xf = x.astype(jnp.float32)
    xc = xf - jnp.mean(xf, axis=-1, keepdims=True)
    var = jnp.mean(xc * xc, axis=-1, keepdims=True)
    return xc * lax.rsqrt(var + EPS) * g.astype(jnp.float32)


def heads(t, n, dh=HEAD_DIM):
    return t.reshape(t.shape[0], t.shape[1], n, dh)


def split_cols(p):
    parts = []
    off = 0
    for n in IN_SPLITS:
        parts.append(p[..., off:off + n])
        off += n
    return parts


def rope(x, tables):
    cos, sin = tables
    half = x.shape[-1] // 2
    x1 = x[..., :half].astype(jnp.float32)
    x2 = x[..., half:].astype(jnp.float32)
    c = cos[:, None, :]
    s = sin[:, None, :]
    return jnp.concatenate([x1 * c - x2 * s, x1 * s + x2 * c], axis=-1).astype(x.dtype)


def axial_rope_tables(n_rows):
    row = jnp.repeat(jnp.arange(n_rows, dtype=jnp.float32), GRID_W)
    col = jnp.tile(jnp.arange(GRID_W, dtype=jnp.float32), n_rows)
    n_freq = HEAD_DIM // 4
    inv = ROPE_BASE ** (-jnp.arange(n_freq, dtype=jnp.float32) / n_freq)
    ang = jnp.concatenate([row[:, None] * inv, col[:, None] * inv], axis=-1)
    return jnp.cos(ang), jnp.sin(ang)


def seq_rope_tables(pos):
    n_freq = HEAD_DIM // 2
    inv = ROPE_BASE ** (-jnp.arange(n_freq, dtype=jnp.float32) / n_freq)
    ang = pos[:, None] * inv
    return jnp.cos(ang), jnp.sin(ang)


def chunk_mlp(uv, w_s, b_s, g_v):
    Bn, N, _ = uv.shape
    u, v = jnp.split(uv, 2, axis=-1)
    v = rms_norm(heads(v, MLP_GROUPS), g_v)
    v = v.reshape(Bn, N // BLOCK, BLOCK, MLP_GROUPS, HEAD_DIM)
    mixed = jnp.einsum('gij,bcjgd->bcigd', w_s, v) + b_s.T[None, None, :, :, None]
    return u * mixed.reshape(Bn, N, MLP_WIDTH)


def dense_attn(q, k, v, sink):
    Bn, N, Hq, d = q.shape
    Hkv = k.shape[2]
    G = Hq // Hkv
    qg = q.reshape(Bn, N, Hkv, G, d)
    s = jnp.einsum('bqhgd,bkhd->bhgqk', qg, k).astype(jnp.float32) * (d ** -0.5)
    if sink is not None:
        sk = jnp.broadcast_to(sink.astype(jnp.float32).reshape(1, Hkv, G, 1, 1), s.shape[:-1] + (1,))
        p = jax.nn.softmax(jnp.concatenate([s, sk], axis=-1), axis=-1)[..., :-1]
    else:
        p = jax.nn.softmax(s, axis=-1)
    o = jnp.einsum('bhgqk,bkhd->bqhgd', p.astype(v.dtype), v)
    return o.reshape(Bn, N, Hq * d)


def window_attn_latent(q, k, v, k_c, v_c, sink):
    Bn, S, Hq, d = q.shape
    Hkv = k.shape[2]
    G = Hq // Hkv
    nb = S // BLOCK
    L = k_c.shape[1]
    scale = d ** -0.5
    qb = q.reshape(Bn, nb, BLOCK, Hkv, G, d)
    pad = jnp.zeros((Bn, BLOCK, Hkv, d), k.dtype)
    kp = jnp.concatenate([pad, k, pad], axis=1).reshape(Bn, nb + 2, BLOCK, Hkv, d)
    vp = jnp.concatenate([pad, v, pad], axis=1).reshape(Bn, nb + 2, BLOCK, Hkv, d)
    kw = jnp.concatenate([kp[:, :-2], kp[:, 1:-1], kp[:, 2:]], axis=2)
    vw = jnp.concatenate([vp[:, :-2], vp[:, 1:-1], vp[:, 2:]], axis=2)
    qpos = jnp.arange(nb)[:, None] * BLOCK + jnp.arange(BLOCK)[None, :]
    kpos = jnp.arange(nb)[:, None] * BLOCK - BLOCK + jnp.arange(3 * BLOCK)[None, :]
    valid = (jnp.abs(qpos[:, :, None] - kpos[:, None, :]) <= WINDOW) & (kpos[:, None, :] >= 0) & (kpos[:, None, :] < S)
    s_loc = jnp.einsum('bnqhgd,bnkhd->bnhgqk', qb, kw).astype(jnp.float32) * scale
    s_loc = jnp.where(valid[None, :, None, None], s_loc, NEG_INF)
    s_ctx = jnp.einsum('bnqhgd,bkhd->bnhgqk', qb, k_c).astype(jnp.float32) * scale
    s_sink = jnp.broadcast_to(sink.astype(jnp.float32).reshape(1, 1, Hkv, G, 1, 1), s_ctx.shape[:-1] + (1,))
    p = jax.nn.softmax(jnp.concatenate([s_ctx, s_loc, s_sink], axis=-1), axis=-1).astype(v.dtype)
    o = (jnp.einsum('bnhgqk,bkhd->bnqhgd', p[..., :L], v_c)
         + jnp.einsum('bnhgqk,bnkhd->bnqhgd', p[..., L:L + 3 * BLOCK], vw))
    return o.reshape(Bn, S, Hq * d)


def global_attn_latent(q, k_all, v_all):
    Bn, S, Hq, d = q.shape
    Hkv = k_all.shape[2]
    G = Hq // Hkv
    nb = S // BLOCK
    scale = d ** -0.5
    qb = q.reshape(Bn, nb, BLOCK, Hkv, G, d).transpose(1, 0, 2, 3, 4, 5)

    def one_block(qblk):
        s = jnp.einsum('bqhgd,bkhd->bhgqk', qblk, k_all).astype(jnp.float32) * scale
        p = jax.nn.softmax(s, axis=-1).astype(v_all.dtype)
        return jnp.einsum('bhgqk,bkhd->bqhgd', p, v_all)

    o = lax.map(one_block, qb)
    return o.transpose(1, 0, 2, 3, 4, 5).reshape(Bn, S, Hq * d)


def retention_scan(q, k, v, log_gamma, s0, shift):
    Bn, N, H, dk = q.shape
    dv = v.shape[-1]
    nc = N // BLOCK
    idx = jnp.arange(BLOCK, dtype=jnp.float32)
    rel = idx[:, None] - idx[None, :] - shift
    mask = rel >= 0
    decay_in = jnp.where(mask[None], jnp.exp(log_gamma[:, None, None] * jnp.where(mask, rel, 0.0)[None]), 0.0)
    q_dec = jnp.exp(log_gamma[:, None] * (idx + 1.0 - shift)[None, :])
    k_dec = jnp.exp(log_gamma[:, None] * (BLOCK - 1.0 - idx)[None, :])
    chunk_dec = jnp.exp(log_gamma * BLOCK)[None, :, None, None]

    def to_chunks(t):
        return t.astype(jnp.float32).reshape(Bn, nc, BLOCK, H, t.shape[-1]).transpose(1, 0, 3, 2, 4)

    def step(state, inp):
        qc, kc, vc = inp
        qk = jnp.einsum('bhqd,bhkd->bhqk', qc, kc) * decay_in
        o = jnp.einsum('bhqk,bhkv->bhqv', qk, vc) + jnp.einsum('bhqd,bhdv->bhqv', qc * q_dec[..., None], state)
        state = chunk_dec * state + jnp.einsum('bhkd,bhkv->bhdv', kc * k_dec[..., None], vc)
        return state, o

    state, o = lax.scan(step, s0, (to_chunks(q), to_chunks(k), to_chunks(v)))
    return o.transpose(1, 0, 3, 2, 4).reshape(Bn, N, H, dv), state


def retention_out(o, g, gate_cols):
    y = group_norm(o, g)
    y = y.reshape(o.shape[0], o.shape[1], -1) * jax.nn.silu(gate_cols.astype(jnp.float32))
    return y.astype(gate_cols.dtype)


def merge(branches, gate_cols, w_branch, w_out):
    gates = jax.nn.sigmoid(gate_cols.reshape(gate_cols.shape[:-1] + (N_BRANCH, D_MODEL)))
    acc = gates[..., 0, :] * (branches[0] @ w_branch[0])
    for i in range(1, N_BRANCH):
        acc = acc + gates[..., i, :] * (branches[i] @ w_branch[i])
    return acc @ w_out


def token_mixers(h_ctx, h_lat, w_in, mlp_g_v, mlp_w_s, mlp_b_s, win_q_norm, win_k_norm, win_sink,
                 glb_q_norm, glb_k_norm, ret_decay, ret_gn, w_branch, w_out, axial, rot_ctx, rot_lat, need_ctx):
    pl = split_cols(h_lat @ w_in)
    pc = split_cols(h_ctx @ w_in)
    a_lat = chunk_mlp(jax.nn.gelu(pl[0]), mlp_w_s, mlp_b_s, mlp_g_v)
    wk_c = rms_norm(heads(pc[2], WIN_KV), win_k_norm)
    wv_c = heads(pc[3], WIN_KV)
    wq_l = rope(rms_norm(heads(pl[1], WIN_HEADS), win_q_norm), axial)
    wk_l = rope(rms_norm(heads(pl[2], WIN_KV), win_k_norm), axial)
    b_lat = window_attn_latent(wq_l, wk_l, heads(pl[3], WIN_KV), wk_c, wv_c, win_sink)
    gk_c = rms_norm(heads(pc[5], GLB_KV), glb_k_norm)
    gv_c = heads(pc[6], GLB_KV)
    gq_l = rope(rms_norm(heads(pl[4], GLB_HEADS), glb_q_norm), axial)
    gk_l = rope(rms_norm(heads(pl[5], GLB_KV), glb_k_norm), axial)
    c_lat = global_attn_latent(gq_l, jnp.concatenate([gk_c, gk_l], axis=1),
                               jnp.concatenate([gv_c, heads(pl[6], GLB_KV)], axis=1))
    k_scale = HEAD_DIM ** -0.5
    rq_c = rope(heads(pc[7], RET_HEADS), rot_ctx)
    rk_c = rope(heads(pc[8], RET_HEADS), rot_ctx) * k_scale
    rv_c = heads(pc[9], RET_HEADS, RET_VDIM)
    rq_l = rope(heads(pl[7], RET_HEADS), rot_lat)
    rk_l = rope(heads(pl[8], RET_HEADS), rot_lat) * k_scale
    rv_l = heads(pl[9], RET_HEADS, RET_VDIM)
    log_g = jax.nn.log_sigmoid(ret_decay.astype(jnp.float32))
    s0 = jnp.zeros((h_lat.shape[0], RET_HEADS, HEAD_DIM, RET_VDIM), jnp.float32)
    flip = lambda t: jnp.flip(t, axis=1)
    oc_f, st_f = retention_scan(rq_c, rk_c, rv_c, log_g[0], s0, 0)
    oc_b, st_b = retention_scan(flip(rq_c), flip(rk_c), flip(rv_c), log_g[1], s0, 1)
    ol_f, _ = retention_scan(rq_l, rk_l, rv_l, log_g[0], st_f, 0)
    ol_b, _ = retention_scan(flip(rq_l), flip(rk_l), flip(rv_l), log_g[1], st_b, 1)
    d_lat = retention_out(ol_f + flip(ol_b), ret_gn, pl[10])
    m_lat = merge((a_lat, b_lat, c_lat, d_lat), pl[11], w_branch, w_out)
    if not need_ctx:
        return None, m_lat
    a_ctx = chunk_mlp(jax.nn.gelu(pc[0]), mlp_w_s, mlp_b_s, mlp_g_v)
    b_ctx = dense_attn(rms_norm(heads(pc[1], WIN_HEADS), win_q_norm), wk_c, wv_c, win_sink)
    c_ctx_out = dense_attn(rms_norm(heads(pc[4], GLB_HEADS), glb_q_norm), gk_c, gv_c, None)
    d_ctx = retention_out(oc_f + flip(oc_b), ret_gn, pc[10])
    m_ctx = merge((a_ctx, b_ctx, c_ctx_out, d_ctx), pc[11], w_branch, w_out)
    return m_ctx, m_lat


def swiglu(h, w1, w3, w2):
    return (jax.nn.silu(h @ w1) * (h @ w3)) @ w2


def moe_swiglu(h, router_w, router_b, w1, w3, w2):
    logits = (h @ router_w + router_b).astype(jnp.float32)
    top_v, top_i = lax.top_k(logits, TOP_K)
    p = jax.nn.softmax(top_v, axis=-1)
    combine = jnp.sum(jax.nn.one_hot(top_i, N_EXPERTS, dtype=jnp.float32) * p[..., None], axis=-2)
    out = combine[..., 0:1].astype(h.dtype) * swiglu(h, w1[0], w3[0], w2[0])
    for e in range(1, N_EXPERTS):
        out = out + combine[..., e:e + 1].astype(h.dtype) * swiglu(h, w1[e], w3[e], w2[e])
    return out


def channel_mixer(h, layer, ffn_w1, ffn_w3, ffn_w2, router_w, router_b, moe_w1, moe_w3, moe_w2):
    j = layer // 2
    if layer % 2 == 0:
        return swiglu(h, ffn_w1[j], ffn_w3[j], ffn_w2[j])
    return moe_swiglu(h, router_w[j], router_b[j], moe_w1[j], moe_w3[j], moe_w2[j])


def setup_inputs(seed: int = 0) -> dict:
    key = jax.random.key(seed)
    ks = jax.random.split(key, 32)
    D = D_MODEL

    def nrm(k, shape, s):
        return jax.random.normal(k, shape, jnp.float32) * s

    gam = 1.0 - 2.0 ** (-5.0 - jnp.arange(RET_HEADS, dtype=jnp.float32))
    decay_logit = jnp.log(gam) - jnp.log1p(-gam)
    return {
        'x': nrm(ks[0], (BATCH, SEQ, D), 1.0),
        'c': nrm(ks[1], (BATCH, D), 1.0),
        'ctx': nrm(ks[2], (BATCH, CTX_LEN, D), 1.0),
        'c_ctx': nrm(ks[3], (D,), 1.0),
        'w_mod': nrm(ks[4], (DEPTH, D, 6 * D), 0.5 * D ** -0.5),
        'b_mod': nrm(ks[5], (DEPTH, 6 * D), 0.02),
        'g_norm1': 1.0 + nrm(ks[6], (DEPTH, D), 0.02),
        'g_norm2': 1.0 + nrm(ks[7], (DEPTH, D), 0.02),
        'w_in': nrm(ks[8], (DEPTH, D, IN_WIDTH), D ** -0.5),
        'mlp_g_v': 1.0 + nrm(ks[9], (DEPTH, MLP_GROUPS, HEAD_DIM), 0.02),
        'mlp_w_s': nrm(ks[10], (DEPTH, MLP_GROUPS, BLOCK, BLOCK), BLOCK ** -0.5),
        'mlp_b_s': 1.0 + nrm(ks[11], (DEPTH, MLP_GROUPS, BLOCK), 0.1),
        'win_q_norm': 1.0 + nrm(ks[12], (DEPTH, HEAD_DIM), 0.02),
        'win_k_norm': 1.0 + nrm(ks[13], (DEPTH, HEAD_DIM), 0.02),
        'win_sink': nrm(ks[14], (DEPTH, WIN_HEADS), 0.5),
        'glb_q_norm': 1.0 + nrm(ks[15], (DEPTH, HEAD_DIM), 0.02),
        'glb_k_norm': 1.0 + nrm(ks[16], (DEPTH, HEAD_DIM), 0.02),
        'ret_decay': decay_logit[None, None, :] + nrm(ks[17], (DEPTH, 2, RET_HEADS), 0.1),
        'ret_gn': 1.0 + nrm(ks[18], (DEPTH, RET_HEADS, RET_VDIM), 0.02),
        'w_branch': nrm(ks[19], (DEPTH, N_BRANCH, BRANCH_W, D), BRANCH_W ** -0.5),
        'w_out': nrm(ks[20], (DEPTH, D, D), D ** -0.5),
        'ffn_w1': nrm(ks[21], (N_DENSE, D, D_FF), D ** -0.5),
        'ffn_w3': nrm(ks[22], (N_DENSE, D, D_FF), D ** -0.5),
        'ffn_w2': nrm(ks[23], (N_DENSE, D_FF, D), D_FF ** -0.5),
        'router_w': nrm(ks[24], (N_MOE, D, N_EXPERTS), D ** -0.5),
        'router_b': nrm(ks[25], (N_MOE, N_EXPERTS), 0.01),
        'moe_w1': nrm(ks[26], (N_MOE, N_EXPERTS, D, D_FF_EXPERT), D ** -0.5),
        'moe_w3': nrm(ks[27], (N_MOE, N_EXPERTS, D, D_FF_EXPERT), D ** -0.5),
        'moe_w2': nrm(ks[28], (N_MOE, N_EXPERTS, D_FF_EXPERT, D), D_FF_EXPERT ** -0.5),
    }


def reference(x, c, ctx, c_ctx, w_mod, b_mod, g_norm1, g_norm2, w_in, mlp_g_v, mlp_w_s, mlp_b_s,
              win_q_norm, win_k_norm, win_sink, glb_q_norm, glb_k_norm, ret_decay, ret_gn, w_branch, w_out,
              ffn_w1, ffn_w3, ffn_w2, router_w, router_b, moe_w1, moe_w3, moe_w2):
    S = x.shape[1]
    L = ctx.shape[1]
    n_rows = S // GRID_W
    axial = axial_rope_tables(n_rows)
    rot_ctx = seq_rope_tables(jnp.arange(L, dtype=jnp.float32))
    rot_lat = seq_rope_tables(L + jnp.arange(S, dtype=jnp.float32))
    silu_c = jax.nn.silu(c)
    silu_cc = jax.nn.silu(c_ctx)[None, :]
    for layer in range(DEPTH):
        need_ctx = layer < DEPTH - 1
        mod_l = (silu_c @ w_mod[layer] + b_mod[layer])[:, None, :]
        mod_c = (silu_cc @ w_mod[layer] + b_mod[layer])[:, None, :]
        sh1_l, sc1_l, g1_l, sh2_l, sc2_l, g2_l = jnp.split(mod_l, 6, axis=-1)
        sh1_c, sc1_c, g1_c, sh2_c, sc2_c, g2_c = jnp.split(mod_c, 6, axis=-1)
        h_l = rms_norm(x, g_norm1[layer]) * (1.0 + sc1_l) + sh1_l
        h_c = rms_norm(ctx, g_norm1[layer]) * (1.0 + sc1_c) + sh1_c
        m_c, m_l = token_mixers(h_c, h_l, w_in[layer], mlp_g_v[layer], mlp_w_s[layer], mlp_b_s[layer],
                                win_q_norm[layer], win_k_norm[layer], win_sink[layer],
                                glb_q_norm[layer], glb_k_norm[layer], ret_decay[layer], ret_gn[layer],
                                w_branch[layer], w_out[layer], axial, rot_ctx, rot_lat, need_ctx)
        x = x + g1_l * m_l
        h_l = rms_norm(x, g_norm2[layer]) * (1.0 + sc2_l) + sh2_l
        x = x + g2_l * channel_mixer(h_l, layer, ffn_w1, ffn_w3, ffn_w2, router_w, router_b, moe_w1, moe_w3, moe_w2)
        if need_ctx:
            ctx = ctx + g1_c * m_c
            h_c = rms_norm(ctx, g_norm2[layer]) * (1.0 + sc2_c) + sh2_c
            ctx = ctx + g2_c * channel_mixer(h_c, layer, ffn_w1, ffn_w3, ffn_w2, router_w, router_b, moe_w1, moe_w3, moe_w2)
    return x
```

```cpp
#include <hip/hip_runtime.h>
#include <cstdio>
#include <cstdint>

#ifndef MK_FUSED
#define MK_FUSED 0
#endif

#define DI __device__ __forceinline__
#define LAS __attribute__((address_space(3)))
#define GAS __attribute__((address_space(1)))
typedef unsigned short bf16_t;
typedef short bf16x8 __attribute__((ext_vector_type(8)));
typedef short s16x4 __attribute__((ext_vector_type(4)));
typedef float f32x4 __attribute__((ext_vector_type(4)));
typedef float f32x2 __attribute__((ext_vector_type(2)));
typedef float f32x16 __attribute__((ext_vector_type(16)));
typedef unsigned u32x4 __attribute__((ext_vector_type(4)));
typedef unsigned u32x2 __attribute__((ext_vector_type(2)));

constexpr int DM = 1024, NBATCH = 2, SEQ = 8192, CTXL = 256, TPB = SEQ + CTXL, T = NBATCH * TPB, DEPTH = 4;
constexpr int INW = 6656, DFF = 2816, NEXP = 8, DFE = 1792;
constexpr int C_U = 0, C_V = 256, C_WQ = 512, C_WK = 768, C_WV = 896, C_GQ = 1024, C_GK = 1280, C_GV = 1408, C_RQ = 1536, C_RK = 1792, C_RV = 2048, C_RG = 2304, C_GATE = 2560;
constexpr int NCHUNK = TPB / 128;
constexpr int NTILE_M = T / 256;
constexpr int MOE_ROWS = 2 * T + NEXP * 256;
constexpr float EPS = 1e-6f;
constexpr float LOG2E = 1.4426950408889634f;
constexpr float QSCALE = 0.125f * LOG2E;

constexpr size_t MiB = 1u << 20;
constexpr size_t WS_CTL = 0, CTL_ZERO_BYTES = 1 * MiB;
constexpr size_t WS_MOD = 1 * MiB;
constexpr size_t WS_TAB = 2 * MiB;
constexpr size_t TAB_AXC = 0, TAB_AXS = 8192 * 32 * 4, TAB_SQC = 2 * 8192 * 32 * 4, TAB_SQS = TAB_SQC + 8448 * 32 * 4;
constexpr size_t WS_WSB = 7 * MiB;
constexpr size_t WS_CTXB = 8 * MiB;
constexpr size_t WS_ROUTE = 10 * MiB;
constexpr size_t WS_VT = 12 * MiB;
constexpr size_t WS_KVT = 21 * MiB;
constexpr size_t WS_SIN = 38 * MiB;
constexpr size_t WS_H = 47 * MiB;
constexpr size_t WS_BR = 80 * MiB;
constexpr size_t WS_P = 113 * MiB;
constexpr size_t WS_HG = WS_P, WS_HIDM = WS_P + 70 * MiB;
constexpr size_t WS_W = 328 * MiB;
constexpr size_t W_IN = 0, W_BR = 13 * MiB, W_OUT = 15 * MiB, W_13 = 17 * MiB, W_2 = 73 * MiB;
constexpr size_t WS_END = WS_W + 101 * MiB;
static_assert((size_t)T * INW * 2 <= 215 * MiB && WS_P + 215 * MiB <= WS_W, "P fits");
static_assert((size_t)MOE_ROWS * 1024 * 2 <= 70 * MiB && (size_t)MOE_ROWS * DFE * 2 + 70 * MiB <= 215 * MiB, "moe overlay fits");
constexpr int RT_E = 0;
constexpr int RT_POS = 2 * T;
constexpr int RT_PW = 4 * T;
constexpr int RT_ROWTOK = 6 * T;
constexpr int RT_ROWP = RT_ROWTOK + MOE_ROWS;
constexpr int RT_META = RT_ROWP + MOE_ROWS;
static_assert((size_t)(RT_META + 256) * 4 <= 2 * MiB, "route fits");
constexpr int CW_BAR = 4096;
constexpr int CW_CNT = 16384;

DI float bf2f(unsigned short h) { return __uint_as_float((unsigned)h << 16); }
DI unsigned f2bf(float f) { unsigned u = __float_as_uint(f); return (u + 0x7fffu + ((u >> 16) & 1u)) >> 16; }
DI unsigned pk2(float lo, float hi) { return f2bf(lo) | (f2bf(hi) << 16); }
DI float ex2(float x) { return __builtin_amdgcn_exp2f(x); }
DI float rcpf_(float x) { return __builtin_amdgcn_rcpf(x); }
DI float sigm(float x) { return rcpf_(1.f + ex2(-x * LOG2E)); }
DI float siluf_(float x) { return x * sigm(x); }
DI float gelu_tanh(float x) { const float u = 0.7978845608f * (x + 0.044715f * x * x * x); return x * sigm(2.f * u); }
DI float wave_sum(float v) {
#pragma unroll
    for (int o = 1; o < 64; o <<= 1) v += __shfl_xor(v, o);
    return v;
}
DI int crow(int r, int hi) { return (r & 3) + 8 * (r >> 2) + 4 * hi; }
#define MFMA16(a, b, c) __builtin_amdgcn_mfma_f32_16x16x32_bf16((a), (b), (c), 0, 0, 0)
#define MFMA32(a, b, c) __builtin_amdgcn_mfma_f32_32x32x16_bf16((a), (b), (c), 0, 0, 0)

struct Params {
    const float* in[29];
    float* out; unsigned char* ws;
    int l_lo, l_hi, ph_lo, ph_hi, fused, pad;
};
DI const float* xrow_c(const float* lat, const float* ctx, int r) { const int b = r / TPB, p = r - b * TPB; return p < CTXL ? ctx + (size_t)(b * CTXL + p) * DM : lat + (size_t)(b * SEQ + p - CTXL) * DM; }
DI float* xrow(float* lat, float* ctx, int r) { const int b = r / TPB, p = r - b * TPB; return p < CTXL ? ctx + (size_t)(b * CTXL + p) * DM : lat + (size_t)(b * SEQ + p - CTXL) * DM; }
DI int modrow(int r) { const int b = r / TPB, p = r - b * TPB; return p < CTXL ? 2 : b; }

namespace pg8 {
constexpr int BM = 256, BK = 64, HALF = 128, HTB = HALF * BK * 2, STAGE_BYTES = 8 * HTB, NXCD = 8, WGM = 8;
DI int lds_byte(int r, int c) { const int st = (r >> 4) * 2 + (c >> 5), rr = r & 15, cc = c & 31, ob = rr * 64 + cc * 2; return st * 1024 + (ob ^ (((ob >> 9) & 1) << 5)); }
DI void stage_rc(int b, int& R, int& C) { const int st = b / 1024, sb = b % 1024, swz = sb ^ (((sb >> 9) & 1) << 5); R = (st >> 1) * 16 + swz / 64; C = (st & 1) * 32 + (swz % 64) / 2; }
DI int perm32(int rho) { const int n = rho >> 4, i = rho & 15; return 8 * (i >> 2) + 4 * n + (i & 3); }
struct Unit { int pm, pn; int aoff; };
struct Gemm { const bf16_t* A; const bf16_t* Bt; int lda, ldb, K; };

struct StaticOrder {
    int nM, nN, nwg, G, c;
    DI void init(int M, int N, int G_, int c_) { nM = M / BM; nN = N / BM; nwg = nM * nN; G = G_; c = c_; }
    DI bool next(int i, Unit& u) const {
        const long L = (long)i * G + c; if (L >= nwg) return false;
        int wgid = (int)L; { const int q = nwg / NXCD, r = nwg % NXCD, xcd = wgid % NXCD, off = wgid / NXCD; wgid = (xcd < r ? xcd * (q + 1) : r * (q + 1) + (xcd - r) * q) + off; }
        const int nig = WGM * nN, gid = wgid / nig, fm = gid * WGM, gsz = (nM - fm) < WGM ? (nM - fm) : WGM;
        u.pm = fm + ((wgid % nig) % gsz); u.pn = (wgid % nig) / gsz; u.aoff = 0; return true;
    }
};
struct MergeOrder : StaticOrder {
    DI bool next(int i, Unit& u) const { if (!StaticOrder::next(i, u)) return false; u.aoff = (u.pn >> 2) * 256 * 2; return true; }
};
struct MoeOrder {
    const int* meta; int nNl, G, c;
    DI bool next(int i, Unit& u) const {
        const int nrt = meta[0]; const long L = (long)i * G + c; if (L >= (long)nrt * nNl) return false;
        const int pm = (int)(L / nNl), pl = (int)(L % nNl); u.pm = pm; u.pn = meta[16 + pm] * nNl + pl; u.aoff = 0; return true;
    }
};

DI unsigned cvt_pk_bf16(float lo, float hi) { unsigned r; asm volatile("v_cvt_pk_bf16_f32 %0, %1, %2" : "=v"(r) : "v"(lo), "v"(hi)); return r; }

struct EpiIn {
    static constexpr bool PERM = true;
    bf16_t* O;
    DI void operator()(const f32x4 (&acc)[2][2][4][2], const Unit& u, int wr, int wc, int fr, int fq) const {
        const int row0 = u.pm * BM + wr * 64 + fr, col0 = u.pn * BM + wc * 32 + 8 * fq; const bool g = u.pn < 2;
#pragma unroll
        for (int ai = 0; ai < 2; ++ai)
#pragma unroll
            for (int m = 0; m < 4; ++m) { bf16_t* rowp = O + (size_t)(row0 + ai * HALF + m * 16) * INW + col0;
#pragma unroll
                for (int bj = 0; bj < 2; ++bj) { f32x4 v0 = acc[ai][bj][m][0], v1 = acc[ai][bj][m][1];
                    if (g) {
#pragma unroll
                        for (int e = 0; e < 4; ++e) { v0[e] = gelu_tanh(v0[e]); v1[e] = gelu_tanh(v1[e]); } }
                    u32x4 w; w.x = cvt_pk_bf16(v0[0], v0[1]); w.y = cvt_pk_bf16(v0[2], v0[3]); w.z = cvt_pk_bf16(v1[0], v1[1]); w.w = cvt_pk_bf16(v1[2], v1[3]);
                    *(u32x4*)(rowp + bj * HALF) = w; }
                asm volatile("" ::: "memory"); }
    }
};
struct EpiMerge {
    static constexpr bool PERM = true;
    bf16_t* P;
    DI void operator()(const f32x4 (&acc)[2][2][4][2], const Unit& u, int wr, int wc, int fr, int fq) const {
        const int row0 = u.pm * BM + wr * 64 + fr, col0 = C_GATE + u.pn * BM + wc * 32 + 8 * fq;
#pragma unroll
        for (int ai = 0; ai < 2; ++ai)
#pragma unroll
            for (int m = 0; m < 4; ++m) { bf16_t* rowp = P + (size_t)(row0 + ai * HALF + m * 16) * INW + col0;
#pragma unroll
                for (int bj = 0; bj < 2; ++bj) { const f32x4 v0 = acc[ai][bj][m][0], v1 = acc[ai][bj][m][1];
                    const u32x4 gt = *(const u32x4*)(rowp + bj * HALF);
                    float g[8]; g[0] = __uint_as_float(gt.x << 16); g[1] = __uint_as_float(gt.x & 0xffff0000u); g[2] = __uint_as_float(gt.y << 16); g[3] = __uint_as_float(gt.y & 0xffff0000u);
                    g[4] = __uint_as_float(gt.z << 16); g[5] = __uint_as_float(gt.z & 0xffff0000u); g[6] = __uint_as_float(gt.w << 16); g[7] = __uint_as_float(gt.w & 0xffff0000u);
                    u32x4 w; w.x = cvt_pk_bf16(sigm(g[0]) * v0[0], sigm(g[1]) * v0[1]); w.y = cvt_pk_bf16(sigm(g[2]) * v0[2], sigm(g[3]) * v0[3]);
                    w.z = cvt_pk_bf16(sigm(g[4]) * v1[0], sigm(g[5]) * v1[1]); w.w = cvt_pk_bf16(sigm(g[6]) * v1[2], sigm(g[7]) * v1[3]);
                    *(u32x4*)(rowp + bj * HALF) = w; asm volatile("" ::: "memory"); }
                }
    }
};
struct EpiResid {
    static constexpr bool PERM = false;
    const float* baseLat; const float* baseCtx; float* outLat; float* outCtx; const float* gate;
    DI void operator()(const f32x4 (&acc)[2][2][4][2], const Unit& u, int wr, int wc, int fr, int fq) const {
        const int b = u.pm / 33, j = u.pm - b * 33;
        const float* bs = j == 0 ? baseCtx + (size_t)b * CTXL * DM : baseLat + (size_t)(b * SEQ + (j - 1) * 256) * DM;
        float* os = j == 0 ? outCtx + (size_t)b * CTXL * DM : outLat + (size_t)(b * SEQ + (j - 1) * 256) * DM;
        const float* gt = gate + (size_t)(j == 0 ? 2 : b) * 6144;
        const int col0 = u.pn * BM + wc * 32 + 4 * fq, r0 = wr * 64 + fr;
        f32x4 gv[2][2];
#pragma unroll
        for (int bj = 0; bj < 2; ++bj)
#pragma unroll
            for (int n = 0; n < 2; ++n) gv[bj][n] = *(const f32x4*)(gt + col0 + bj * HALF + n * 16);
#pragma unroll
        for (int ai = 0; ai < 2; ++ai)
#pragma unroll
            for (int m = 0; m < 4; ++m) { const size_t off = (size_t)(r0 + ai * HALF + m * 16) * DM + col0;
#pragma unroll
                for (int bj = 0; bj < 2; ++bj)
#pragma unroll
                    for (int n = 0; n < 2; ++n) { const f32x4 x = *(const f32x4*)(bs + off + bj * HALF + n * 16); *(f32x4*)(os + off + bj * HALF + n * 16) = x + gv[bj][n] * acc[ai][bj][m][n]; }
                asm volatile("" ::: "memory"); }
    }
};
struct EpiSwiglu {
    static constexpr bool PERM = true;
    bf16_t* O; int ldo; int nNl;
    DI void operator()(const f32x4 (&acc)[2][2][4][2], const Unit& u, int wr, int wc, int fr, int fq) const {
        const int row0 = u.pm * BM + wr * 64 + fr, col0 = (u.pn % nNl) * HALF + wc * 32 + 8 * fq;
#pragma unroll
        for (int ai = 0; ai < 2; ++ai)
#pragma unroll
            for (int m = 0; m < 4; ++m) { bf16_t* rowp = O + (size_t)(row0 + ai * HALF + m * 16) * ldo + col0;
                const f32x4 a0 = acc[ai][0][m][0], a1 = acc[ai][0][m][1], b0 = acc[ai][1][m][0], b1 = acc[ai][1][m][1];
                u32x4 w; w.x = cvt_pk_bf16(siluf_(a0[0]) * b0[0], siluf_(a0[1]) * b0[1]); w.y = cvt_pk_bf16(siluf_(a0[2]) * b0[2], siluf_(a0[3]) * b0[3]);
                w.z = cvt_pk_bf16(siluf_(a1[0]) * b1[0], siluf_(a1[1]) * b1[1]); w.w = cvt_pk_bf16(siluf_(a1[2]) * b1[2], siluf_(a1[3]) * b1[3]);
                *(u32x4*)rowp = w; asm volatile("" ::: "memory"); }
    }
};
struct EpiMoe2 {
    static constexpr bool PERM = true;
    bf16_t* Y; const float* rowp; int nNl;
    DI void operator()(const f32x4 (&acc)[2][2][4][2], const Unit& u, int wr, int wc, int fr, int fq) const {
        const int col0 = (u.pn % nNl) * BM + wc * 32 + 8 * fq, r0 = u.pm * BM + wr * 64 + fr;
#pragma unroll
        for (int ai = 0; ai < 2; ++ai)
#pragma unroll
            for (int m = 0; m < 4; ++m) { const int r = r0 + ai * HALF + m * 16; const float pw = rowp[r]; bf16_t* rowq = Y + (size_t)r * DM + col0;
#pragma unroll
                for (int bj = 0; bj < 2; ++bj) { const f32x4 v0 = acc[ai][bj][m][0] * pw, v1 = acc[ai][bj][m][1] * pw;
                    u32x4 w; w.x = cvt_pk_bf16(v0[0], v0[1]); w.y = cvt_pk_bf16(v0[2], v0[3]); w.z = cvt_pk_bf16(v1[0], v1[1]); w.w = cvt_pk_bf16(v1[2], v1[3]);
                    *(u32x4*)(rowq + bj * HALF) = w; }
                asm volatile("" ::: "memory"); }
    }
};

template <class Epi, class Sched>
DI void gemm_phase(LAS unsigned char* lds, const int tid, const Gemm g, const Sched& S, const Epi& E) {
    constexpr bool SP2 = true, ALIGN_EPI = true;
    const int wid = __builtin_amdgcn_readfirstlane(tid >> 6), lane = tid & 63, wr = wid >> 2, wc = wid & 3, fr = lane & 15, fq = lane >> 4;
    const int K = g.K, nt = K / BK;
    unsigned voffA[2], voffB[2];
#pragma unroll
    for (int i = 0; i < 2; ++i) { int R, C; stage_rc(tid * 16 + i * 8192, R, C); const int Rb = Epi::PERM ? ((R & ~31) + perm32(R & 31)) : R;
        voffA[i] = (unsigned)(R * g.lda + C) * 2u; voffB[i] = (unsigned)(Rb * g.ldb + C) * 2u; }
    const size_t kstep = (size_t)(BK * 2);
    const size_t hstepA = (size_t)HALF * g.lda * 2, hstepB = (size_t)HALF * g.ldb * 2;
    const size_t tstepA = 2 * hstepA, tstepB = 2 * hstepB;
    const unsigned ldsw = (unsigned)wid * 1024u;
    const int aoff = lds_byte(wr * 64 + fr, fq * 8), boff = lds_byte(wc * 32 + fr, fq * 8);
#define PG8_SA(b, h) (((b) * 2 + (h)) * HTB)
#define PG8_SB(b, h) ((4 + (b) * 2 + (h)) * HTB)
#define PG8_STAGE(bufoff, gbase, voff) do { _Pragma("unroll") for (int _i = 0; _i < 2; ++_i) \
        __builtin_amdgcn_global_load_lds((const unsigned*)((const char*)(gbase) + (voff)[_i]), (LAS unsigned*)(lds + (bufoff) + ldsw + _i * 8192), 16, 0, 0); } while (0)
#define PG8_LDA(dst, b, h) do { _Pragma("unroll") for (int m = 0; m < 4; ++m) _Pragma("unroll") for (int k = 0; k < 2; ++k) dst[m][k] = *(const LAS bf16x8*)(lds + PG8_SA(b, h) + aoff + m * 2048 + k * 1024); } while (0)
#define PG8_LDB(dst, b, h) do { _Pragma("unroll") for (int n = 0; n < 2; ++n) _Pragma("unroll") for (int k = 0; k < 2; ++k) dst[n][k] = *(const LAS bf16x8*)(lds + PG8_SB(b, h) + boff + n * 2048 + k * 1024); } while (0)
#define PG8_MMA(ai, bj, At, Bt) do { __builtin_amdgcn_s_setprio(1); _Pragma("unroll") for (int m = 0; m < 4; ++m) _Pragma("unroll") for (int n = 0; n < 2; ++n) _Pragma("unroll") for (int k = 0; k < 2; ++k) \
        acc[ai][bj][m][n] = __builtin_amdgcn_mfma_f32_16x16x32_bf16(Bt[n][k], At[m][k], acc[ai][bj][m][n], 0, 0, 0); __builtin_amdgcn_s_setprio(0); } while (0)
#define PG8_WAIT_V(n) asm volatile("s_waitcnt vmcnt(" #n ")" ::: "memory")
#define PG8_WAIT_L(n) asm volatile("s_waitcnt lgkmcnt(" #n ")" ::: "memory")
#define PG8_BAR __builtin_amdgcn_s_barrier()
#define PG8_SCHED __builtin_amdgcn_sched_barrier(0)
    Unit cur, nxt; int ui = 0;
    if (!S.next(0, cur)) return;
    f32x4 acc[2][2][4][2];
#pragma unroll
    for (int a = 0; a < 2; ++a)
#pragma unroll
        for (int b = 0; b < 2; ++b)
#pragma unroll
            for (int m = 0; m < 4; ++m)
#pragma unroll
                for (int n = 0; n < 2; ++n) acc[a][b][m][n] = (f32x4){0.f, 0.f, 0.f, 0.f};
    bf16x8 At[4][2], B0[2][2], B1[2][2];
    const char* cA = (const char*)g.A + (size_t)cur.pm * tstepA + cur.aoff; const char* cB = (const char*)g.Bt + (size_t)cur.pn * tstepB;
    PG8_STAGE(PG8_SB(0, 0), cB, voffB); PG8_STAGE(PG8_SB(0, 1), cB + hstepB, voffB); PG8_STAGE(PG8_SA(0, 0), cA, voffA); PG8_STAGE(PG8_SA(0, 1), cA + hstepA, voffA);
    if (wr == 1) PG8_BAR;
    PG8_WAIT_V(2); PG8_BAR;
    PG8_STAGE(PG8_SB(1, 0), cB + kstep, voffB); PG8_STAGE(PG8_SA(1, 0), cA + kstep, voffA); PG8_STAGE(PG8_SB(1, 1), cB + hstepB + kstep, voffB);
    PG8_WAIT_V(6); PG8_BAR;
    for (;;) {
        const bool has_next = S.next(ui + 1, nxt);
        const char* nA = has_next ? (const char*)g.A + (size_t)nxt.pm * tstepA + nxt.aoff : cA; const char* nB = has_next ? (const char*)g.Bt + (size_t)nxt.pn * tstepB : cB;
        for (int t = 0; t < nt; t += 2) {
            const bool last = (t == nt - 2);
            const char* a1 = cA + (size_t)(t + 1) * kstep;
            const char* a2 = last ? nA : cA + (size_t)(t + 2) * kstep; const char* b2 = last ? nB : cB + (size_t)(t + 2) * kstep;
            const char* a3 = a2 + kstep; const char* b3 = b2 + kstep;
            PG8_LDB(B0, 0, 0); PG8_LDB(B1, 0, 1); PG8_SCHED; PG8_LDA(At, 0, 0); PG8_STAGE(PG8_SA(1, 1), a1 + hstepA, voffA);
            PG8_WAIT_V(8); PG8_WAIT_L(0); PG8_BAR; PG8_MMA(0, 0, At, B0); PG8_MMA(0, 1, At, B1); PG8_BAR; PG8_SCHED;
            PG8_LDA(At, 0, 1); PG8_STAGE(PG8_SB(0, 0), b2, voffB); PG8_STAGE(PG8_SB(0, 1), b2 + hstepB, voffB); PG8_STAGE(PG8_SA(0, 0), a2, voffA);
            PG8_WAIT_V(8); PG8_WAIT_L(0); PG8_BAR; PG8_MMA(1, 0, At, B0); PG8_MMA(1, 1, At, B1); PG8_BAR; PG8_SCHED;
            PG8_LDB(B0, 1, 0); PG8_LDB(B1, 1, 1); PG8_SCHED; PG8_LDA(At, 1, 0); PG8_STAGE(PG8_SA(0, 1), a2 + hstepA, voffA);
            PG8_WAIT_V(8); PG8_WAIT_L(0); PG8_BAR; PG8_MMA(0, 0, At, B0); PG8_MMA(0, 1, At, B1); PG8_BAR; PG8_SCHED;
            PG8_LDA(At, 1, 1); PG8_STAGE(PG8_SB(1, 0), b3, voffB); PG8_STAGE(PG8_SB(1, 1), b3 + hstepB, voffB); PG8_STAGE(PG8_SA(1, 0), a3, voffA);
            PG8_WAIT_V(8); PG8_WAIT_L(0); PG8_BAR; PG8_MMA(1, 0, At, B0); PG8_MMA(1, 1, At, B1); PG8_BAR; PG8_SCHED;
        }
        if constexpr (ALIGN_EPI) { if (wr == 0) PG8_BAR; }
        E(acc, cur, wr, wc, fr, fq);
        if (!has_next) break;
#pragma unroll
        for (int a = 0; a < 2; ++a)
#pragma unroll
            for (int b = 0; b < 2; ++b)
#pragma unroll
                for (int m = 0; m < 4; ++m)
#pragma unroll
                    for (int n = 0; n < 2; ++n) acc[a][b][m][n] = (f32x4){0.f, 0.f, 0.f, 0.f};
        cur = nxt; cA = nA; cB = nB; ++ui;
        if constexpr (ALIGN_EPI) { if (wr == 1) PG8_BAR; }
    }
    PG8_WAIT_V(0);
    if constexpr (!ALIGN_EPI) { if (wr == 0) PG8_BAR; }
    PG8_BAR;
#undef PG8_SA
#undef PG8_SB
#undef PG8_STAGE
#undef PG8_LDA
#undef PG8_LDB
#undef PG8_MMA
#undef PG8_WAIT_V
#undef PG8_WAIT_L
#undef PG8_BAR
#undef PG8_SCHED
}
}

#define XB_TMO      128
#define XB_XCNT(j)  (256  + 64 * (j))
#define XB_XSUB(j)  (1280 + 64 * (j))
#define XB_XGEN(j)  (2304 + 64 * (j))
#define XB_TOP      3328
#define XB_TOPGEN   3392
#define XCD_BAR_WORDS 3456
#define XB_SPIN_CAP (1u << 18)
DI unsigned xb_ld(unsigned* p)              { return __hip_atomic_load(p, __ATOMIC_RELAXED, __HIP_MEMORY_SCOPE_AGENT); }
DI unsigned xb_add(unsigned* p, unsigned v) { return __hip_atomic_fetch_add(p, v, __ATOMIC_RELAXED, __HIP_MEMORY_SCOPE_AGENT); }
DI unsigned xb_xcc_id() { return (unsigned)__builtin_amdgcn_s_getreg((3 << 11) | 20) & 0xFu; }
#define XB_SPIN(cond, bar) do { unsigned _sp = 0; while (cond) { __builtin_amdgcn_s_sleep(1); \
    if ((++_sp & 255u) == 0u) { if (xb_ld(&(bar)[XB_TMO])) break; if (_sp > XB_SPIN_CAP) { atomicAdd(&(bar)[XB_TMO], 1u); break; } } } } while (0)
struct XcdBarrier { unsigned* bar; unsigned x; volatile LAS unsigned* st; };
DI XcdBarrier xcd_barrier_post(unsigned* bar, volatile LAS unsigned* st) {
    XcdBarrier b; b.bar = bar; b.x = xb_xcc_id(); b.st = st;
    if (threadIdx.x == 0) (void)xb_add(&bar[XB_XCNT(b.x)], 1u);
    return b;
}
DI void xcd_barrier_complete(unsigned* bar, unsigned x, unsigned& nloc, unsigned& nx) {
    const unsigned G = gridDim.x * gridDim.y * gridDim.z;
    unsigned sum, cnt, mine, sp = 0u;
    for (;;) {
        sum = 0u; cnt = 0u; mine = 0u;
#pragma unroll
        for (unsigned j = 0; j < 16; ++j) { const unsigned c = xb_ld(&bar[XB_XCNT(j)]); sum += c; cnt += (c > 0u) ? 1u : 0u; mine = (j == x) ? c : mine; }
        if (sum == G) break;
        __builtin_amdgcn_s_sleep(1);
        if ((++sp & 255u) == 0u) { if (xb_ld(&bar[XB_TMO])) break; if (sp > XB_SPIN_CAP) { atomicAdd(&bar[XB_TMO], 1u); break; } }
    }
    nloc = mine > 0u ? mine : 1u; nx = cnt > 0u ? cnt : 1u;
}
DI void xcd_barrier(const XcdBarrier& b) {
    asm volatile("s_waitcnt vmcnt(0)" ::: "memory");
    __syncthreads();
    if (threadIdx.x == 0) {
        unsigned* bar = b.bar;
        __builtin_amdgcn_s_waitcnt(0);
        unsigned nloc = b.st[0], nx = b.st[1];
        if (nloc == 0u) { xcd_barrier_complete(bar, b.x, nloc, nx); b.st[0] = nloc; b.st[1] = nx; }
        const unsigned old = xb_add(&bar[XB_XSUB(b.x)], 1u);
        const unsigned gen = old / nloc;
        if (old + 1u == (gen + 1u) * nloc) {
            __builtin_amdgcn_fence(__ATOMIC_RELEASE, "agent");
            asm volatile("s_waitcnt vmcnt(0)" ::: "memory");
            const unsigned og = xb_add(&bar[XB_TOP], 1u);
            const unsigned tg = og / nx;
            if (og + 1u == (tg + 1u) * nx) xb_add(&bar[XB_TOPGEN], 1u);
            else XB_SPIN(xb_ld(&bar[XB_TOPGEN]) == tg, bar);
            __builtin_amdgcn_fence(__ATOMIC_ACQUIRE, "agent");
            xb_add(&bar[XB_XGEN(b.x)], 1u);
            asm volatile("s_waitcnt vmcnt(0)" ::: "memory");
        } else {
            XB_SPIN(xb_ld(&bar[XB_XGEN(b.x)]) == gen, bar);
            __builtin_amdgcn_fence(__ATOMIC_ACQUIRE, "agent");
            asm volatile("s_waitcnt vmcnt(0)" ::: "memory");
        }
    }
    __syncthreads();
}

constexpr int NWAVES = 8, NTHREADS = 512;
constexpr int RING_BYTES = 131072, MISC_OFF = RING_BYTES + 320, LDS_BYTES = 147456;

struct Ctx {
    LAS unsigned char* lds; int tid, lane, wave, G, bid, z;
    float* out; unsigned char* ws;
};
#define WSP(T_, off) ((T_*)(C.ws + (off)))

DI void phase_g0(const Params& a, const Ctx& C) {
    const float* cvec = a.in[C.z + 1]; const float* cctx = a.in[C.z + 3]; const float* w_mod = a.in[C.z + 4]; const float* b_mod = a.in[C.z + 5];
    float* mod = WSP(float, WS_MOD);
    LAS float* red = (LAS float*)C.lds;
    for (int u = C.bid; u < DEPTH * 96; u += C.G) {
        const int L = u / 96, cg = u % 96, col = cg * 64 + C.lane;
        float a0 = 0.f, a1 = 0.f, a2 = 0.f;
        const float* w = w_mod + (size_t)L * DM * 6144 + col;
        for (int kk = 0; kk < 128; ++kk) { const int k = C.wave * 128 + kk; const float wv = w[(size_t)k * 6144];
            a0 += siluf_(cvec[k]) * wv; a1 += siluf_(cvec[DM + k]) * wv; a2 += siluf_(cctx[k]) * wv; }
        red[(C.wave * 3 + 0) * 64 + C.lane] = a0; red[(C.wave * 3 + 1) * 64 + C.lane] = a1; red[(C.wave * 3 + 2) * 64 + C.lane] = a2;
        __syncthreads();
        if (C.wave < 3) { float s = 0.f;
#pragma unroll
            for (int w8 = 0; w8 < 8; ++w8) s += red[(w8 * 3 + C.wave) * 64 + C.lane];
            mod[(size_t)(L * 3 + C.wave) * 6144 + col] = s + b_mod[L * 6144 + col]; }
        __syncthreads();
    }
    const int gt = C.bid * NTHREADS + C.tid, GT = C.G * NTHREADS;
    float* tab = WSP(float, WS_TAB);
    for (int i = gt; i < SEQ * 32; i += GT) { const int t = i >> 5, f = i & 31; const float pos = (f < 16) ? (float)(t >> 6) : (float)(t & 63);
        const float inv = exp2f(-(float)(f & 15) * (13.287712379549449f / 16.f)); const float ang = pos * inv; float s, c; sincosf(ang, &s, &c);
        tab[TAB_AXC / 4 + i] = c; tab[TAB_AXS / 4 + i] = s; }
    for (int i = gt; i < TPB * 32; i += GT) { const int p = i >> 5, f = i & 31;
        const float inv = exp2f(-(float)f * (13.287712379549449f / 32.f)); const float ang = (float)p * inv; float s, c; sincosf(ang, &s, &c);
        tab[TAB_SQC / 4 + i] = c; tab[TAB_SQS / 4 + i] = s; }
    const float* ws_in = a.in[C.z + 10]; bf16_t* wsb = WSP(bf16_t, WS_WSB);
    for (int i = gt; i < DEPTH * 4 * 128 * 128; i += GT) wsb[i] = (bf16_t)f2bf(ws_in[i]);
}

DI void cvt_item(const float* W, int K, int N, bf16_t* WT, int mode, int row_off, LAS float* scr, int item, int lane) {
    const int nblk = N / 32, kb = item / nblk, nb = item % nblk, k0 = 64 * kb, n0 = 32 * nb;
#pragma unroll 8
    for (int i = 0; i < 32; ++i) { const int kk = 2 * i + (lane >> 5); scr[kk * 33 + (lane & 31)] = W[(size_t)(k0 + kk) * N + n0 + (lane & 31)]; }
    asm volatile("s_waitcnt lgkmcnt(0)" ::: "memory");
    const int r0 = (mode == 0) ? row_off + n0 : row_off + 256 * (n0 >> 7) + (n0 & 127) + (mode == 2 ? 128 : 0);
    const int c = lane & 7;
#pragma unroll
    for (int j = 0; j < 4; ++j) { const int n = (lane >> 3) + 8 * j; const LAS float* s = scr + (8 * c) * 33 + n;
        u32x4 o; o.x = pk2(s[0 * 33], s[1 * 33]); o.y = pk2(s[2 * 33], s[3 * 33]); o.z = pk2(s[4 * 33], s[5 * 33]); o.w = pk2(s[6 * 33], s[7 * 33]);
        *(u32x4*)(WT + (size_t)(r0 + n) * K + k0 + 8 * c) = o; }
    asm volatile("s_waitcnt lgkmcnt(0)" ::: "memory");
}
DI void phase_cvt(const Params& a, const Ctx& C, int L) {
    LAS float* scr = (LAS float*)(C.lds + C.wave * 16384);
    const int gw = C.bid * NWAVES + C.wave, NGW = C.G * NWAVES;
    bf16_t* win_t = WSP(bf16_t, WS_W + W_IN); bf16_t* wbr_t = WSP(bf16_t, WS_W + W_BR); bf16_t* wout_t = WSP(bf16_t, WS_W + W_OUT);
    bf16_t* w13_t = WSP(bf16_t, WS_W + W_13); bf16_t* w2_t = WSP(bf16_t, WS_W + W_2);
    const int j = L >> 1; const bool moe = L & 1;
    constexpr int I_IN = 16 * 208, I_BR = 4 * 32, I_OUT = 16 * 32, I_F13 = 16 * 88, I_F2 = 44 * 32, I_M13 = 16 * 56, I_M2 = 28 * 32;
    const int nitems = I_IN + 4 * I_BR + I_OUT + (moe ? NEXP * (2 * I_M13 + I_M2) : 2 * I_F13 + I_F2);
    for (int it = gw; it < nitems; it += NGW) {
        int r = it;
        if (r < I_IN) { cvt_item(a.in[C.z + 8] + (size_t)L * DM * INW, DM, INW, win_t, 0, 0, scr, r, C.lane); continue; } r -= I_IN;
        if (r < 4 * I_BR) { const int i = r / I_BR; cvt_item(a.in[C.z + 19] + (size_t)(L * 4 + i) * 256 * DM, 256, DM, wbr_t, 0, i * DM, scr, r % I_BR, C.lane); continue; } r -= 4 * I_BR;
        if (r < I_OUT) { cvt_item(a.in[C.z + 20] + (size_t)L * DM * DM, DM, DM, wout_t, 0, 0, scr, r, C.lane); continue; } r -= I_OUT;
        if (!moe) {
            if (r < I_F13) { cvt_item(a.in[C.z + 21] + (size_t)j * DM * DFF, DM, DFF, w13_t, 1, 0, scr, r, C.lane); continue; } r -= I_F13;
            if (r < I_F13) { cvt_item(a.in[C.z + 22] + (size_t)j * DM * DFF, DM, DFF, w13_t, 2, 0, scr, r, C.lane); continue; } r -= I_F13;
            cvt_item(a.in[C.z + 23] + (size_t)j * DFF * DM, DFF, DM, w2_t, 0, 0, scr, r, C.lane);
        } else {
            const int e = r / (2 * I_M13 + I_M2); r -= e * (2 * I_M13 + I_M2);
            const size_t eo = (size_t)(j * NEXP + e) * DM * DFE;
            if (r < I_M13) { cvt_item(a.in[C.z + 26] + eo, DM, DFE, w13_t, 1, e * 2 * DFE, scr, r, C.lane); continue; } r -= I_M13;
            if (r < I_M13) { cvt_item(a.in[C.z + 27] + eo, DM, DFE, w13_t, 2, e * 2 * DFE, scr, r, C.lane); continue; } r -= I_M13;
            cvt_item(a.in[C.z + 28] + eo, DFE, DM, w2_t, 0, e * DM, scr, r, C.lane);
        }
    }
}

DI void phase_norm(const Params& a, const Ctx& C, int L, int which, const float* srcLat, const float* srcCtx) {
    const float* gn = a.in[C.z + which ? 7 : 6] + (size_t)L * DM;
    const float* mod = WSP(float, WS_MOD) + (size_t)L * 3 * 6144;
    bf16_t* H = WSP(bf16_t, WS_H);
    const bool route = which && (L & 1);
    const float* rw = a.in[C.z + 24] + (size_t)(L >> 1) * DM * NEXP; const float* rb = a.in[C.z + 25] + (size_t)(L >> 1) * NEXP;
    int* rt_i = WSP(int, WS_ROUTE); float* rt_f = WSP(float, WS_ROUTE);
    unsigned* cnt = WSP(unsigned, WS_CTL) + CW_CNT + (L >> 1) * 8 * 64;
    const int gw = C.bid * NWAVES + C.wave, NGW = C.G * NWAVES;
    for (int r = gw; r < T; r += NGW) {
        const float* xr = xrow_c(srcLat, srcCtx, r); const int mr = modrow(r);
        const float* sh = mod + (size_t)mr * 6144 + (which ? 3 : 0) * DM; const float* sc = sh + DM;
        f32x4 v[4]; float ss = 0.f;
#pragma unroll
        for (int j = 0; j < 4; ++j) { v[j] = *(const f32x4*)(xr + 4 * C.lane + 256 * j); ss += (v[j].x * v[j].x + v[j].y * v[j].y) + (v[j].z * v[j].z + v[j].w * v[j].w); }
        const float rs = 1.f / sqrtf(wave_sum(ss) * (1.f / DM) + EPS);
        float lg[8];
#pragma unroll
        for (int e = 0; e < 8; ++e) lg[e] = 0.f;
#pragma unroll
        for (int j = 0; j < 4; ++j) { const int c0 = 4 * C.lane + 256 * j; const f32x4 g4 = *(const f32x4*)(gn + c0), s4 = *(const f32x4*)(sc + c0), h4 = *(const f32x4*)(sh + c0);
            f32x4 h = v[j] * rs * g4 * (s4 + 1.f) + h4;
            u32x2 o; o.x = pk2(h.x, h.y); o.y = pk2(h.z, h.w); *(u32x2*)(H + (size_t)r * DM + c0) = o;
            if (route) {
#pragma unroll
                for (int q = 0; q < 4; ++q) { const f32x4 w0 = *(const f32x4*)(rw + (size_t)(c0 + q) * 8), w1 = *(const f32x4*)(rw + (size_t)(c0 + q) * 8 + 4); const float hv = h[q];
                    lg[0] += hv * w0.x; lg[1] += hv * w0.y; lg[2] += hv * w0.z; lg[3] += hv * w0.w; lg[4] += hv * w1.x; lg[5] += hv * w1.y; lg[6] += hv * w1.z; lg[7] += hv * w1.w; } } }
        if (route) {
#pragma unroll
            for (int e = 0; e < 8; ++e) lg[e] = wave_sum(lg[e]) + rb[e];
            int e1 = 0; float v1 = lg[0];
#pragma unroll
            for (int e = 1; e < 8; ++e) if (lg[e] > v1) { v1 = lg[e]; e1 = e; }
            int e2 = -1; float v2 = -3.0e38f;
#pragma unroll
            for (int e = 0; e < 8; ++e) if (e != e1 && lg[e] > v2) { v2 = lg[e]; e2 = e; }
            if (C.lane == 0) { const float p1 = 1.f / (1.f + expf(v2 - v1));
                const unsigned q1 = atomicAdd(cnt + e1 * 64, 1u), q2 = atomicAdd(cnt + e2 * 64, 1u);
                rt_i[RT_E + 2 * r] = e1; rt_i[RT_E + 2 * r + 1] = e2; rt_i[RT_POS + 2 * r] = (int)q1; rt_i[RT_POS + 2 * r + 1] = (int)q2;
                rt_f[RT_PW + 2 * r] = p1; rt_f[RT_PW + 2 * r + 1] = 1.f - p1; }
        }
    }
}

DI void phase_prep(const Params& a, const Ctx& C, int L) {
    bf16_t* P = WSP(bf16_t, WS_P); bf16_t* VT = WSP(bf16_t, WS_VT);
    const float* tab = WSP(float, WS_TAB);
    const float* axc = tab + TAB_AXC / 4; const float* axs = tab + TAB_AXS / 4; const float* sqc = tab + TAB_SQC / 4; const float* sqs = tab + TAB_SQS / 4;
    const float* gvv = a.in[C.z + 9] + (size_t)L * 256; const float* wqn = a.in[C.z + 12] + L * 64; const float* wkn = a.in[C.z + 13] + L * 64; const float* gqn = a.in[C.z + 15] + L * 64; const float* gkn = a.in[C.z + 16] + L * 64;
    const int lane = C.lane, i32 = lane & 31; const bool hiH = lane >= 32;
    for (int u = C.bid; u < T / 64; u += C.G) {
        const int row0 = u * 64;
        for (int rr = 0; rr < 8; ++rr) {
            const int r = row0 + C.wave * 8 + rr; const int b = r / TPB, p = r - b * TPB; const bool lat = p >= CTXL; const int t = p - CTXL;
            bf16_t* pr = P + (size_t)r * INW;
            const float ac = lat ? axc[t * 32 + i32] : 1.f, as = lat ? axs[t * 32 + i32] : 0.f;
            const float sc_ = sqc[p * 32 + i32], ss_ = sqs[p * 32 + i32];
#pragma unroll 1
            for (int it = 0; it < 24; ++it) {
                int col; const float* g = nullptr; float scale = 1.f; int rope = 0;
                if (it < 4) { col = C_WQ + 64 * it; g = wqn; rope = 1; scale = QSCALE; }
                else if (it < 6) { col = C_WK + 64 * (it - 4); g = wkn; rope = 1; }
                else if (it < 10) { col = C_GQ + 64 * (it - 6); g = gqn; rope = 1; scale = QSCALE; }
                else if (it < 12) { col = C_GK + 64 * (it - 10); g = gkn; rope = 1; }
                else if (it < 16) { col = C_RQ + 64 * (it - 12); rope = 2; }
                else if (it < 20) { col = C_RK + 64 * (it - 16); rope = 2; scale = 0.125f; }
                else { col = C_V + 64 * (it - 20); g = gvv + 64 * (it - 20); }
                float x = bf2f(pr[col + lane]);
                if (g) { const float ss = wave_sum(x * x); x = x * (1.f / sqrtf(ss * (1.f / 64.f) + EPS)) * g[lane]; }
                if (rope) { const float c = rope == 1 ? ac : sc_, s = rope == 1 ? as : ss_; const float o = __shfl_xor(x, 32);
                    x = hiH ? (o * s + x * c) : (x * c - o * s); }
                pr[col + lane] = (bf16_t)f2bf(x * scale);
            }
        }
        { const int hh = C.tid >> 7, d = (C.tid >> 1) & 63, tg = C.tid & 1; const int kind = hh >> 1, kvh = hh & 1;
          const int b = row0 / TPB, p0 = row0 - b * TPB + 32 * tg; const int col = (kind ? C_GV : C_WV) + 64 * kvh + d;
          const bf16_t* src = P + (size_t)(row0 + 32 * tg) * INW + col;
          bf16_t* dst = VT + ((size_t)((kind * 2 + b) * 2 + kvh) * 64 + d) * TPB + p0;
#pragma unroll
          for (int q = 0; q < 4; ++q) { unsigned w[4];
#pragma unroll
              for (int e = 0; e < 4; ++e) { const unsigned lo = src[(size_t)(8 * q + 2 * e) * INW], hi = src[(size_t)(8 * q + 2 * e + 1) * INW]; w[e] = lo | (hi << 16); }
              *(u32x4*)(dst + 8 * q) = (u32x4){w[0], w[1], w[2], w[3]}; } }
    }
}

DI void mixA_unit(const Params& a, const Ctx& C, int L, int cg, int g) {
    const bf16_t* P = WSP(bf16_t, WS_P); bf16_t* BR = WSP(bf16_t, WS_BR);
    const bf16_t* W = WSP(bf16_t, WS_WSB) + (size_t)(L * 4 + g) * 128 * 128; const float* bs = a.in[C.z + 11] + (size_t)(L * 4 + g) * 128;
    LAS bf16_t* vnT = (LAS bf16_t*)C.lds;
    const int row0 = cg * 128, lane = C.lane, l15 = lane & 15, quad = lane >> 4;
#pragma unroll
    for (int it = 0; it < 2; ++it) { const int idx = C.tid + 512 * it, j = idx >> 3, ch = idx & 7;
        const u32x4 v = *(const u32x4*)(P + (size_t)(row0 + j) * INW + C_V + 64 * g + 8 * ch);
        const unsigned w[4] = {v.x, v.y, v.z, v.w};
#pragma unroll
        for (int e = 0; e < 4; ++e) { vnT[(8 * ch + 2 * e) * 136 + j] = (bf16_t)(w[e] & 0xffffu); vnT[(8 * ch + 2 * e + 1) * 136 + j] = (bf16_t)(w[e] >> 16); } }
    __syncthreads();
    const int i0 = 16 * C.wave;
    f32x4 acc[4];
#pragma unroll
    for (int dt = 0; dt < 4; ++dt) acc[dt] = (f32x4){0.f, 0.f, 0.f, 0.f};
#pragma unroll
    for (int ks = 0; ks < 4; ++ks) { const bf16x8 a = *(const bf16x8*)(W + (size_t)(i0 + l15) * 128 + 32 * ks + 8 * quad);
#pragma unroll
        for (int dt = 0; dt < 4; ++dt) { const bf16x8 bb = *(const LAS bf16x8*)(vnT + (16 * dt + l15) * 136 + 32 * ks + 8 * quad); acc[dt] = MFMA16(a, bb, acc[dt]); } }
#pragma unroll
    for (int dt = 0; dt < 4; ++dt)
#pragma unroll
        for (int j = 0; j < 4; ++j) { const int i = i0 + quad * 4 + j, d = 16 * dt + l15; const float mixed = acc[dt][j] + bs[i];
            const float uv = bf2f(P[(size_t)(row0 + i) * INW + C_U + 64 * g + d]); BR[(size_t)(row0 + i) * DM + 64 * g + d] = (bf16_t)f2bf(uv * mixed); }
    __syncthreads();
}

DI void attn_unit(const Params& a, const Ctx& C, int L, int kind, int b, int kvh, int qrow0, int ntile0, int krow0, int ntile1, int krow1, bool masked, bool has_sink) {
    const bf16_t* P = WSP(bf16_t, WS_P); bf16_t* BR = WSP(bf16_t, WS_BR);
    const bf16_t* VTb = WSP(bf16_t, WS_VT) + (size_t)((kind * 2 + b) * 2 + kvh) * 64 * TPB;
    const int Qcol = kind ? C_GQ : C_WQ, Kcol = (kind ? C_GK : C_WK) + 64 * kvh, Ocol = kind ? 512 : 256;
    LAS bf16_t* Kb = (LAS bf16_t*)C.lds;
    LAS bf16_t* Vb = (LAS bf16_t*)(C.lds + 2 * 64 * 144);
    const int lane = C.lane, r32 = lane & 31, hi = lane >> 5, w = C.wave, hq = 2 * kvh + (w >> 2);
    const int q = qrow0 + 32 * (w & 3) + r32;
    bf16x8 qr[4];
#pragma unroll
    for (int d0 = 0; d0 < 4; ++d0) qr[d0] = *(const bf16x8*)(P + (size_t)q * INW + Qcol + 64 * hq + 16 * d0 + 8 * hi);
    float m = has_sink ? a.in[C.z + 14][L * 4 + hq] * LOG2E : -1e30f, l = (has_sink && hi == 0) ? 1.f : 0.f;
    f32x16 o0, o1;
#pragma unroll
    for (int i = 0; i < 16; ++i) { o0[i] = 0.f; o1[i] = 0.f; }
    const int nt = ntile0 + ntile1; const int lr = C.tid >> 3, lc = C.tid & 7;
    const int qpos = q - (b * TPB + CTXL);
    u32x4 kreg, vreg;
    { const int kr = krow0; kreg = *(const u32x4*)(P + (size_t)(kr + lr) * INW + Kcol + 8 * lc); vreg = *(const u32x4*)(VTb + (size_t)lr * TPB + (kr - b * TPB) + 8 * lc); }
    *(LAS u32x4*)(Kb + lr * 72 + 8 * lc) = kreg; *(LAS u32x4*)(Vb + lr * 72 + 8 * lc) = vreg;
    __syncthreads();
    for (int t = 0; t < nt; ++t) {
        const int cur = t & 1; const bool more = t + 1 < nt;
        if (more) { const int tn = t + 1; const int kr = tn < ntile0 ? krow0 + 64 * tn : krow1 + 64 * (tn - ntile0);
            kreg = *(const u32x4*)(P + (size_t)(kr + lr) * INW + Kcol + 8 * lc); vreg = *(const u32x4*)(VTb + (size_t)lr * TPB + (kr - b * TPB) + 8 * lc); }
        const LAS bf16_t* Kc = Kb + cur * 64 * 72; const LAS bf16_t* Vc = Vb + cur * 64 * 72;
        f32x16 p0, p1;
#pragma unroll
        for (int i = 0; i < 16; ++i) { p0[i] = 0.f; p1[i] = 0.f; }
#pragma unroll
        for (int d0 = 0; d0 < 4; ++d0) { const bf16x8 k0 = *(const LAS bf16x8*)(Kc + r32 * 72 + 16 * d0 + 8 * hi), k1 = *(const LAS bf16x8*)(Kc + (32 + r32) * 72 + 16 * d0 + 8 * hi);
            p0 = MFMA32(k0, qr[d0], p0); p1 = MFMA32(k1, qr[d0], p1); }
        if (masked && t >= ntile0) { const int kp0 = krow1 + 64 * (t - ntile0) - (b * TPB + CTXL);
#pragma unroll
            for (int i = 0; i < 16; ++i) { const int kp = kp0 + crow(i, hi); int d = qpos - kp; d = d < 0 ? -d : d; if (d > 128) p0[i] = -1e30f; int d2 = qpos - (kp + 32); d2 = d2 < 0 ? -d2 : d2; if (d2 > 128) p1[i] = -1e30f; } }
        float mx = p0[0];
#pragma unroll
        for (int i = 1; i < 16; ++i) mx = fmaxf(mx, p0[i]);
#pragma unroll
        for (int i = 0; i < 16; ++i) mx = fmaxf(mx, p1[i]);
        mx = fmaxf(mx, __shfl_xor(mx, 32));
        const float mn = fmaxf(m, mx), alpha = ex2(m - mn); m = mn; l *= alpha;
        float ps = 0.f;
#pragma unroll
        for (int i = 0; i < 16; ++i) { o0[i] *= alpha; o1[i] *= alpha; p0[i] = ex2(p0[i] - mn); p1[i] = ex2(p1[i] - mn); ps += p0[i] + p1[i]; }
        l += ps;
        bf16x8 pw[4];
        { u32x4 t0 = {pk2(p0[0], p0[1]), pk2(p0[2], p0[3]), pk2(p0[4], p0[5]), pk2(p0[6], p0[7])}; pw[0] = __builtin_bit_cast(bf16x8, t0);
          u32x4 t1 = {pk2(p0[8], p0[9]), pk2(p0[10], p0[11]), pk2(p0[12], p0[13]), pk2(p0[14], p0[15])}; pw[1] = __builtin_bit_cast(bf16x8, t1);
          u32x4 t2 = {pk2(p1[0], p1[1]), pk2(p1[2], p1[3]), pk2(p1[4], p1[5]), pk2(p1[6], p1[7])}; pw[2] = __builtin_bit_cast(bf16x8, t2);
          u32x4 t3 = {pk2(p1[8], p1[9]), pk2(p1[10], p1[11]), pk2(p1[12], p1[13]), pk2(p1[14], p1[15])}; pw[3] = __builtin_bit_cast(bf16x8, t3); }
#pragma unroll
        for (int s = 0; s < 4; ++s) {
            const u32x2 a0 = *(const LAS u32x2*)(Vc + r32 * 72 + 16 * s + 4 * hi), a1 = *(const LAS u32x2*)(Vc + r32 * 72 + 16 * s + 8 + 4 * hi);
            const u32x2 c0 = *(const LAS u32x2*)(Vc + (32 + r32) * 72 + 16 * s + 4 * hi), c1 = *(const LAS u32x2*)(Vc + (32 + r32) * 72 + 16 * s + 8 + 4 * hi);
            const u32x4 va = {a0.x, a0.y, a1.x, a1.y}, vc = {c0.x, c0.y, c1.x, c1.y};
            o0 = MFMA32(__builtin_bit_cast(bf16x8, va), pw[s], o0); o1 = MFMA32(__builtin_bit_cast(bf16x8, vc), pw[s], o1); }
        if (more) { const int nx = cur ^ 1; *(LAS u32x4*)(Kb + nx * 64 * 72 + lr * 72 + 8 * lc) = kreg; *(LAS u32x4*)(Vb + nx * 64 * 72 + lr * 72 + 8 * lc) = vreg; }
        __syncthreads();
    }
    l += __shfl_xor(l, 32);
    const float inv = 1.f / l;
    bf16_t* orow = BR + (size_t)q * DM + Ocol + 64 * hq;
#pragma unroll
    for (int g = 0; g < 4; ++g) { const int d = 8 * g + 4 * hi;
        u32x2 w0 = {pk2(o0[4 * g] * inv, o0[4 * g + 1] * inv), pk2(o0[4 * g + 2] * inv, o0[4 * g + 3] * inv)}; *(u32x2*)(orow + d) = w0;
        u32x2 w1 = {pk2(o1[4 * g] * inv, o1[4 * g + 1] * inv), pk2(o1[4 * g + 2] * inv, o1[4 * g + 3] * inv)}; *(u32x2*)(orow + 32 + d) = w1; }
}

DI float log2_sigmoid(float x) { return -log1pf(expf(-x)) * LOG2E; }
DI void ret_kv_unit(const Params& a, const Ctx& C, int L, int cg, int h) {
    const bf16_t* P = WSP(bf16_t, WS_P); float* KVT = WSP(float, WS_KVT);
    const float l2f = log2_sigmoid(a.in[C.z + 17][(L * 2 + 0) * 4 + h]), l2b = log2_sigmoid(a.in[C.z + 17][(L * 2 + 1) * 4 + h]);
    LAS bf16_t* VTs = (LAS bf16_t*)C.lds; LAS bf16_t* KTf = VTs + 64 * 136; LAS bf16_t* KTb = KTf + 64 * 136;
    const int row0 = cg * 128, lane = C.lane, l15 = lane & 15, quad = lane >> 4;
#pragma unroll
    for (int it = 0; it < 2; ++it) { const int idx = C.tid + 512 * it, j = idx >> 3, ch = idx & 7;
        const u32x4 kv = *(const u32x4*)(P + (size_t)(row0 + j) * INW + C_RK + 64 * h + 8 * ch), vv = *(const u32x4*)(P + (size_t)(row0 + j) * INW + C_RV + 64 * h + 8 * ch);
        const float wf = ex2((float)(127 - j) * l2f), wb = ex2((float)j * l2b);
        const unsigned kw[4] = {kv.x, kv.y, kv.z, kv.w}, vw[4] = {vv.x, vv.y, vv.z, vv.w};
#pragma unroll
        for (int e = 0; e < 4; ++e) { const float k0 = __uint_as_float(kw[e] << 16), k1 = __uint_as_float(kw[e] & 0xffff0000u);
            KTf[(8 * ch + 2 * e) * 136 + j] = (bf16_t)f2bf(k0 * wf); KTf[(8 * ch + 2 * e + 1) * 136 + j] = (bf16_t)f2bf(k1 * wf);
            KTb[(8 * ch + 2 * e) * 136 + j] = (bf16_t)f2bf(k0 * wb); KTb[(8 * ch + 2 * e + 1) * 136 + j] = (bf16_t)f2bf(k1 * wb);
            VTs[(8 * ch + 2 * e) * 136 + j] = (bf16_t)(vw[e] & 0xffffu); VTs[(8 * ch + 2 * e + 1) * 136 + j] = (bf16_t)(vw[e] >> 16); } }
    __syncthreads();
    const int dir = C.wave >> 2, vt = C.wave & 3; const LAS bf16_t* KT = dir ? KTb : KTf;
    f32x4 acc[4];
#pragma unroll
    for (int dt = 0; dt < 4; ++dt) acc[dt] = (f32x4){0.f, 0.f, 0.f, 0.f};
#pragma unroll
    for (int ks = 0; ks < 4; ++ks) { const bf16x8 a = *(const LAS bf16x8*)(VTs + (16 * vt + l15) * 136 + 32 * ks + 8 * quad);
#pragma unroll
        for (int dt = 0; dt < 4; ++dt) { const bf16x8 bb = *(const LAS bf16x8*)(KT + (16 * dt + l15) * 136 + 32 * ks + 8 * quad); acc[dt] = MFMA16(a, bb, acc[dt]); } }
    const int b = cg / NCHUNK, c = cg - b * NCHUNK;
    float* dst = KVT + ((size_t)((dir * 2 + b) * 4 + h) * NCHUNK + c) * 4096;
#pragma unroll
    for (int dt = 0; dt < 4; ++dt)
#pragma unroll
        for (int j = 0; j < 4; ++j) dst[(16 * vt + quad * 4 + j) * 64 + 16 * dt + l15] = acc[dt][j];
    __syncthreads();
}
DI void phase_ret_scan(const Params& a, const Ctx& C, int L) {
    const float* KVT = WSP(float, WS_KVT); bf16_t* SIN = WSP(bf16_t, WS_SIN);
    const int gt = C.bid * NTHREADS + C.tid;
    if (gt < 2 * 2 * 4 * 4096) {
        const int e = gt & 4095, bh = (gt >> 12) & 7, dir = gt >> 15, h = bh & 3;
        const float cd = ex2(128.f * log2_sigmoid(a.in[C.z + 17][(L * 2 + dir) * 4 + h]));
        const size_t base = (size_t)((dir * 2 + (bh >> 2)) * 4 + h) * NCHUNK * 4096 + e;
        float st = 0.f;
        for (int t = 0; t < NCHUNK; ++t) { const int c = dir == 0 ? t : (t == 0 ? 1 : (t == 1 ? 0 : 67 - t));
            SIN[base + (size_t)c * 4096] = (bf16_t)f2bf(st); st = cd * st + KVT[base + (size_t)c * 4096]; }
    }
}
DI void ret_out_unit(const Params& a, const Ctx& C, int L, int cg, int h) {
    const bf16_t* P = WSP(bf16_t, WS_P); bf16_t* BR = WSP(bf16_t, WS_BR); const bf16_t* SIN = WSP(bf16_t, WS_SIN);
    const float l2f = log2_sigmoid(a.in[C.z + 17][(L * 2 + 0) * 4 + h]), l2b = log2_sigmoid(a.in[C.z + 17][(L * 2 + 1) * 4 + h]);
    const float* gn = a.in[C.z + 18] + (size_t)(L * 4 + h) * 64;
    LAS bf16_t* Qs = (LAS bf16_t*)C.lds;
    LAS bf16_t* Ks = Qs + 128 * 72;
    LAS bf16_t* VTs = Ks + 128 * 72;
    LAS bf16_t* Wd = VTs + 64 * 136;
    LAS bf16_t* SfT = Wd + 128 * 136;
    LAS bf16_t* SbT = SfT + 64 * 72;
    const int row0 = cg * 128, lane = C.lane, l15 = lane & 15, quad = lane >> 4; const int b = cg / NCHUNK, c = cg - b * NCHUNK;
#pragma unroll
    for (int it = 0; it < 2; ++it) { const int idx = C.tid + 512 * it, j = idx >> 3, ch = idx & 7; const bf16_t* pr = P + (size_t)(row0 + j) * INW + 64 * h + 8 * ch;
        *(LAS u32x4*)(Qs + j * 72 + 8 * ch) = *(const u32x4*)(pr + C_RQ); *(LAS u32x4*)(Ks + j * 72 + 8 * ch) = *(const u32x4*)(pr + C_RK);
        const u32x4 vv = *(const u32x4*)(pr + C_RV); const unsigned vw[4] = {vv.x, vv.y, vv.z, vv.w};
#pragma unroll
        for (int e = 0; e < 4; ++e) { VTs[(8 * ch + 2 * e) * 136 + j] = (bf16_t)(vw[e] & 0xffffu); VTs[(8 * ch + 2 * e + 1) * 136 + j] = (bf16_t)(vw[e] >> 16); } }
    { const int v = C.tid >> 3, ch = C.tid & 7;
      *(LAS u32x4*)(SfT + v * 72 + 8 * ch) = *(const u32x4*)(SIN + ((size_t)((0 * 2 + b) * 4 + h) * NCHUNK + c) * 4096 + v * 64 + 8 * ch);
      *(LAS u32x4*)(SbT + v * 72 + 8 * ch) = *(const u32x4*)(SIN + ((size_t)((1 * 2 + b) * 4 + h) * NCHUNK + c) * 4096 + v * 64 + 8 * ch); }
    __syncthreads();
    const int i0 = 16 * C.wave;
    { bf16x8 a[2];
#pragma unroll
      for (int ks = 0; ks < 2; ++ks) a[ks] = *(const LAS bf16x8*)(Qs + (i0 + l15) * 72 + 32 * ks + 8 * quad);
#pragma unroll
      for (int jt = 0; jt < 8; ++jt) { f32x4 acc = {0.f, 0.f, 0.f, 0.f};
#pragma unroll
          for (int ks = 0; ks < 2; ++ks) { const bf16x8 bb = *(const LAS bf16x8*)(Ks + (16 * jt + l15) * 72 + 32 * ks + 8 * quad); acc = MFMA16(a[ks], bb, acc); }
#pragma unroll
          for (int r = 0; r < 4; ++r) { const int i = i0 + quad * 4 + r, j = 16 * jt + l15, dl = i - j;
              const float f = dl >= 0 ? ex2((float)dl * l2f) : ex2((float)(-dl - 1) * l2b); Wd[i * 136 + j] = (bf16_t)f2bf(acc[r] * f); } } }
    __syncthreads();
    f32x4 oi[4], tf[4], tb[4];
#pragma unroll
    for (int vt = 0; vt < 4; ++vt) { oi[vt] = (f32x4){0.f, 0.f, 0.f, 0.f}; tf[vt] = oi[vt]; tb[vt] = oi[vt]; }
#pragma unroll
    for (int ks = 0; ks < 4; ++ks) { const bf16x8 a = *(const LAS bf16x8*)(Wd + (i0 + l15) * 136 + 32 * ks + 8 * quad);
#pragma unroll
        for (int vt = 0; vt < 4; ++vt) { const bf16x8 bb = *(const LAS bf16x8*)(VTs + (16 * vt + l15) * 136 + 32 * ks + 8 * quad); oi[vt] = MFMA16(a, bb, oi[vt]); } }
#pragma unroll
    for (int ks = 0; ks < 2; ++ks) { const bf16x8 a = *(const LAS bf16x8*)(Qs + (i0 + l15) * 72 + 32 * ks + 8 * quad);
#pragma unroll
        for (int vt = 0; vt < 4; ++vt) { const bf16x8 b1 = *(const LAS bf16x8*)(SfT + (16 * vt + l15) * 72 + 32 * ks + 8 * quad), b2 = *(const LAS bf16x8*)(SbT + (16 * vt + l15) * 72 + 32 * ks + 8 * quad);
            tf[vt] = MFMA16(a, b1, tf[vt]); tb[vt] = MFMA16(a, b2, tb[vt]); } }
#pragma unroll
    for (int r = 0; r < 4; ++r) { const int i = i0 + quad * 4 + r; const float qf = ex2((float)(i + 1) * l2f), qb = ex2((float)(127 - i) * l2b);
        float o[4]; float s = 0.f;
#pragma unroll
        for (int vt = 0; vt < 4; ++vt) { o[vt] = oi[vt][r] + qf * tf[vt][r] + qb * tb[vt][r]; s += o[vt]; }
        s += __shfl_xor(s, 1); s += __shfl_xor(s, 2); s += __shfl_xor(s, 4); s += __shfl_xor(s, 8);
        const float mean = s * (1.f / 64.f); float q2 = 0.f;
#pragma unroll
        for (int vt = 0; vt < 4; ++vt) { o[vt] -= mean; q2 += o[vt] * o[vt]; }
        q2 += __shfl_xor(q2, 1); q2 += __shfl_xor(q2, 2); q2 += __shfl_xor(q2, 4); q2 += __shfl_xor(q2, 8);
        const float rs = 1.f / sqrtf(q2 * (1.f / 64.f) + EPS);
#pragma unroll
        for (int vt = 0; vt < 4; ++vt) { const int v = 16 * vt + l15; const float gt = bf2f(P[(size_t)(row0 + i) * INW + C_RG + 64 * h + v]);
            BR[(size_t)(row0 + i) * DM + 768 + 64 * h + v] = (bf16_t)f2bf(o[vt] * rs * gn[v] * siluf_(gt)); } }
    __syncthreads();
}

DI void phase_mix(const Params& a, const Ctx& C, int L) {
    constexpr int N_CL = 256, N_BL = 256, N_BC = 8, N_CC = 8, N_A = 528, N_KV = 528;
    constexpr int NU = N_CL + N_BL + N_BC + N_CC + N_A + N_KV;
    for (int u = C.bid; u < NU; u += C.G) {
        int r = u;
        if (r < N_CL) { const int b = r >> 7, kvh = (r >> 6) & 1, n = r & 63; attn_unit(a, C, L, 1, b, kvh, b * TPB + CTXL + n * 128, TPB / 64, b * TPB, 0, 0, false, false); continue; } r -= N_CL;
        if (r < N_BL) { const int b = r >> 7, kvh = (r >> 6) & 1, n = r & 63; const int ls = (n > 0 ? n - 1 : 0) * 128, le = (n < 63 ? n + 2 : 64) * 128;
            attn_unit(a, C, L, 0, b, kvh, b * TPB + CTXL + n * 128, 4, b * TPB, (le - ls) / 64, b * TPB + CTXL + ls, true, true); continue; } r -= N_BL;
        if (r < N_BC) { const int b = r >> 2, kvh = (r >> 1) & 1, cb = r & 1; attn_unit(a, C, L, 0, b, kvh, b * TPB + cb * 128, 4, b * TPB, 0, 0, false, true); continue; } r -= N_BC;
        if (r < N_CC) { const int b = r >> 2, kvh = (r >> 1) & 1, cb = r & 1; attn_unit(a, C, L, 1, b, kvh, b * TPB + cb * 128, 4, b * TPB, 0, 0, false, false); continue; } r -= N_CC;
        if (r < N_A) { mixA_unit(a, C, L, r >> 2, r & 3); continue; } r -= N_A;
        ret_kv_unit(a, C, L, r >> 2, r & 3);
    }
}
DI void phase_ret_out(const Params& a, const Ctx& C, int L) { for (int u = C.bid; u < 528; u += C.G) ret_out_unit(a, C, L, u >> 2, u & 3); }

DI void phase_sum4(const Params& a, const Ctx& C) {
    const bf16_t* P = WSP(bf16_t, WS_P); bf16_t* A = WSP(bf16_t, WS_H);
    const int gt = C.bid * NTHREADS + C.tid, GT = C.G * NTHREADS;
    for (int i = gt; i < T * 128; i += GT) { const int r = i >> 7, c = (i & 127) * 8; const bf16_t* pr = P + (size_t)r * INW + C_GATE + c;
        float s[8];
#pragma unroll
        for (int e = 0; e < 8; ++e) s[e] = 0.f;
#pragma unroll
        for (int br = 0; br < 4; ++br) { const u32x4 v = *(const u32x4*)(pr + br * 1024); const unsigned w[4] = {v.x, v.y, v.z, v.w};
#pragma unroll
            for (int e = 0; e < 4; ++e) { s[2 * e] += __uint_as_float(w[e] << 16); s[2 * e + 1] += __uint_as_float(w[e] & 0xffff0000u); } }
        *(u32x4*)(A + (size_t)r * DM + c) = (u32x4){pk2(s[0], s[1]), pk2(s[2], s[3]), pk2(s[4], s[5]), pk2(s[6], s[7])}; }
}

DI void phase_gather(const Params& a, const Ctx& C, int L) {
    const unsigned* cnt = WSP(unsigned, WS_CTL) + CW_CNT + (L >> 1) * 8 * 64;
    int* rt_i = WSP(int, WS_ROUTE); float* rt_f = WSP(float, WS_ROUTE);
    const bf16_t* H = WSP(bf16_t, WS_H); bf16_t* HG = WSP(bf16_t, WS_HG);
    int base[NEXP + 1]; int cn[NEXP];
    { int acc = 0;
#pragma unroll
      for (int e = 0; e < NEXP; ++e) { cn[e] = (int)__hip_atomic_load(cnt + e * 64, __ATOMIC_RELAXED, __HIP_MEMORY_SCOPE_AGENT); base[e] = acc; acc += ((cn[e] + 255) >> 8) << 8; } base[NEXP] = acc; }
    if (C.bid == 0) {
        if (C.tid == 0) { rt_i[RT_META] = base[NEXP] >> 8; }
        for (int rt = C.tid; rt < (base[NEXP] >> 8); rt += NTHREADS) { int e = 0;
#pragma unroll
            for (int k = 1; k < NEXP; ++k) if (rt * 256 >= base[k]) e = k;
            rt_i[RT_META + 16 + rt] = e; }
#pragma unroll
        for (int e = 0; e < NEXP; ++e) for (int r = base[e] + cn[e] + C.tid; r < base[e + 1]; r += NTHREADS) rt_i[RT_ROWTOK + r] = -1;
    }
    const int gw = C.bid * NWAVES + C.wave, NGW = C.G * NWAVES;
    for (int t = gw; t < T; t += NGW) {
        const u32x4 h0 = *(const u32x4*)(H + (size_t)t * DM + 8 * C.lane), h1 = *(const u32x4*)(H + (size_t)t * DM + 512 + 8 * C.lane);
#pragma unroll
        for (int k = 0; k < 2; ++k) { const int e = rt_i[RT_E + 2 * t + k], pos = rt_i[RT_POS + 2 * t + k];
            int bs = 0;
#pragma unroll
            for (int q = 0; q < NEXP; ++q) if (q == e) bs = base[q];
            const int row = bs + pos;
            *(u32x4*)(HG + (size_t)row * DM + 8 * C.lane) = h0; *(u32x4*)(HG + (size_t)row * DM + 512 + 8 * C.lane) = h1;
            if (C.lane == 0) { rt_i[RT_ROWTOK + row] = t; rt_f[RT_ROWP + row] = rt_f[RT_PW + 2 * t + k]; } }
    }
}

DI void phase_combine(const Params& a, const Ctx& C, int L) {
    const unsigned* cnt = WSP(unsigned, WS_CTL) + CW_CNT + (L >> 1) * 8 * 64;
    const int* rt_i = WSP(int, WS_ROUTE); const bf16_t* Y = WSP(bf16_t, WS_HG);
    const float* mod = WSP(float, WS_MOD) + (size_t)L * 3 * 6144 + 5 * DM;
    int base[NEXP];
    { int acc = 0;
#pragma unroll
      for (int e = 0; e < NEXP; ++e) { const int cn = (int)__hip_atomic_load(cnt + e * 64, __ATOMIC_RELAXED, __HIP_MEMORY_SCOPE_AGENT); base[e] = acc; acc += ((cn + 255) >> 8) << 8; } }
    const int gw = C.bid * NWAVES + C.wave, NGW = C.G * NWAVES;
    for (int t = gw; t < T; t += NGW) {
        int row[2];
#pragma unroll
        for (int k = 0; k < 2; ++k) { const int e = rt_i[RT_E + 2 * t + k], pos = rt_i[RT_POS + 2 * t + k]; int bs = 0;
#pragma unroll
            for (int q = 0; q < NEXP; ++q) if (q == e) bs = base[q];
            row[k] = bs + pos; }
        float* xr = xrow(C.out, WSP(float, WS_CTXB), t); const float* gt = mod + (size_t)modrow(t) * 6144;
#pragma unroll
        for (int hf = 0; hf < 2; ++hf) { const int c = hf * 512 + 8 * C.lane;
            const u32x4 y0 = *(const u32x4*)(Y + (size_t)row[0] * DM + c), y1 = *(const u32x4*)(Y + (size_t)row[1] * DM + c);
            const unsigned w0[4] = {y0.x, y0.y, y0.z, y0.w}, w1[4] = {y1.x, y1.y, y1.z, y1.w};
#pragma unroll
            for (int q = 0; q < 2; ++q) { const f32x4 g = *(const f32x4*)(gt + c + 4 * q); f32x4 x = *(const f32x4*)(xr + c + 4 * q);
                x[0] += g[0] * (__uint_as_float(w0[2 * q] << 16) + __uint_as_float(w1[2 * q] << 16));
                x[1] += g[1] * (__uint_as_float(w0[2 * q] & 0xffff0000u) + __uint_as_float(w1[2 * q] & 0xffff0000u));
                x[2] += g[2] * (__uint_as_float(w0[2 * q + 1] << 16) + __uint_as_float(w1[2 * q + 1] << 16));
                x[3] += g[3] * (__uint_as_float(w0[2 * q + 1] & 0xffff0000u) + __uint_as_float(w1[2 * q + 1] & 0xffff0000u));
                *(f32x4*)(xr + c + 4 * q) = x; } }
    }
}

constexpr int PH_PER_LAYER = 15;
#define PHASE_CTX() Ctx C; { int z_ = 0; asm volatile("s_mov_b32 %0, 0" : "=s"(z_)); C.z = z_; C.lds = (LAS unsigned char*)lds_raw; { int t_ = threadIdx.x; asm volatile("" : "+v"(t_)); C.tid = t_; } C.lane = C.tid & 63; \
    C.wave = __builtin_amdgcn_readfirstlane(C.tid >> 6); C.G = gridDim.x; C.bid = blockIdx.x; C.out = a.out + z_; C.ws = a.ws + z_; }
template <int PHMASK, bool FUSED>
__global__ void __launch_bounds__(NTHREADS, 2) mixer_fwd(Params a) {
    extern __shared__ __attribute__((aligned(16))) unsigned char lds_raw[];
    volatile LAS unsigned* MISC = (volatile LAS unsigned*)((LAS unsigned char*)lds_raw + MISC_OFF);
    if (threadIdx.x < 32) MISC[threadIdx.x] = 0u;
    __syncthreads();
    XcdBarrier bar; bar.bar = (unsigned*)(a.ws + WS_CTL) + CW_BAR; bar.x = 0; bar.st = nullptr;
    if (FUSED) bar = xcd_barrier_post((unsigned*)(a.ws + WS_CTL) + CW_BAR, MISC + 8);
#define SEAM() do { if (FUSED) xcd_barrier(bar); } while (0)
#ifndef PHASE_MASK
#define PHASE_MASK 0xffff
#endif
#define RUN(k) ((((PHASE_MASK) & (PHMASK)) >> (k)) & 1)

    if (a.l_lo == 0 && RUN(0)) { PHASE_CTX(); phase_g0(a, C); SEAM(); }
    for (int L = a.l_lo; L < a.l_hi; ++L) {
        const bool moe = L & 1;
        if (RUN(1)) { PHASE_CTX(); phase_cvt(a, C, L); phase_norm(a, C, L, 0, L == 0 ? a.in[C.z + 0] : C.out, L == 0 ? a.in[C.z + 2] : WSP(float, WS_CTXB)); __syncthreads(); SEAM(); }
        if (RUN(2)) { PHASE_CTX(); pg8::Gemm g{WSP(bf16_t, WS_H), WSP(bf16_t, WS_W + W_IN), DM, DM, DM}; pg8::StaticOrder S; S.init(T, INW, C.G, C.bid); pg8::EpiIn E{WSP(bf16_t, WS_P)};
            pg8::gemm_phase(C.lds, C.tid, g, S, E); SEAM(); }
        if (RUN(3)) { PHASE_CTX(); phase_prep(a, C, L); __syncthreads(); SEAM(); }
        if (RUN(4)) { PHASE_CTX(); phase_mix(a, C, L); __syncthreads(); SEAM(); }
        if (RUN(5)) { PHASE_CTX(); phase_ret_scan(a, C, L); SEAM(); }
        if (RUN(6)) { PHASE_CTX(); phase_ret_out(a, C, L); SEAM(); }
        if (RUN(7)) { PHASE_CTX(); pg8::Gemm g{WSP(bf16_t, WS_BR), WSP(bf16_t, WS_W + W_BR), DM, 256, 256}; pg8::MergeOrder S; S.init(T, 4096, C.G, C.bid); pg8::EpiMerge E{WSP(bf16_t, WS_P)};
            pg8::gemm_phase(C.lds, C.tid, g, S, E); SEAM(); }
        if (RUN(8)) { PHASE_CTX(); phase_sum4(a, C); SEAM(); }
        if (RUN(9)) { PHASE_CTX(); pg8::Gemm g{WSP(bf16_t, WS_H), WSP(bf16_t, WS_W + W_OUT), DM, DM, DM}; pg8::StaticOrder S; S.init(T, DM, C.G, C.bid);
            pg8::EpiResid E{L == 0 ? a.in[C.z + 0] : C.out, L == 0 ? a.in[C.z + 2] : WSP(float, WS_CTXB), C.out, WSP(float, WS_CTXB), WSP(float, WS_MOD) + (size_t)L * 3 * 6144 + 2 * DM};
            pg8::gemm_phase(C.lds, C.tid, g, S, E); SEAM(); }
        if (RUN(10)) { PHASE_CTX(); phase_norm(a, C, L, 1, C.out, WSP(float, WS_CTXB)); SEAM(); }
        if (!moe) {
            if (RUN(11)) { PHASE_CTX(); pg8::Gemm g{WSP(bf16_t, WS_H), WSP(bf16_t, WS_W + W_13), DM, DM, DM}; pg8::StaticOrder S; S.init(T, 2 * DFF, C.G, C.bid); pg8::EpiSwiglu E{WSP(bf16_t, WS_P), DFF, 1 << 20};
                pg8::gemm_phase(C.lds, C.tid, g, S, E); SEAM(); }
            if (RUN(12)) { PHASE_CTX(); pg8::Gemm g{WSP(bf16_t, WS_P), WSP(bf16_t, WS_W + W_2), DFF, DFF, DFF}; pg8::StaticOrder S; S.init(T, DM, C.G, C.bid);
                pg8::EpiResid E{C.out, WSP(float, WS_CTXB), C.out, WSP(float, WS_CTXB), WSP(float, WS_MOD) + (size_t)L * 3 * 6144 + 5 * DM};
                pg8::gemm_phase(C.lds, C.tid, g, S, E); SEAM(); }
        } else {
            if (RUN(11)) { PHASE_CTX(); phase_gather(a, C, L); SEAM(); }
            if (RUN(12)) { PHASE_CTX(); pg8::Gemm g{WSP(bf16_t, WS_HG), WSP(bf16_t, WS_W + W_13), DM, DM, DM}; pg8::MoeOrder S{WSP(int, WS_ROUTE) + RT_META, 14, C.G, C.bid}; pg8::EpiSwiglu E{WSP(bf16_t, WS_HIDM), DFE, 14};
                pg8::gemm_phase(C.lds, C.tid, g, S, E); SEAM(); }
            if (RUN(13)) { PHASE_CTX(); pg8::Gemm g{WSP(bf16_t, WS_HIDM), WSP(bf16_t, WS_W + W_2), DFE, DFE, DFE}; pg8::MoeOrder S{WSP(int, WS_ROUTE) + RT_META, 4, C.G, C.bid};
                pg8::EpiMoe2 E{WSP(bf16_t, WS_HG), WSP(float, WS_ROUTE) + RT_ROWP, 4};
                pg8::gemm_phase(C.lds, C.tid, g, S, E); SEAM(); }
            if (RUN(14)) { PHASE_CTX(); phase_combine(a, C, L); SEAM(); }
        }
    }
#undef SEAM
#undef RUN
}

typedef void (*kern_t)(Params);
template <int PH> static kern_t phase_kernel() { return mixer_fwd<(1 << PH), false>; }
static kern_t get_kernel(int ph) {
    switch (ph) {
        case 0: return phase_kernel<0>(); case 1: return phase_kernel<1>(); case 2: return phase_kernel<2>(); case 3: return phase_kernel<3>(); case 4: return phase_kernel<4>();
        case 5: return phase_kernel<5>(); case 6: return phase_kernel<6>(); case 7: return phase_kernel<7>(); case 8: return phase_kernel<8>(); case 9: return phase_kernel<9>();
        case 10: return phase_kernel<10>(); case 11: return phase_kernel<11>(); case 12: return phase_kernel<12>(); case 13: return phase_kernel<13>(); default: return phase_kernel<14>();
    }
}
extern "C" void kernel_launch(void* const* d_in, const int* in_sizes, int n_in, void* d_out, int out_size, void* d_ws, size_t ws_size, hipStream_t stream) {
    static int grid = 0;
    if (grid == 0) {
        if (n_in != 29 || out_size != NBATCH * SEQ * DM || ws_size < WS_END) { fprintf(stderr, "kernel_launch: unexpected shapes (n_in %d, out %d, ws %zu < %zu)\n", n_in, out_size, ws_size, (size_t)WS_END); grid = -1; return; }
        int dev = 0, cus = 0;
        if (hipGetDevice(&dev) != hipSuccess || hipDeviceGetAttribute(&cus, hipDeviceAttributeMultiprocessorCount, dev) != hipSuccess) { grid = -1; return; }
#if MK_FUSED
        if (hipFuncSetAttribute((const void*)mixer_fwd<0x7fff, true>, hipFuncAttributeMaxDynamicSharedMemorySize, LDS_BYTES) != hipSuccess) { grid = -1; return; }
#else
        for (int ph = 0; ph < PH_PER_LAYER; ++ph) if (hipFuncSetAttribute((const void*)get_kernel(ph), hipFuncAttributeMaxDynamicSharedMemorySize, LDS_BYTES) != hipSuccess) { grid = -1; return; }
#endif
        (void)hipGetLastError();
        grid = cus;
    }
    if (grid < 0) return;
    (void)hipMemsetAsync((char*)d_ws + WS_CTL, 0, CTL_ZERO_BYTES, stream);
    Params p{};
    for (int i = 0; i < 29; ++i) p.in[i] = (const float*)d_in[i];
    p.out = (float*)d_out; p.ws = (unsigned char*)d_ws; p.pad = 0; p.ph_lo = 0; p.ph_hi = 0;
#if MK_FUSED
    p.l_lo = 0; p.l_hi = DEPTH; p.fused = 1;
    hipLaunchKernelGGL((mixer_fwd<0x7fff, true>), dim3(grid), dim3(NTHREADS), LDS_BYTES, stream, p);
#else
    p.fused = 0; p.l_lo = 0; p.l_hi = 1;
    hipLaunchKernelGGL(get_kernel(0), dim3(grid), dim3(NTHREADS), LDS_BYTES, stream, p);
#ifndef NL_RUN
#define NL_RUN DEPTH
#endif
    for (int L = 0; L < NL_RUN; ++L)
        for (int ph = 1; ph < PH_PER_LAYER; ++ph) {
            if (!(L & 1) && ph >= 13) continue;
            p.l_lo = L; p.l_hi = L + 1;
            hipLaunchKernelGGL(get_kernel(ph), dim3(grid), dim3(NTHREADS), LDS_BYTES, stream, p);
        }
#endif
}
```

```cpp
#include <hip/hip_runtime.h>
#include <cstdio>
#include <cstdint>

#ifndef MK_FUSED
#define MK_FUSED 1
#endif

#define DI __device__ __forceinline__
#define LAS __attribute__((address_space(3)))
#define GAS __attribute__((address_space(1)))
typedef unsigned short bf16_t;
typedef short bf16x8 __attribute__((ext_vector_type(8)));
typedef short s16x4 __attribute__((ext_vector_type(4)));
typedef float f32x4 __attribute__((ext_vector_type(4)));
typedef float f32x2 __attribute__((ext_vector_type(2)));
typedef float f32x16 __attribute__((ext_vector_type(16)));
typedef unsigned u32x4 __attribute__((ext_vector_type(4)));
typedef unsigned u32x2 __attribute__((ext_vector_type(2)));

constexpr int DM = 1024, NBATCH = 2, SEQ = 8192, CTXL = 256, TPB = SEQ + CTXL, T = NBATCH * TPB, DEPTH = 4;
constexpr int INW = 6656, DFF = 2816, NEXP = 8, DFE = 1792;
constexpr int C_U = 0, C_V = 256, C_WQ = 512, C_WK = 768, C_WV = 896, C_GQ = 1024, C_GK = 1280, C_GV = 1408, C_RQ = 1536, C_RK = 1792, C_RV = 2048, C_RG = 2304, C_GATE = 2560;
constexpr int NCHUNK = TPB / 128;
constexpr int NTILE_M = T / 256;
constexpr int MOE_ROWS = 2 * T + NEXP * 256;
constexpr float EPS = 1e-6f;
constexpr float LOG2E = 1.4426950408889634f;
constexpr float QSCALE = 0.125f * LOG2E;

constexpr size_t MiB = 1u << 20;
constexpr size_t WS_CTL = 0, CTL_ZERO_BYTES = 1 * MiB;
constexpr size_t WS_MOD = 1 * MiB;
constexpr size_t WS_L2G = 1 * MiB + 512 * 1024;
constexpr size_t WS_TAB = 2 * MiB;
constexpr size_t TAB_AXC = 0, TAB_AXS = 8192 * 32 * 4, TAB_SQC = 2 * 8192 * 32 * 4, TAB_SQS = TAB_SQC + 8448 * 32 * 4;
constexpr size_t WS_WSB = 7 * MiB;
constexpr size_t WS_CTXB = 8 * MiB;
constexpr size_t WS_ROUTE = 10 * MiB;
constexpr size_t WS_VT = 12 * MiB;
constexpr size_t WS_KVT = 21 * MiB;
constexpr size_t WS_SIN = 38 * MiB;
constexpr size_t WS_H = 47 * MiB;
constexpr size_t WS_BR = 80 * MiB;
constexpr size_t WS_P = 113 * MiB;
constexpr size_t WS_HG = WS_P, WS_HIDM = WS_P + 70 * MiB;
constexpr size_t WS_W = 328 * MiB;
constexpr size_t W_IN = 0, W_BR = 13 * MiB, W_OUT = 15 * MiB, W_13 = 17 * MiB, W_2 = 73 * MiB;
constexpr size_t WS_END = WS_W + 101 * MiB;
static_assert((size_t)T * INW * 2 <= 215 * MiB && WS_P + 215 * MiB <= WS_W, "P fits");
static_assert((size_t)MOE_ROWS * 1024 * 2 <= 70 * MiB && (size_t)MOE_ROWS * DFE * 2 + 70 * MiB <= 215 * MiB, "moe overlay fits");
constexpr int RT_E = 0;
constexpr int RT_POS = 2 * T;
constexpr int RT_PW = 4 * T;
constexpr int RT_ROWTOK = 6 * T;
constexpr int RT_ROWP = RT_ROWTOK + MOE_ROWS;
constexpr int RT_META = RT_ROWP + MOE_ROWS;
static_assert((size_t)(RT_META + 256) * 4 <= 2 * MiB, "route fits");
constexpr int CW_BAR = 4096;
constexpr int CW_CNT = 16384;

DI float bf2f(unsigned short h) { return __uint_as_float((unsigned)h << 16); }
DI unsigned f2bf(float f) { unsigned u = __float_as_uint(f); return (u + 0x7fffu + ((u >> 16) & 1u)) >> 16; }
DI unsigned pk2(float lo, float hi) { return f2bf(lo) | (f2bf(hi) << 16); }
DI float ex2(float x) { return __builtin_amdgcn_exp2f(x); }
DI float rcpf_(float x) { return __builtin_amdgcn_rcpf(x); }
DI float sigm(float x) { return rcpf_(1.f + ex2(-x * LOG2E)); }
DI float siluf_(float x) { return x * sigm(x); }
DI float gelu_tanh(float x) { const float u = 0.7978845608f * (x + 0.044715f * x * x * x); return x * sigm(2.f * u); }
DI float wave_sum(float v) {
#pragma unroll
    for (int o = 1; o < 64; o <<= 1) v += __shfl_xor(v, o);
    return v;
}
DI int crow(int r, int hi) { return (r & 3) + 8 * (r >> 2) + 4 * hi; }
#define MFMA16(a, b, c) __builtin_amdgcn_mfma_f32_16x16x32_bf16((a), (b), (c), 0, 0, 0)
#define MFMA32(a, b, c) __builtin_amdgcn_mfma_f32_32x32x16_bf16((a), (b), (c), 0, 0, 0)

struct Params {
    const float* in[29];
    float* out; unsigned char* ws;
    int l_lo, l_hi, ph_lo, ph_hi, fused, pad;
};
DI const float* xrow_c(const float* lat, const float* ctx, int r) { const int b = r / TPB, p = r - b * TPB; return p < CTXL ? ctx + (size_t)(b * CTXL + p) * DM : lat + (size_t)(b * SEQ + p - CTXL) * DM; }
DI float* xrow(float* lat, float* ctx, int r) { const int b = r / TPB, p = r - b * TPB; return p < CTXL ? ctx + (size_t)(b * CTXL + p) * DM : lat + (size_t)(b * SEQ + p - CTXL) * DM; }
DI int modrow(int r) { const int b = r / TPB, p = r - b * TPB; return p < CTXL ? 2 : b; }

namespace pg8 {
constexpr int BM = 256, BK = 64, HALF = 128, HTB = HALF * BK * 2, STAGE_BYTES = 8 * HTB, NXCD = 8, WGM = 8;
DI int lds_byte(int r, int c) { const int st = (r >> 4) * 2 + (c >> 5), rr = r & 15, cc = c & 31, ob = rr * 64 + cc * 2; return st * 1024 + (ob ^ (((ob >> 9) & 1) << 5)); }
DI void stage_rc(int b, int& R, int& C) { const int st = b / 1024, sb = b % 1024, swz = sb ^ (((sb >> 9) & 1) << 5); R = (st >> 1) * 16 + swz / 64; C = (st & 1) * 32 + (swz % 64) / 2; }
DI int perm32(int rho) { const int n = rho >> 4, i = rho & 15; return 8 * (i >> 2) + 4 * n + (i & 3); }
struct Unit { int pm, pn; int aoff; };
struct Gemm { const bf16_t* A; const bf16_t* Bt; int lda, ldb, K; };

struct StaticOrder {
    int nM, nN, nwg, G, c;
    DI void init(int M, int N, int G_, int c_) { nM = M / BM; nN = N / BM; nwg = nM * nN; G = G_; c = c_; }
    DI bool next(int i, Unit& u) const {
        const long L = (long)i * G + c; if (L >= nwg) return false;
        int wgid = (int)L; { const int q = nwg / NXCD, r = nwg % NXCD, xcd = wgid % NXCD, off = wgid / NXCD; wgid = (xcd < r ? xcd * (q + 1) : r * (q + 1) + (xcd - r) * q) + off; }
        const int nig = WGM * nN, gid = wgid / nig, fm = gid * WGM, gsz = (nM - fm) < WGM ? (nM - fm) : WGM;
        u.pm = fm + ((wgid % nig) % gsz); u.pn = (wgid % nig) / gsz; u.aoff = 0; return true;
    }
};
struct MergeOrder : StaticOrder {
    DI bool next(int i, Unit& u) const { if (!StaticOrder::next(i, u)) return false; u.aoff = (u.pn >> 2) * 256 * 2; return true; }
};
struct MoeOrder {
    const int* meta; int nNl, G, c;
    DI bool next(int i, Unit& u) const {
        const int nrt = meta[0]; const long L = (long)i * G + c; if (L >= (long)nrt * nNl) return false;
        const int pm = (int)(L / nNl), pl = (int)(L % nNl); u.pm = pm; u.pn = meta[16 + pm] * nNl + pl; u.aoff = 0; return true;
    }
};

DI unsigned cvt_pk_bf16(float lo, float hi) { unsigned r; asm volatile("v_cvt_pk_bf16_f32 %0, %1, %2" : "=v"(r) : "v"(lo), "v"(hi)); return r; }

struct EpiIn {
    static constexpr bool PERM = true;
    bf16_t* O;
    DI void operator()(const f32x4 (&acc)[2][2][4][2], const Unit& u, int wr, int wc, int fr, int fq) const {
        const int row0 = u.pm * BM + wr * 64 + fr, col0 = u.pn * BM + wc * 32 + 8 * fq; const bool g = u.pn < 2;
#pragma unroll
        for (int ai = 0; ai < 2; ++ai)
#pragma unroll
            for (int m = 0; m < 4; ++m) { bf16_t* rowp = O + (size_t)(row0 + ai * HALF + m * 16) * INW + col0;
#pragma unroll
                for (int bj = 0; bj < 2; ++bj) { f32x4 v0 = acc[ai][bj][m][0], v1 = acc[ai][bj][m][1];
                    if (g) {
#pragma unroll
                        for (int e = 0; e < 4; ++e) { v0[e] = gelu_tanh(v0[e]); v1[e] = gelu_tanh(v1[e]); } }
                    u32x4 w; w.x = cvt_pk_bf16(v0[0], v0[1]); w.y = cvt_pk_bf16(v0[2], v0[3]); w.z = cvt_pk_bf16(v1[0], v1[1]); w.w = cvt_pk_bf16(v1[2], v1[3]);
                    *(u32x4*)(rowp + bj * HALF) = w; }
                asm volatile("" ::: "memory"); }
    }
};
struct EpiMerge {
    static constexpr bool PERM = true;
    bf16_t* P;
    DI void operator()(const f32x4 (&acc)[2][2][4][2], const Unit& u, int wr, int wc, int fr, int fq) const {
        const int row0 = u.pm * BM + wr * 64 + fr, col0 = C_GATE + u.pn * BM + wc * 32 + 8 * fq;
#pragma unroll
        for (int ai = 0; ai < 2; ++ai)
#pragma unroll
            for (int m = 0; m < 4; ++m) { bf16_t* rowp = P + (size_t)(row0 + ai * HALF + m * 16) * INW + col0;
#pragma unroll
                for (int bj = 0; bj < 2; ++bj)
#pragma unroll
                    for (int n = 0; n < 2; ++n) { const f32x4 v = acc[ai][bj][m][n];
                        const u32x2 gt = *(const u32x2*)(rowp + bj * HALF + 4 * n);
                        u32x2 w; w.x = cvt_pk_bf16(sigm(__uint_as_float(gt.x << 16)) * v[0], sigm(__uint_as_float(gt.x & 0xffff0000u)) * v[1]);
                        w.y = cvt_pk_bf16(sigm(__uint_as_float(gt.y << 16)) * v[2], sigm(__uint_as_float(gt.y & 0xffff0000u)) * v[3]);
                        *(u32x2*)(rowp + bj * HALF + 4 * n) = w; asm volatile("" ::: "memory"); }
                }
    }
};
struct EpiResid {
    static constexpr bool PERM = false;
    const float* baseLat; const float* baseCtx; float* outLat; float* outCtx; const float* gate;
    DI void operator()(const f32x4 (&acc)[2][2][4][2], const Unit& u, int wr, int wc, int fr, int fq) const {
        const int b = u.pm / 33, j = u.pm - b * 33;
        const float* bs = j == 0 ? baseCtx + (size_t)b * CTXL * DM : baseLat + (size_t)(b * SEQ + (j - 1) * 256) * DM;
        float* os = j == 0 ? outCtx + (size_t)b * CTXL * DM : outLat + (size_t)(b * SEQ + (j - 1) * 256) * DM;
        const float* gt = gate + (size_t)(j == 0 ? 2 : b) * 6144;
        const int col0 = u.pn * BM + wc * 32 + 4 * fq, r0 = wr * 64 + fr;
        f32x4 gv[2][2];
#pragma unroll
        for (int bj = 0; bj < 2; ++bj)
#pragma unroll
            for (int n = 0; n < 2; ++n) gv[bj][n] = *(const f32x4*)(gt + col0 + bj * HALF + n * 16);
#pragma unroll
        for (int ai = 0; ai < 2; ++ai)
#pragma unroll
            for (int m = 0; m < 4; ++m) { const size_t off = (size_t)(r0 + ai * HALF + m * 16) * DM + col0;
#pragma unroll
                for (int bj = 0; bj < 2; ++bj)
#pragma unroll
                    for (int n = 0; n < 2; ++n) { const f32x4 x = *(const f32x4*)(bs + off + bj * HALF + n * 16); *(f32x4*)(os + off + bj * HALF + n * 16) = x + gv[bj][n] * acc[ai][bj][m][n]; }
                asm volatile("" ::: "memory"); }
    }
};
struct EpiSwiglu {
    static constexpr bool PERM = true;
    bf16_t* O; int ldo; int nNl;
    DI void operator()(const f32x4 (&acc)[2][2][4][2], const Unit& u, int wr, int wc, int fr, int fq) const {
        const int row0 = u.pm * BM + wr * 64 + fr, col0 = (u.pn % nNl) * HALF + wc * 32 + 8 * fq;
#pragma unroll
        for (int ai = 0; ai < 2; ++ai)
#pragma unroll
            for (int m = 0; m < 4; ++m) { bf16_t* rowp = O + (size_t)(row0 + ai * HALF + m * 16) * ldo + col0;
                const f32x4 a0 = acc[ai][0][m][0], a1 = acc[ai][0][m][1], b0 = acc[ai][1][m][0], b1 = acc[ai][1][m][1];
                u32x4 w; w.x = cvt_pk_bf16(siluf_(a0[0]) * b0[0], siluf_(a0[1]) * b0[1]); w.y = cvt_pk_bf16(siluf_(a0[2]) * b0[2], siluf_(a0[3]) * b0[3]);
                w.z = cvt_pk_bf16(siluf_(a1[0]) * b1[0], siluf_(a1[1]) * b1[1]); w.w = cvt_pk_bf16(siluf_(a1[2]) * b1[2], siluf_(a1[3]) * b1[3]);
                *(u32x4*)rowp = w; asm volatile("" ::: "memory"); }
    }
};
struct EpiMoe2 {
    static constexpr bool PERM = true;
    bf16_t* Y; const float* rowp; int nNl;
    DI void operator()(const f32x4 (&acc)[2][2][4][2], const Unit& u, int wr, int wc, int fr, int fq) const {
        const int col0 = (u.pn % nNl) * BM + wc * 32 + 8 * fq, r0 = u.pm * BM + wr * 64 + fr;
#pragma unroll
        for (int ai = 0; ai < 2; ++ai)
#pragma unroll
            for (int m = 0; m < 4; ++m) { const int r = r0 + ai * HALF + m * 16; const float pw = rowp[r]; bf16_t* rowq = Y + (size_t)r * DM + col0;
#pragma unroll
                for (int bj = 0; bj < 2; ++bj) { const f32x4 v0 = acc[ai][bj][m][0] * pw, v1 = acc[ai][bj][m][1] * pw;
                    u32x4 w; w.x = cvt_pk_bf16(v0[0], v0[1]); w.y = cvt_pk_bf16(v0[2], v0[3]); w.z = cvt_pk_bf16(v1[0], v1[1]); w.w = cvt_pk_bf16(v1[2], v1[3]);
                    *(u32x4*)(rowq + bj * HALF) = w; }
                asm volatile("" ::: "memory"); }
    }
};

template <class Epi, class Sched>
DI void gemm_phase(LAS unsigned char* lds, const int tid, const Gemm g, const Sched& S, const Epi& E) {
    constexpr bool SP2 = true, ALIGN_EPI = true;
    const int wid = __builtin_amdgcn_readfirstlane(tid >> 6), lane = tid & 63, wr = wid >> 2, wc = wid & 3, fr = lane & 15, fq = lane >> 4;
    const int K = g.K, nt = K / BK;
    unsigned voffA[2], voffB[2];
#pragma unroll
    for (int i = 0; i < 2; ++i) { int R, C; stage_rc(tid * 16 + i * 8192, R, C); const int Rb = Epi::PERM ? ((R & ~31) + perm32(R & 31)) : R;
        voffA[i] = (unsigned)(R * g.lda + C) * 2u; voffB[i] = (unsigned)(Rb * g.ldb + C) * 2u; }
    const size_t kstep = (size_t)(BK * 2);
    const size_t hstepA = (size_t)HALF * g.lda * 2, hstepB = (size_t)HALF * g.ldb * 2;
    const size_t tstepA = 2 * hstepA, tstepB = 2 * hstepB;
    const unsigned ldsw = (unsigned)wid * 1024u;
    const int aoff = lds_byte(wr * 64 + fr, fq * 8), boff = lds_byte(wc * 32 + fr, fq * 8);
#define PG8_SA(b, h) (((b) * 2 + (h)) * HTB)
#define PG8_SB(b, h) ((4 + (b) * 2 + (h)) * HTB)
#define PG8_STAGE(bufoff, gbase, voff) do { _Pragma("unroll") for (int _i = 0; _i < 2; ++_i) \
        __builtin_amdgcn_global_load_lds((const unsigned*)((const char*)(gbase) + (voff)[_i]), (LAS unsigned*)(lds + (bufoff) + ldsw + _i * 8192), 16, 0, 0); } while (0)
#define PG8_LDA(dst, b, h) do { _Pragma("unroll") for (int m = 0; m < 4; ++m) _Pragma("unroll") for (int k = 0; k < 2; ++k) dst[m][k] = *(const LAS bf16x8*)(lds + PG8_SA(b, h) + aoff + m * 2048 + k * 1024); } while (0)
#define PG8_LDB(dst, b, h) do { _Pragma("unroll") for (int n = 0; n < 2; ++n) _Pragma("unroll") for (int k = 0; k < 2; ++k) dst[n][k] = *(const LAS bf16x8*)(lds + PG8_SB(b, h) + boff + n * 2048 + k * 1024); } while (0)
#define PG8_MMA(ai, bj, At, Bt) do { __builtin_amdgcn_s_setprio(1); _Pragma("unroll") for (int m = 0; m < 4; ++m) _Pragma("unroll") for (int n = 0; n < 2; ++n) _Pragma("unroll") for (int k = 0; k < 2; ++k) \
        acc[ai][bj][m][n] = __builtin_amdgcn_mfma_f32_16x16x32_bf16(Bt[n][k], At[m][k], acc[ai][bj][m][n], 0, 0, 0); __builtin_amdgcn_s_setprio(0); } while (0)
#define PG8_WAIT_V(n) asm volatile("s_waitcnt vmcnt(" #n ")" ::: "memory")
#define PG8_WAIT_L(n) asm volatile("s_waitcnt lgkmcnt(" #n ")" ::: "memory")
#define PG8_BAR __builtin_amdgcn_s_barrier()
#define PG8_SCHED __builtin_amdgcn_sched_barrier(0)
    Unit cur, nxt; int ui = 0;
    if (!S.next(0, cur)) return;
    f32x4 acc[2][2][4][2];
#pragma unroll
    for (int a = 0; a < 2; ++a)
#pragma unroll
        for (int b = 0; b < 2; ++b)
#pragma unroll
            for (int m = 0; m < 4; ++m)
#pragma unroll
                for (int n = 0; n < 2; ++n) acc[a][b][m][n] = (f32x4){0.f, 0.f, 0.f, 0.f};
    bf16x8 At[4][2], B0[2][2], B1[2][2];
    const char* cA = (const char*)g.A + (size_t)cur.pm * tstepA + cur.aoff; const char* cB = (const char*)g.Bt + (size_t)cur.pn * tstepB;
    PG8_STAGE(PG8_SB(0, 0), cB, voffB); PG8_STAGE(PG8_SB(0, 1), cB + hstepB, voffB); PG8_STAGE(PG8_SA(0, 0), cA, voffA); PG8_STAGE(PG8_SA(0, 1), cA + hstepA, voffA);
    if (wr == 1) PG8_BAR;
    PG8_WAIT_V(2); PG8_BAR;
    PG8_STAGE(PG8_SB(1, 0), cB + kstep, voffB); PG8_STAGE(PG8_SA(1, 0), cA + kstep, voffA); PG8_STAGE(PG8_SB(1, 1), cB + hstepB + kstep, voffB);
    PG8_WAIT_V(6); PG8_BAR;
    for (;;) {
        const bool has_next = S.next(ui + 1, nxt);
        const char* nA = has_next ? (const char*)g.A + (size_t)nxt.pm * tstepA + nxt.aoff : cA; const char* nB = has_next ? (const char*)g.Bt + (size_t)nxt.pn * tstepB : cB;
        for (int t = 0; t < nt; t += 2) {
            const bool last = (t == nt - 2);
            const char* a1 = cA + (size_t)(t + 1) * kstep;
            const char* a2 = last ? nA : cA + (size_t)(t + 2) * kstep; const char* b2 = last ? nB : cB + (size_t)(t + 2) * kstep;
            const char* a3 = a2 + kstep; const char* b3 = b2 + kstep;
            PG8_LDB(B0, 0, 0); PG8_LDB(B1, 0, 1); PG8_SCHED; PG8_LDA(At, 0, 0); PG8_STAGE(PG8_SA(1, 1), a1 + hstepA, voffA);
            PG8_WAIT_V(8); PG8_WAIT_L(0); PG8_BAR; PG8_MMA(0, 0, At, B0); PG8_MMA(0, 1, At, B1); PG8_BAR; PG8_SCHED;
            PG8_LDA(At, 0, 1); PG8_STAGE(PG8_SB(0, 0), b2, voffB); PG8_STAGE(PG8_SB(0, 1), b2 + hstepB, voffB); PG8_STAGE(PG8_SA(0, 0), a2, voffA);
            PG8_WAIT_V(8); PG8_WAIT_L(0); PG8_BAR; PG8_MMA(1, 0, At, B0); PG8_MMA(1, 1, At, B1); PG8_BAR; PG8_SCHED;
            PG8_LDB(B0, 1, 0); PG8_LDB(B1, 1, 1); PG8_SCHED; PG8_LDA(At, 1, 0); PG8_STAGE(PG8_SA(0, 1), a2 + hstepA, voffA);
            PG8_WAIT_V(8); PG8_WAIT_L(0); PG8_BAR; PG8_MMA(0, 0, At, B0); PG8_MMA(0, 1, At, B1); PG8_BAR; PG8_SCHED;
            PG8_LDA(At, 1, 1); PG8_STAGE(PG8_SB(1, 0), b3, voffB); PG8_STAGE(PG8_SB(1, 1), b3 + hstepB, voffB); PG8_STAGE(PG8_SA(1, 0), a3, voffA);
            PG8_WAIT_V(8); PG8_WAIT_L(0); PG8_BAR; PG8_MMA(1, 0, At, B0); PG8_MMA(1, 1, At, B1); PG8_BAR; PG8_SCHED;
        }
        if constexpr (ALIGN_EPI) { if (wr == 0) PG8_BAR; }
        E(acc, cur, wr, wc, fr, fq);
        if (!has_next) break;
#pragma unroll
        for (int a = 0; a < 2; ++a)
#pragma unroll
            for (int b = 0; b < 2; ++b)
#pragma unroll
                for (int m = 0; m < 4; ++m)
#pragma unroll
                    for (int n = 0; n < 2; ++n) acc[a][b][m][n] = (f32x4){0.f, 0.f, 0.f, 0.f};
        cur = nxt; cA = nA; cB = nB; ++ui;
        if constexpr (ALIGN_EPI) { if (wr == 1) PG8_BAR; }
    }
    PG8_WAIT_V(0);
    if constexpr (!ALIGN_EPI) { if (wr == 0) PG8_BAR; }
    PG8_BAR;
#undef PG8_SA
#undef PG8_SB
#undef PG8_STAGE
#undef PG8_LDA
#undef PG8_LDB
#undef PG8_MMA
#undef PG8_WAIT_V
#undef PG8_WAIT_L
#undef PG8_BAR
#undef PG8_SCHED
}
}

#define XB_TMO      128
#define XB_XCNT(j)  (256  + 64 * (j))
#define XB_XSUB(j)  (1280 + 64 * (j))
#define XB_XGEN(j)  (2304 + 64 * (j))
#define XB_TOP      3328
#define XB_TOPGEN   3392
#define XCD_BAR_WORDS 3456
#define XB_SPIN_CAP (1u << 18)
DI unsigned xb_ld(unsigned* p)              { return __hip_atomic_load(p, __ATOMIC_RELAXED, __HIP_MEMORY_SCOPE_AGENT); }
DI unsigned xb_add(unsigned* p, unsigned v) { return __hip_atomic_fetch_add(p, v, __ATOMIC_RELAXED, __HIP_MEMORY_SCOPE_AGENT); }
DI unsigned xb_xcc_id() { return (unsigned)__builtin_amdgcn_s_getreg((3 << 11) | 20) & 0xFu; }
#define XB_SPIN(cond, bar) do { unsigned _sp = 0; while (cond) { __builtin_amdgcn_s_sleep(1); \
    if ((++_sp & 255u) == 0u) { if (xb_ld(&(bar)[XB_TMO])) break; if (_sp > XB_SPIN_CAP) { atomicAdd(&(bar)[XB_TMO], 1u); break; } } } } while (0)
struct XcdBarrier { unsigned* bar; unsigned x; volatile LAS unsigned* st; };
DI XcdBarrier xcd_barrier_post(unsigned* bar, volatile LAS unsigned* st) {
    XcdBarrier b; b.bar = bar; b.x = xb_xcc_id(); b.st = st;
    if (threadIdx.x == 0) (void)xb_add(&bar[XB_XCNT(b.x)], 1u);
    return b;
}
DI void xcd_barrier_complete(unsigned* bar, unsigned x, unsigned& nloc, unsigned& nx) {
    const unsigned G = gridDim.x * gridDim.y * gridDim.z;
    unsigned sum, cnt, mine, sp = 0u;
    for (;;) {
        sum = 0u; cnt = 0u; mine = 0u;
#pragma unroll
        for (unsigned j = 0; j < 16; ++j) { const unsigned c = xb_ld(&bar[XB_XCNT(j)]); sum += c; cnt += (c > 0u) ? 1u : 0u; mine = (j == x) ? c : mine; }
        if (sum == G) break;
        __builtin_amdgcn_s_sleep(1);
        if ((++sp & 255u) == 0u) { if (xb_ld(&bar[XB_TMO])) break; if (sp > XB_SPIN_CAP) { atomicAdd(&bar[XB_TMO], 1u); break; } }
    }
    nloc = mine > 0u ? mine : 1u; nx = cnt > 0u ? cnt : 1u;
}
__device__ __attribute__((noinline)) void xcd_barrier_fn(unsigned* bar_, unsigned x_, unsigned st_off) {
    XcdBarrier b; { const unsigned hi_ = (unsigned)__builtin_amdgcn_readfirstlane((int)((unsigned long long)bar_ >> 32)), lo_ = (unsigned)__builtin_amdgcn_readfirstlane((int)(unsigned)(unsigned long long)bar_);
      b.bar = (unsigned*)(((unsigned long long)hi_ << 32) | (unsigned long long)lo_); }
    b.x = (unsigned)__builtin_amdgcn_readfirstlane((int)x_); b.st = (volatile LAS unsigned*)(unsigned long long)(unsigned)__builtin_amdgcn_readfirstlane((int)st_off);
    asm volatile("s_waitcnt vmcnt(0)" ::: "memory");
    __syncthreads();
    if (threadIdx.x == 0) {
        unsigned* bar = b.bar;
        __builtin_amdgcn_s_waitcnt(0);
        unsigned nloc = b.st[0], nx = b.st[1];
        if (nloc == 0u) { xcd_barrier_complete(bar, b.x, nloc, nx); b.st[0] = nloc; b.st[1] = nx; }
        const unsigned old = xb_add(&bar[XB_XSUB(b.x)], 1u);
        const unsigned gen = old / nloc;
        if (old + 1u == (gen + 1u) * nloc) {
            __builtin_amdgcn_fence(__ATOMIC_RELEASE, "agent");
            asm volatile("s_waitcnt vmcnt(0)" ::: "memory");
            const unsigned og = xb_add(&bar[XB_TOP], 1u);
            const unsigned tg = og / nx;
            if (og + 1u == (tg + 1u) * nx) xb_add(&bar[XB_TOPGEN], 1u);
            else XB_SPIN(xb_ld(&bar[XB_TOPGEN]) == tg, bar);
            __builtin_amdgcn_fence(__ATOMIC_ACQUIRE, "agent");
            xb_add(&bar[XB_XGEN(b.x)], 1u);
            asm volatile("s_waitcnt vmcnt(0)" ::: "memory");
        } else {
            XB_SPIN(xb_ld(&bar[XB_XGEN(b.x)]) == gen, bar);
            __builtin_amdgcn_fence(__ATOMIC_ACQUIRE, "agent");
            asm volatile("s_waitcnt vmcnt(0)" ::: "memory");
        }
    }
    __syncthreads();
}

constexpr int NWAVES = 8, NTHREADS = 512;
constexpr int RING_BYTES = 131072, MISC_OFF = RING_BYTES + 320, LDS_BYTES = 147456;

struct Ctx {
    LAS unsigned char* lds; int tid, lane, wave, G, bid, z;
    float* out; unsigned char* ws;
};
#define WSP(T_, off) ((T_*)(C.ws + (off)))

DI float log2_sigmoid(float x) { return -log1pf(expf(-x)) * LOG2E; }
DI void phase_g0(const Params& a, const Ctx& C) {
    const float* cvec = a.in[C.z + 1]; const float* cctx = a.in[C.z + 3]; const float* w_mod = a.in[C.z + 4]; const float* b_mod = a.in[C.z + 5];
    float* mod = WSP(float, WS_MOD);
    LAS float* red = (LAS float*)C.lds;
    for (int u = C.bid; u < DEPTH * 96; u += C.G) {
        const int L = u / 96, cg = u % 96, col = cg * 64 + C.lane;
        float a0 = 0.f, a1 = 0.f, a2 = 0.f;
        const float* w = w_mod + (size_t)L * DM * 6144 + col;
        for (int kk = 0; kk < 128; ++kk) { const int k = C.wave * 128 + kk; const float wv = w[(size_t)k * 6144];
            a0 += siluf_(cvec[k]) * wv; a1 += siluf_(cvec[DM + k]) * wv; a2 += siluf_(cctx[k]) * wv; }
        red[(C.wave * 3 + 0) * 64 + C.lane] = a0; red[(C.wave * 3 + 1) * 64 + C.lane] = a1; red[(C.wave * 3 + 2) * 64 + C.lane] = a2;
        __syncthreads();
        if (C.wave < 3) { float s = 0.f;
#pragma unroll
            for (int w8 = 0; w8 < 8; ++w8) s += red[(w8 * 3 + C.wave) * 64 + C.lane];
            mod[(size_t)(L * 3 + C.wave) * 6144 + col] = s + b_mod[L * 6144 + col]; }
        __syncthreads();
    }
    const int gt = C.bid * NTHREADS + C.tid, GT = C.G * NTHREADS;
    float* tab = WSP(float, WS_TAB);
    for (int i = gt; i < SEQ * 32; i += GT) { const int t = i >> 5, f = i & 31; const float pos = (f < 16) ? (float)(t >> 6) : (float)(t & 63);
        const float inv = exp2f(-(float)(f & 15) * (13.287712379549449f / 16.f)); const float ang = pos * inv; float s, c; sincosf(ang, &s, &c);
        tab[TAB_AXC / 4 + i] = c; tab[TAB_AXS / 4 + i] = s; }
    for (int i = gt; i < TPB * 32; i += GT) { const int p = i >> 5, f = i & 31;
        const float inv = exp2f(-(float)f * (13.287712379549449f / 32.f)); const float ang = (float)p * inv; float s, c; sincosf(ang, &s, &c);
        tab[TAB_SQC / 4 + i] = c; tab[TAB_SQS / 4 + i] = s; }
    if (gt < DEPTH * 8) WSP(float, WS_L2G)[gt] = log2_sigmoid(a.in[C.z + 17][gt]);
    const float* ws_in = a.in[C.z + 10]; bf16_t* wsb = WSP(bf16_t, WS_WSB);
    for (int i = gt; i < DEPTH * 4 * 128 * 128; i += GT) wsb[i] = (bf16_t)f2bf(ws_in[i]);
}

DI void cvt_item(const float* W, int K, int N, bf16_t* WT, int mode, int row_off, LAS float* scr, int item, int lane) {
    const int nblk = N / 32, kb = item / nblk, nb = item % nblk, k0 = 64 * kb, n0 = 32 * nb;
#pragma unroll 8
    for (int i = 0; i < 32; ++i) { const int kk = 2 * i + (lane >> 5); scr[kk * 33 + (lane & 31)] = W[(size_t)(k0 + kk) * N + n0 + (lane & 31)]; }
    asm volatile("s_waitcnt lgkmcnt(0)" ::: "memory");
    const int r0 = (mode == 0) ? row_off + n0 : row_off + 256 * (n0 >> 7) + (n0 & 127) + (mode == 2 ? 128 : 0);
    const int c = lane & 7;
#pragma unroll
    for (int j = 0; j < 4; ++j) { const int n = (lane >> 3) + 8 * j; const LAS float* s = scr + (8 * c) * 33 + n;
        u32x4 o; o.x = pk2(s[0 * 33], s[1 * 33]); o.y = pk2(s[2 * 33], s[3 * 33]); o.z = pk2(s[4 * 33], s[5 * 33]); o.w = pk2(s[6 * 33], s[7 * 33]);
        *(u32x4*)(WT + (size_t)(r0 + n) * K + k0 + 8 * c) = o; }
    asm volatile("s_waitcnt lgkmcnt(0)" ::: "memory");
}
DI void phase_cvt(const Params& a, const Ctx& C, int L) {
    LAS float* scr = (LAS float*)(C.lds + C.wave * 16384);
    const int gw = C.bid * NWAVES + C.wave, NGW = C.G * NWAVES;
    bf16_t* win_t = WSP(bf16_t, WS_W + W_IN); bf16_t* wbr_t = WSP(bf16_t, WS_W + W_BR); bf16_t* wout_t = WSP(bf16_t, WS_W + W_OUT);
    bf16_t* w13_t = WSP(bf16_t, WS_W + W_13); bf16_t* w2_t = WSP(bf16_t, WS_W + W_2);
    const int j = L >> 1; const bool moe = L & 1;
    constexpr int I_IN = 16 * 208, I_BR = 4 * 32, I_OUT = 16 * 32, I_F13 = 16 * 88, I_F2 = 44 * 32, I_M13 = 16 * 56, I_M2 = 28 * 32;
    const int nitems = I_IN + 4 * I_BR + I_OUT + (moe ? NEXP * (2 * I_M13 + I_M2) : 2 * I_F13 + I_F2);
    for (int it = gw; it < nitems; it += NGW) {
        int r = it;
        if (r < I_IN) { cvt_item(a.in[C.z + 8] + (size_t)L * DM * INW, DM, INW, win_t, 0, 0, scr, r, C.lane); continue; } r -= I_IN;
        if (r < 4 * I_BR) { const int i = r / I_BR; cvt_item(a.in[C.z + 19] + (size_t)(L * 4 + i) * 256 * DM, 256, DM, wbr_t, 0, i * DM, scr, r % I_BR, C.lane); continue; } r -= 4 * I_BR;
        if (r < I_OUT) { cvt_item(a.in[C.z + 20] + (size_t)L * DM * DM, DM, DM, wout_t, 0, 0, scr, r, C.lane); continue; } r -= I_OUT;
        if (!moe) {
            if (r < I_F13) { cvt_item(a.in[C.z + 21] + (size_t)j * DM * DFF, DM, DFF, w13_t, 1, 0, scr, r, C.lane); continue; } r -= I_F13;
            if (r < I_F13) { cvt_item(a.in[C.z + 22] + (size_t)j * DM * DFF, DM, DFF, w13_t, 2, 0, scr, r, C.lane); continue; } r -= I_F13;
            cvt_item(a.in[C.z + 23] + (size_t)j * DFF * DM, DFF, DM, w2_t, 0, 0, scr, r, C.lane);
        } else {
            const int e = r / (2 * I_M13 + I_M2); r -= e * (2 * I_M13 + I_M2);
            const size_t eo = (size_t)(j * NEXP + e) * DM * DFE;
            if (r < I_M13) { cvt_item(a.in[C.z + 26] + eo, DM, DFE, w13_t, 1, e * 2 * DFE, scr, r, C.lane); continue; } r -= I_M13;
            if (r < I_M13) { cvt_item(a.in[C.z + 27] + eo, DM, DFE, w13_t, 2, e * 2 * DFE, scr, r, C.lane); continue; } r -= I_M13;
            cvt_item(a.in[C.z + 28] + eo, DFE, DM, w2_t, 0, e * DM, scr, r, C.lane);
        }
    }
}

DI void phase_norm(const Params& a, const Ctx& C, int L, int which, const float* srcLat, const float* srcCtx) {
    const float* gn = a.in[C.z + which ? 7 : 6] + (size_t)L * DM;
    const float* mod = WSP(float, WS_MOD) + (size_t)L * 3 * 6144;
    bf16_t* H = WSP(bf16_t, WS_H);
    const bool route = which && (L & 1);
    const float* rw = a.in[C.z + 24] + (size_t)(L >> 1) * DM * NEXP; const float* rb = a.in[C.z + 25] + (size_t)(L >> 1) * NEXP;
    int* rt_i = WSP(int, WS_ROUTE); float* rt_f = WSP(float, WS_ROUTE);
    unsigned* cnt = WSP(unsigned, WS_CTL) + CW_CNT + (L >> 1) * 8 * 64;
    const int gw = C.bid * NWAVES + C.wave, NGW = C.G * NWAVES;
    for (int r = gw; r < T; r += NGW) {
        const float* xr = xrow_c(srcLat, srcCtx, r); const int mr = modrow(r);
        const float* sh = mod + (size_t)mr * 6144 + (which ? 3 : 0) * DM; const float* sc = sh + DM;
        f32x4 v[4]; float ss = 0.f;
#pragma unroll
        for (int j = 0; j < 4; ++j) { v[j] = *(const f32x4*)(xr + 4 * C.lane + 256 * j); ss += (v[j].x * v[j].x + v[j].y * v[j].y) + (v[j].z * v[j].z + v[j].w * v[j].w); }
        const float rs = __builtin_amdgcn_rsqf(wave_sum(ss) * (1.f / DM) + EPS);
        float lg[8];
#pragma unroll
        for (int e = 0; e < 8; ++e) lg[e] = 0.f;
#pragma unroll
        for (int j = 0; j < 4; ++j) { const int c0 = 4 * C.lane + 256 * j; const f32x4 g4 = *(const f32x4*)(gn + c0), s4 = *(const f32x4*)(sc + c0), h4 = *(const f32x4*)(sh + c0);
            f32x4 h = v[j] * rs * g4 * (s4 + 1.f) + h4;
            u32x2 o; o.x = pk2(h.x, h.y); o.y = pk2(h.z, h.w); *(u32x2*)(H + (size_t)r * DM + c0) = o;
            if (route) {
#pragma unroll
                for (int q = 0; q < 4; ++q) { const f32x4 w0 = *(const f32x4*)(rw + (size_t)(c0 + q) * 8), w1 = *(const f32x4*)(rw + (size_t)(c0 + q) * 8 + 4); const float hv = h[q];
                    lg[0] += hv * w0.x; lg[1] += hv * w0.y; lg[2] += hv * w0.z; lg[3] += hv * w0.w; lg[4] += hv * w1.x; lg[5] += hv * w1.y; lg[6] += hv * w1.z; lg[7] += hv * w1.w; } } }
        if (route) {
#pragma unroll
            for (int e = 0; e < 8; ++e) lg[e] = wave_sum(lg[e]) + rb[e];
            int e1 = 0; float v1 = lg[0];
#pragma unroll
            for (int e = 1; e < 8; ++e) if (lg[e] > v1) { v1 = lg[e]; e1 = e; }
            int e2 = -1; float v2 = -3.0e38f;
#pragma unroll
            for (int e = 0; e < 8; ++e) if (e != e1 && lg[e] > v2) { v2 = lg[e]; e2 = e; }
            if (C.lane == 0) { const float p1 = rcpf_(1.f + ex2((v2 - v1) * LOG2E));
                const unsigned q1 = atomicAdd(cnt + e1 * 64, 1u), q2 = atomicAdd(cnt + e2 * 64, 1u);
                rt_i[RT_E + 2 * r] = e1; rt_i[RT_E + 2 * r + 1] = e2; rt_i[RT_POS + 2 * r] = (int)q1; rt_i[RT_POS + 2 * r + 1] = (int)q2;
                rt_f[RT_PW + 2 * r] = p1; rt_f[RT_PW + 2 * r + 1] = 1.f - p1; }
        }
    }
}

DI void phase_prep(const Params& a, const Ctx& C, int L) {
    bf16_t* P = WSP(bf16_t, WS_P); bf16_t* VT = WSP(bf16_t, WS_VT);
    const float* tab = WSP(float, WS_TAB);
    const float* axc = tab + TAB_AXC / 4; const float* axs = tab + TAB_AXS / 4; const float* sqc = tab + TAB_SQC / 4; const float* sqs = tab + TAB_SQS / 4;
    const float* gvv = a.in[C.z + 9] + (size_t)L * 256; const float* wqn = a.in[C.z + 12] + L * 64; const float* wkn = a.in[C.z + 13] + L * 64; const float* gqn = a.in[C.z + 15] + L * 64; const float* gkn = a.in[C.z + 16] + L * 64;
    const int lane = C.lane, i32 = lane & 31; const bool hiH = lane >= 32;
    for (int u = C.bid; u < T / 64; u += C.G) {
        const int row0 = u * 64;
        for (int rr = 0; rr < 8; ++rr) {
            const int r = row0 + C.wave * 8 + rr; const int b = r / TPB, p = r - b * TPB; const bool lat = p >= CTXL; const int t = p - CTXL;
            bf16_t* pr = P + (size_t)r * INW;
            const float ac = lat ? axc[t * 32 + i32] : 1.f, as = lat ? axs[t * 32 + i32] : 0.f;
            const float sc_ = sqc[p * 32 + i32], ss_ = sqs[p * 32 + i32];
#pragma unroll 1
            for (int it = 0; it < 24; ++it) {
                int col; const float* g = nullptr; float scale = 1.f; int rope = 0;
                if (it < 4) { col = C_WQ + 64 * it; g = wqn; rope = 1; scale = QSCALE; }
                else if (it < 6) { col = C_WK + 64 * (it - 4); g = wkn; rope = 1; }
                else if (it < 10) { col = C_GQ + 64 * (it - 6); g = gqn; rope = 1; scale = QSCALE; }
                else if (it < 12) { col = C_GK + 64 * (it - 10); g = gkn; rope = 1; }
                else if (it < 16) { col = C_RQ + 64 * (it - 12); rope = 2; }
                else if (it < 20) { col = C_RK + 64 * (it - 16); rope = 2; scale = 0.125f; }
                else { col = C_V + 64 * (it - 20); g = gvv + 64 * (it - 20); }
                float x = bf2f(pr[col + lane]);
                if (g) { const float ss = wave_sum(x * x); x = x * __builtin_amdgcn_rsqf(ss * (1.f / 64.f) + EPS) * g[lane]; }
                if (rope) { const float c = rope == 1 ? ac : sc_, s = rope == 1 ? as : ss_; const float o = __shfl_xor(x, 32);
                    x = hiH ? (o * s + x * c) : (x * c - o * s); }
                pr[col + lane] = (bf16_t)f2bf(x * scale);
            }
        }
        { const int hh = C.tid >> 7, d = (C.tid >> 1) & 63, tg = C.tid & 1; const int kind = hh >> 1, kvh = hh & 1;
          const int b = row0 / TPB, p0 = row0 - b * TPB + 32 * tg; const int col = (kind ? C_GV : C_WV) + 64 * kvh + d;
          const bf16_t* src = P + (size_t)(row0 + 32 * tg) * INW + col;
          bf16_t* dst = VT + ((size_t)((kind * 2 + b) * 2 + kvh) * 64 + d) * TPB + p0;
#pragma unroll
          for (int q = 0; q < 4; ++q) { unsigned w[4];
#pragma unroll
              for (int e = 0; e < 4; ++e) { const unsigned lo = src[(size_t)(8 * q + 2 * e) * INW], hi = src[(size_t)(8 * q + 2 * e + 1) * INW]; w[e] = lo | (hi << 16); }
              *(u32x4*)(dst + 8 * q) = (u32x4){w[0], w[1], w[2], w[3]}; } }
    }
}

DI void mixA_unit(const Params& a, const Ctx& C, int L, int cg, int g) {
    const bf16_t* P = WSP(bf16_t, WS_P); bf16_t* BR = WSP(bf16_t, WS_BR);
    const bf16_t* W = WSP(bf16_t, WS_WSB) + (size_t)(L * 4 + g) * 128 * 128; const float* bs = a.in[C.z + 11] + (size_t)(L * 4 + g) * 128;
    LAS bf16_t* vnT = (LAS bf16_t*)C.lds;
    const int row0 = cg * 128, lane = C.lane, l15 = lane & 15, quad = lane >> 4;
#pragma unroll
    for (int it = 0; it < 2; ++it) { const int idx = C.tid + 512 * it, j = idx >> 3, ch = idx & 7;
        const u32x4 v = *(const u32x4*)(P + (size_t)(row0 + j) * INW + C_V + 64 * g + 8 * ch);
        const unsigned w[4] = {v.x, v.y, v.z, v.w};
#pragma unroll
        for (int e = 0; e < 4; ++e) { vnT[(8 * ch + 2 * e) * 136 + j] = (bf16_t)(w[e] & 0xffffu); vnT[(8 * ch + 2 * e + 1) * 136 + j] = (bf16_t)(w[e] >> 16); } }
    __syncthreads();
    const int i0 = 16 * C.wave;
    f32x4 acc[4];
#pragma unroll
    for (int dt = 0; dt < 4; ++dt) acc[dt] = (f32x4){0.f, 0.f, 0.f, 0.f};
#pragma unroll
    for (int ks = 0; ks < 4; ++ks) { const bf16x8 a = *(const bf16x8*)(W + (size_t)(i0 + l15) * 128 + 32 * ks + 8 * quad);
#pragma unroll
        for (int dt = 0; dt < 4; ++dt) { const bf16x8 bb = *(const LAS bf16x8*)(vnT + (16 * dt + l15) * 136 + 32 * ks + 8 * quad); acc[dt] = MFMA16(a, bb, acc[dt]); } }
#pragma unroll
    for (int dt = 0; dt < 4; ++dt)
#pragma unroll
        for (int j = 0; j < 4; ++j) { const int i = i0 + quad * 4 + j, d = 16 * dt + l15; const float mixed = acc[dt][j] + bs[i];
            const float uv = bf2f(P[(size_t)(row0 + i) * INW + C_U + 64 * g + d]); BR[(size_t)(row0 + i) * DM + 64 * g + d] = (bf16_t)f2bf(uv * mixed); }
    __syncthreads();
}

DI void attn_unit(const Params& a, const Ctx& C, int L, int kind, int b, int kvh, int qrow0, int ntile0, int krow0, int ntile1, int krow1, bool masked, bool has_sink) {
    const bf16_t* P = WSP(bf16_t, WS_P); bf16_t* BR = WSP(bf16_t, WS_BR);
    const bf16_t* VTb = WSP(bf16_t, WS_VT) + (size_t)((kind * 2 + b) * 2 + kvh) * 64 * TPB;
    const int Qcol = kind ? C_GQ : C_WQ, Kcol = (kind ? C_GK : C_WK) + 64 * kvh, Ocol = kind ? 512 : 256;
    LAS bf16_t* Kb = (LAS bf16_t*)C.lds;
    LAS bf16_t* Vb = (LAS bf16_t*)(C.lds + 2 * 64 * 144);
    const int lane = C.lane, r32 = lane & 31, hi = lane >> 5, w = C.wave, hq = 2 * kvh + (w >> 2);
    const int q = qrow0 + 32 * (w & 3) + r32;
    bf16x8 qr[4];
#pragma unroll
    for (int d0 = 0; d0 < 4; ++d0) qr[d0] = *(const bf16x8*)(P + (size_t)q * INW + Qcol + 64 * hq + 16 * d0 + 8 * hi);
    float m = has_sink ? a.in[C.z + 14][L * 4 + hq] * LOG2E : -1e30f, l = (has_sink && hi == 0) ? 1.f : 0.f;
    f32x16 o0, o1;
#pragma unroll
    for (int i = 0; i < 16; ++i) { o0[i] = 0.f; o1[i] = 0.f; }
    const int nt = ntile0 + ntile1; const int lr = C.tid >> 3, lc = C.tid & 7;
    const int qpos = q - (b * TPB + CTXL);
    u32x4 kreg, vreg;
    { const int kr = krow0; kreg = *(const u32x4*)(P + (size_t)(kr + lr) * INW + Kcol + 8 * lc); vreg = *(const u32x4*)(VTb + (size_t)lr * TPB + (kr - b * TPB) + 8 * lc); }
    *(LAS u32x4*)(Kb + lr * 72 + 8 * lc) = kreg; *(LAS u32x4*)(Vb + lr * 72 + 8 * lc) = vreg;
    __syncthreads();
    for (int t = 0; t < nt; ++t) {
        const int cur = t & 1; const bool more = t + 1 < nt;
        if (more) { const int tn = t + 1; const int kr = tn < ntile0 ? krow0 + 64 * tn : krow1 + 64 * (tn - ntile0);
            kreg = *(const u32x4*)(P + (size_t)(kr + lr) * INW + Kcol + 8 * lc); vreg = *(const u32x4*)(VTb + (size_t)lr * TPB + (kr - b * TPB) + 8 * lc); }
        const LAS bf16_t* Kc = Kb + cur * 64 * 72; const LAS bf16_t* Vc = Vb + cur * 64 * 72;
        f32x16 p0, p1;
#pragma unroll
        for (int i = 0; i < 16; ++i) { p0[i] = 0.f; p1[i] = 0.f; }
#pragma unroll
        for (int d0 = 0; d0 < 4; ++d0) { const bf16x8 k0 = *(const LAS bf16x8*)(Kc + r32 * 72 + 16 * d0 + 8 * hi), k1 = *(const LAS bf16x8*)(Kc + (32 + r32) * 72 + 16 * d0 + 8 * hi);
            p0 = MFMA32(k0, qr[d0], p0); p1 = MFMA32(k1, qr[d0], p1); }
        if (masked && t >= ntile0) { const int kp0 = krow1 + 64 * (t - ntile0) - (b * TPB + CTXL);
#pragma unroll
            for (int i = 0; i < 16; ++i) { const int kp = kp0 + crow(i, hi); int d = qpos - kp; d = d < 0 ? -d : d; if (d > 128) p0[i] = -1e30f; int d2 = qpos - (kp + 32); d2 = d2 < 0 ? -d2 : d2; if (d2 > 128) p1[i] = -1e30f; } }
        float mx = p0[0];
#pragma unroll
        for (int i = 1; i < 16; ++i) mx = fmaxf(mx, p0[i]);
#pragma unroll
        for (int i = 0; i < 16; ++i) mx = fmaxf(mx, p1[i]);
        mx = fmaxf(mx, __shfl_xor(mx, 32));
        const float mn = fmaxf(m, mx), alpha = ex2(m - mn); m = mn; l *= alpha;
        float ps = 0.f;
#pragma unroll
        for (int i = 0; i < 16; ++i) { o0[i] *= alpha; o1[i] *= alpha; p0[i] = ex2(p0[i] - mn); p1[i] = ex2(p1[i] - mn); ps += p0[i] + p1[i]; }
        l += ps;
        bf16x8 pw[4];
        { u32x4 t0 = {pk2(p0[0], p0[1]), pk2(p0[2], p0[3]), pk2(p0[4], p0[5]), pk2(p0[6], p0[7])}; pw[0] = __builtin_bit_cast(bf16x8, t0);
          u32x4 t1 = {pk2(p0[8], p0[9]), pk2(p0[10], p0[11]), pk2(p0[12], p0[13]), pk2(p0[14], p0[15])}; pw[1] = __builtin_bit_cast(bf16x8, t1);
          u32x4 t2 = {pk2(p1[0], p1[1]), pk2(p1[2], p1[3]), pk2(p1[4], p1[5]), pk2(p1[6], p1[7])}; pw[2] = __builtin_bit_cast(bf16x8, t2);
          u32x4 t3 = {pk2(p1[8], p1[9]), pk2(p1[10], p1[11]), pk2(p1[12], p1[13]), pk2(p1[14], p1[15])}; pw[3] = __builtin_bit_cast(bf16x8, t3); }
#pragma unroll
        for (int s = 0; s < 4; ++s) {
            const u32x2 a0 = *(const LAS u32x2*)(Vc + r32 * 72 + 16 * s + 4 * hi), a1 = *(const LAS u32x2*)(Vc + r32 * 72 + 16 * s + 8 + 4 * hi);
            const u32x2 c0 = *(const LAS u32x2*)(Vc + (32 + r32) * 72 + 16 * s + 4 * hi), c1 = *(const LAS u32x2*)(Vc + (32 + r32) * 72 + 16 * s + 8 + 4 * hi);
            const u32x4 va = {a0.x, a0.y, a1.x, a1.y}, vc = {c0.x, c0.y, c1.x, c1.y};
            o0 = MFMA32(__builtin_bit_cast(bf16x8, va), pw[s], o0); o1 = MFMA32(__builtin_bit_cast(bf16x8, vc), pw[s], o1); }
        if (more) { const int nx = cur ^ 1; *(LAS u32x4*)(Kb + nx * 64 * 72 + lr * 72 + 8 * lc) = kreg; *(LAS u32x4*)(Vb + nx * 64 * 72 + lr * 72 + 8 * lc) = vreg; }
        __syncthreads();
    }
    l += __shfl_xor(l, 32);
    const float inv = rcpf_(l);
    bf16_t* orow = BR + (size_t)q * DM + Ocol + 64 * hq;
#pragma unroll
    for (int g = 0; g < 4; ++g) { const int d = 8 * g + 4 * hi;
        u32x2 w0 = {pk2(o0[4 * g] * inv, o0[4 * g + 1] * inv), pk2(o0[4 * g + 2] * inv, o0[4 * g + 3] * inv)}; *(u32x2*)(orow + d) = w0;
        u32x2 w1 = {pk2(o1[4 * g] * inv, o1[4 * g + 1] * inv), pk2(o1[4 * g + 2] * inv, o1[4 * g + 3] * inv)}; *(u32x2*)(orow + 32 + d) = w1; }
}

DI void ret_kv_unit(const Params& a, const Ctx& C, int L, int cg, int h) {
    const bf16_t* P = WSP(bf16_t, WS_P); float* KVT = WSP(float, WS_KVT);
    const float l2f = WSP(float, WS_L2G)[(L * 2 + 0) * 4 + h], l2b = WSP(float, WS_L2G)[(L * 2 + 1) * 4 + h];
    LAS bf16_t* VTs = (LAS bf16_t*)C.lds; LAS bf16_t* KTf = VTs + 64 * 136; LAS bf16_t* KTb = KTf + 64 * 136;
    const int row0 = cg * 128, lane = C.lane, l15 = lane & 15, quad = lane >> 4;
#pragma unroll
    for (int it = 0; it < 2; ++it) { const int idx = C.tid + 512 * it, j = idx >> 3, ch = idx & 7;
        const u32x4 kv = *(const u32x4*)(P + (size_t)(row0 + j) * INW + C_RK + 64 * h + 8 * ch), vv = *(const u32x4*)(P + (size_t)(row0 + j) * INW + C_RV + 64 * h + 8 * ch);
        const float wf = ex2((float)(127 - j) * l2f), wb = ex2((float)j * l2b);
        const unsigned kw[4] = {kv.x, kv.y, kv.z, kv.w}, vw[4] = {vv.x, vv.y, vv.z, vv.w};
#pragma unroll
        for (int e = 0; e < 4; ++e) { const float k0 = __uint_as_float(kw[e] << 16), k1 = __uint_as_float(kw[e] & 0xffff0000u);
            KTf[(8 * ch + 2 * e) * 136 + j] = (bf16_t)f2bf(k0 * wf); KTf[(8 * ch + 2 * e + 1) * 136 + j] = (bf16_t)f2bf(k1 * wf);
            KTb[(8 * ch + 2 * e) * 136 + j] = (bf16_t)f2bf(k0 * wb); KTb[(8 * ch + 2 * e + 1) * 136 + j] = (bf16_t)f2bf(k1 * wb);
            VTs[(8 * ch + 2 * e) * 136 + j] = (bf16_t)(vw[e] & 0xffffu); VTs[(8 * ch + 2 * e + 1) * 136 + j] = (bf16_t)(vw[e] >> 16); } }
    __syncthreads();
    const int dir = C.wave >> 2, vt = C.wave & 3; const LAS bf16_t* KT = dir ? KTb : KTf;
    f32x4 acc[4];
#pragma unroll
    for (int dt = 0; dt < 4; ++dt) acc[dt] = (f32x4){0.f, 0.f, 0.f, 0.f};
#pragma unroll
    for (int ks = 0; ks < 4; ++ks) { const bf16x8 a = *(const LAS bf16x8*)(VTs + (16 * vt + l15) * 136 + 32 * ks + 8 * quad);
#pragma unroll
        for (int dt = 0; dt < 4; ++dt) { const bf16x8 bb = *(const LAS bf16x8*)(KT + (16 * dt + l15) * 136 + 32 * ks + 8 * quad); acc[dt] = MFMA16(a, bb, acc[dt]); } }
    const int b = cg / NCHUNK, c = cg - b * NCHUNK;
    float* dst = KVT + ((size_t)((dir * 2 + b) * 4 + h) * NCHUNK + c) * 4096;
#pragma unroll
    for (int dt = 0; dt < 4; ++dt)
#pragma unroll
        for (int j = 0; j < 4; ++j) dst[(16 * vt + quad * 4 + j) * 64 + 16 * dt + l15] = acc[dt][j];
    __syncthreads();
}
DI void phase_ret_scan(const Params& a, const Ctx& C, int L) {
    const float* KVT = WSP(float, WS_KVT); bf16_t* SIN = WSP(bf16_t, WS_SIN);
    const int gt = C.bid * NTHREADS + C.tid;
    if (gt < 2 * 2 * 4 * 4096) {
        const int e = gt & 4095, bh = (gt >> 12) & 7, dir = gt >> 15, h = bh & 3;
        const float cd = ex2(128.f * WSP(float, WS_L2G)[(L * 2 + dir) * 4 + h]);
        const size_t base = (size_t)((dir * 2 + (bh >> 2)) * 4 + h) * NCHUNK * 4096 + e;
        float st = 0.f;
        for (int t = 0; t < NCHUNK; ++t) { const int c = dir == 0 ? t : (t == 0 ? 1 : (t == 1 ? 0 : 67 - t));
            SIN[base + (size_t)c * 4096] = (bf16_t)f2bf(st); st = cd * st + KVT[base + (size_t)c * 4096]; }
    }
}
DI void ret_out_unit(const Params& a, const Ctx& C, int L, int cg, int h) {
    const bf16_t* P = WSP(bf16_t, WS_P); bf16_t* BR = WSP(bf16_t, WS_BR); const bf16_t* SIN = WSP(bf16_t, WS_SIN);
    const float l2f = WSP(float, WS_L2G)[(L * 2 + 0) * 4 + h], l2b = WSP(float, WS_L2G)[(L * 2 + 1) * 4 + h];
    const float* gn = a.in[C.z + 18] + (size_t)(L * 4 + h) * 64;
    LAS bf16_t* Qs = (LAS bf16_t*)C.lds;
    LAS bf16_t* Ks = Qs + 128 * 72;
    LAS bf16_t* VTs = Ks + 128 * 72;
    LAS bf16_t* Wd = VTs + 64 * 136;
    LAS bf16_t* SfT = Wd + 128 * 136;
    LAS bf16_t* SbT = SfT + 64 * 72;
    const int row0 = cg * 128, lane = C.lane, l15 = lane & 15, quad = lane >> 4; const int b = cg / NCHUNK, c = cg - b * NCHUNK;
#pragma unroll
    for (int it = 0; it < 2; ++it) { const int idx = C.tid + 512 * it, j = idx >> 3, ch = idx & 7; const bf16_t* pr = P + (size_t)(row0 + j) * INW + 64 * h + 8 * ch;
        *(LAS u32x4*)(Qs + j * 72 + 8 * ch) = *(const u32x4*)(pr + C_RQ); *(LAS u32x4*)(Ks + j * 72 + 8 * ch) = *(const u32x4*)(pr + C_RK);
        const u32x4 vv = *(const u32x4*)(pr + C_RV); const unsigned vw[4] = {vv.x, vv.y, vv.z, vv.w};
#pragma unroll
        for (int e = 0; e < 4; ++e) { VTs[(8 * ch + 2 * e) * 136 + j] = (bf16_t)(vw[e] & 0xffffu); VTs[(8 * ch + 2 * e + 1) * 136 + j] = (bf16_t)(vw[e] >> 16); } }
    { const int v = C.tid >> 3, ch = C.tid & 7;
      *(LAS u32x4*)(SfT + v * 72 + 8 * ch) = *(const u32x4*)(SIN + ((size_t)((0 * 2 + b) * 4 + h) * NCHUNK + c) * 4096 + v * 64 + 8 * ch);
      *(LAS u32x4*)(SbT + v * 72 + 8 * ch) = *(const u32x4*)(SIN + ((size_t)((1 * 2 + b) * 4 + h) * NCHUNK + c) * 4096 + v * 64 + 8 * ch); }
    __syncthreads();
    const int i0 = 16 * C.wave;
    { bf16x8 a[2];
#pragma unroll
      for (int ks = 0; ks < 2; ++ks) a[ks] = *(const LAS bf16x8*)(Qs + (i0 + l15) * 72 + 32 * ks + 8 * quad);
#pragma unroll
      for (int jt = 0; jt < 8; ++jt) { f32x4 acc = {0.f, 0.f, 0.f, 0.f};
#pragma unroll
          for (int ks = 0; ks < 2; ++ks) { const bf16x8 bb = *(const LAS bf16x8*)(Ks + (16 * jt + l15) * 72 + 32 * ks + 8 * quad); acc = MFMA16(a[ks], bb, acc); }
#pragma unroll
          for (int r = 0; r < 4; ++r) { const int i = i0 + quad * 4 + r, j = 16 * jt + l15, dl = i - j;
              const float f = dl >= 0 ? ex2((float)dl * l2f) : ex2((float)(-dl - 1) * l2b); Wd[i * 136 + j] = (bf16_t)f2bf(acc[r] * f); } } }
    __syncthreads();
    f32x4 oi[4], tf[4], tb[4];
#pragma unroll
    for (int vt = 0; vt < 4; ++vt) { oi[vt] = (f32x4){0.f, 0.f, 0.f, 0.f}; tf[vt] = oi[vt]; tb[vt] = oi[vt]; }
#pragma unroll
    for (int ks = 0; ks < 4; ++ks) { const bf16x8 a = *(const LAS bf16x8*)(Wd + (i0 + l15) * 136 + 32 * ks + 8 * quad);
#pragma unroll
        for (int vt = 0; vt < 4; ++vt) { const bf16x8 bb = *(const LAS bf16x8*)(VTs + (16 * vt + l15) * 136 + 32 * ks + 8 * quad); oi[vt] = MFMA16(a, bb, oi[vt]); } }
#pragma unroll
    for (int ks = 0; ks < 2; ++ks) { const bf16x8 a = *(const LAS bf16x8*)(Qs + (i0 + l15) * 72 + 32 * ks + 8 * quad);
#pragma unroll
        for (int vt = 0; vt < 4; ++vt) { const bf16x8 b1 = *(const LAS bf16x8*)(SfT + (16 * vt + l15) * 72 + 32 * ks + 8 * quad), b2 = *(const LAS bf16x8*)(SbT + (16 * vt + l15) * 72 + 32 * ks + 8 * quad);
            tf[vt] = MFMA16(a, b1, tf[vt]); tb[vt] = MFMA16(a, b2, tb[vt]); } }
#pragma unroll
    for (int r = 0; r < 4; ++r) { const int i = i0 + quad * 4 + r; const float qf = ex2((float)(i + 1) * l2f), qb = ex2((float)(127 - i) * l2b);
        float o[4]; float s = 0.f;
#pragma unroll
        for (int vt = 0; vt < 4; ++vt) { o[vt] = oi[vt][r] + qf * tf[vt][r] + qb * tb[vt][r]; s += o[vt]; }
        s += __shfl_xor(s, 1); s += __shfl_xor(s, 2); s += __shfl_xor(s, 4); s += __shfl_xor(s, 8);
        const float mean = s * (1.f / 64.f); float q2 = 0.f;
#pragma unroll
        for (int vt = 0; vt < 4; ++vt) { o[vt] -= mean; q2 += o[vt] * o[vt]; }
        q2 += __shfl_xor(q2, 1); q2 += __shfl_xor(q2, 2); q2 += __shfl_xor(q2, 4); q2 += __shfl_xor(q2, 8);
        const float rs = __builtin_amdgcn_rsqf(q2 * (1.f / 64.f) + EPS);
#pragma unroll
        for (int vt = 0; vt < 4; ++vt) { const int v = 16 * vt + l15; const float gt = bf2f(P[(size_t)(row0 + i) * INW + C_RG + 64 * h + v]);
            BR[(size_t)(row0 + i) * DM + 768 + 64 * h + v] = (bf16_t)f2bf(o[vt] * rs * gn[v] * siluf_(gt)); } }
    __syncthreads();
}

DI void phase_mix(const Params& a, const Ctx& C, int L) {
    constexpr int N_CL = 256, N_BL = 256, N_BC = 8, N_CC = 8, N_A = 528, N_KV = 528;
    constexpr int NU = N_CL + N_BL + N_BC + N_CC + N_A + N_KV;
    for (int u = C.bid; u < NU; u += C.G) {
        int r = u;
        if (r < N_CL) { const int b = r >> 7, kvh = (r >> 6) & 1, n = r & 63; attn_unit(a, C, L, 1, b, kvh, b * TPB + CTXL + n * 128, TPB / 64, b * TPB, 0, 0, false, false); continue; } r -= N_CL;
        if (r < N_BL) { const int b = r >> 7, kvh = (r >> 6) & 1, n = r & 63; const int ls = (n > 0 ? n - 1 : 0) * 128, le = (n < 63 ? n + 2 : 64) * 128;
            attn_unit(a, C, L, 0, b, kvh, b * TPB + CTXL + n * 128, 4, b * TPB, (le - ls) / 64, b * TPB + CTXL + ls, true, true); continue; } r -= N_BL;
        if (r < N_BC) { const int b = r >> 2, kvh = (r >> 1) & 1, cb = r & 1; attn_unit(a, C, L, 0, b, kvh, b * TPB + cb * 128, 4, b * TPB, 0, 0, false, true); continue; } r -= N_BC;
        if (r < N_CC) { const int b = r >> 2, kvh = (r >> 1) & 1, cb = r & 1; attn_unit(a, C, L, 1, b, kvh, b * TPB + cb * 128, 4, b * TPB, 0, 0, false, false); continue; } r -= N_CC;
        if (r < N_A) { mixA_unit(a, C, L, r >> 2, r & 3); continue; } r -= N_A;
        ret_kv_unit(a, C, L, r >> 2, r & 3);
    }
}
DI void phase_ret_out(const Params& a, const Ctx& C, int L) { for (int u = C.bid; u < 528; u += C.G) ret_out_unit(a, C, L, u >> 2, u & 3); }

DI void phase_sum4(const Params& a, const Ctx& C) {
    const bf16_t* P = WSP(bf16_t, WS_P); bf16_t* A = WSP(bf16_t, WS_H);
    const int gt = C.bid * NTHREADS + C.tid, GT = C.G * NTHREADS;
    for (int i = gt; i < T * 128; i += GT) { const int r = i >> 7, c = (i & 127) * 8; const bf16_t* pr = P + (size_t)r * INW + C_GATE + c;
        float s[8];
#pragma unroll
        for (int e = 0; e < 8; ++e) s[e] = 0.f;
#pragma unroll
        for (int br = 0; br < 4; ++br) { const u32x4 v = *(const u32x4*)(pr + br * 1024); const unsigned w[4] = {v.x, v.y, v.z, v.w};
#pragma unroll
            for (int e = 0; e < 4; ++e) { s[2 * e] += __uint_as_float(w[e] << 16); s[2 * e + 1] += __uint_as_float(w[e] & 0xffff0000u); } }
        *(u32x4*)(A + (size_t)r * DM + c) = (u32x4){pk2(s[0], s[1]), pk2(s[2], s[3]), pk2(s[4], s[5]), pk2(s[6], s[7])}; }
}

DI void phase_gather(const Params& a, const Ctx& C, int L) {
    const unsigned* cnt = WSP(unsigned, WS_CTL) + CW_CNT + (L >> 1) * 8 * 64;
    int* rt_i = WSP(int, WS_ROUTE); float* rt_f = WSP(float, WS_ROUTE);
    const bf16_t* H = WSP(bf16_t, WS_H); bf16_t* HG = WSP(bf16_t, WS_HG);
    int base[NEXP + 1]; int cn[NEXP];
    { int acc = 0;
#pragma unroll
      for (int e = 0; e < NEXP; ++e) { cn[e] = (int)__hip_atomic_load(cnt + e * 64, __ATOMIC_RELAXED, __HIP_MEMORY_SCOPE_AGENT); base[e] = acc; acc += ((cn[e] + 255) >> 8) << 8; } base[NEXP] = acc; }
    if (C.bid == 0) {
        if (C.tid == 0) { rt_i[RT_META] = base[NEXP] >> 8; }
        for (int rt = C.tid; rt < (base[NEXP] >> 8); rt += NTHREADS) { int e = 0;
#pragma unroll
            for (int k = 1; k < NEXP; ++k) if (rt * 256 >= base[k]) e = k;
            rt_i[RT_META + 16 + rt] = e; }
#pragma unroll
        for (int e = 0; e < NEXP; ++e) for (int r = base[e] + cn[e] + C.tid; r < base[e + 1]; r += NTHREADS) rt_i[RT_ROWTOK + r] = -1;
    }
    const int gw = C.bid * NWAVES + C.wave, NGW = C.G * NWAVES;
    for (int t = gw; t < T; t += NGW) {
        const u32x4 h0 = *(const u32x4*)(H + (size_t)t * DM + 8 * C.lane), h1 = *(const u32x4*)(H + (size_t)t * DM + 512 + 8 * C.lane);
#pragma unroll
        for (int k = 0; k < 2; ++k) { const int e = rt_i[RT_E + 2 * t + k], pos = rt_i[RT_POS + 2 * t + k];
            int bs = 0;
#pragma unroll
            for (int q = 0; q < NEXP; ++q) if (q == e) bs = base[q];
            const int row = bs + pos;
            *(u32x4*)(HG + (size_t)row * DM + 8 * C.lane) = h0; *(u32x4*)(HG + (size_t)row * DM + 512 + 8 * C.lane) = h1;
            if (C.lane == 0) { rt_i[RT_ROWTOK + row] = t; rt_f[RT_ROWP + row] = rt_f[RT_PW + 2 * t + k]; } }
    }
}

DI void phase_combine(const Params& a, const Ctx& C, int L) {
    const unsigned* cnt = WSP(unsigned, WS_CTL) + CW_CNT + (L >> 1) * 8 * 64;
    const int* rt_i = WSP(int, WS_ROUTE); const bf16_t* Y = WSP(bf16_t, WS_HG);
    const float* mod = WSP(float, WS_MOD) + (size_t)L * 3 * 6144 + 5 * DM;
    int base[NEXP];
    { int acc = 0;
#pragma unroll
      for (int e = 0; e < NEXP; ++e) { const int cn = (int)__hip_atomic_load(cnt + e * 64, __ATOMIC_RELAXED, __HIP_MEMORY_SCOPE_AGENT); base[e] = acc; acc += ((cn + 255) >> 8) << 8; } }
    const int gw = C.bid * NWAVES + C.wave, NGW = C.G * NWAVES;
    for (int t = gw; t < T; t += NGW) {
        int row[2];
#pragma unroll
        for (int k = 0; k < 2; ++k) { const int e = rt_i[RT_E + 2 * t + k], pos = rt_i[RT_POS + 2 * t + k]; int bs = 0;
#pragma unroll
            for (int q = 0; q < NEXP; ++q) if (q == e) bs = base[q];
            row[k] = bs + pos; }
        float* xr = xrow(C.out, WSP(float, WS_CTXB), t); const float* gt = mod + (size_t)modrow(t) * 6144;
#pragma unroll
        for (int hf = 0; hf < 2; ++hf) { const int c = hf * 512 + 8 * C.lane;
            const u32x4 y0 = *(const u32x4*)(Y + (size_t)row[0] * DM + c), y1 = *(const u32x4*)(Y + (size_t)row[1] * DM + c);
            const unsigned w0[4] = {y0.x, y0.y, y0.z, y0.w}, w1[4] = {y1.x, y1.y, y1.z, y1.w};
#pragma unroll
            for (int q = 0; q < 2; ++q) { const f32x4 g = *(const f32x4*)(gt + c + 4 * q); f32x4 x = *(const f32x4*)(xr + c + 4 * q);
                x[0] += g[0] * (__uint_as_float(w0[2 * q] << 16) + __uint_as_float(w1[2 * q] << 16));
                x[1] += g[1] * (__uint_as_float(w0[2 * q] & 0xffff0000u) + __uint_as_float(w1[2 * q] & 0xffff0000u));
                x[2] += g[2] * (__uint_as_float(w0[2 * q + 1] << 16) + __uint_as_float(w1[2 * q + 1] << 16));
                x[3] += g[3] * (__uint_as_float(w0[2 * q + 1] & 0xffff0000u) + __uint_as_float(w1[2 * q + 1] & 0xffff0000u));
                *(f32x4*)(xr + c + 4 * q) = x; } }
    }
}

constexpr int PH_PER_LAYER = 15;
#define PHASE_CTX() Ctx C; { int z_ = 0; asm volatile("s_mov_b32 %0, 0" : "=s"(z_)); C.z = z_; C.lds = (LAS unsigned char*)lds_raw; { int t_ = threadIdx.x; asm volatile("" : "+v"(t_)); C.tid = t_; } C.lane = C.tid & 63; \
    C.wave = __builtin_amdgcn_readfirstlane(C.tid >> 6); C.G = (int)gridDim.x + z_; C.bid = (int)blockIdx.x + z_; C.out = a.out + z_; C.ws = a.ws + z_; }
template <int PHMASK, bool FUSED>
__global__ void __launch_bounds__(NTHREADS, 2) mixer_fwd(Params a) {
    extern __shared__ __attribute__((aligned(16))) unsigned char lds_raw[];
    volatile LAS unsigned* MISC = (volatile LAS unsigned*)((LAS unsigned char*)lds_raw + MISC_OFF);
    if (threadIdx.x < 32) MISC[threadIdx.x] = 0u;
    __syncthreads();
    XcdBarrier bar; bar.bar = (unsigned*)(a.ws + WS_CTL) + CW_BAR; bar.x = 0; bar.st = nullptr;
    if (FUSED) bar = xcd_barrier_post((unsigned*)(a.ws + WS_CTL) + CW_BAR, MISC + 8);
#define SEAM() do { if (FUSED) xcd_barrier_fn(bar.bar, bar.x, (unsigned)(unsigned long long)bar.st); } while (0)
#ifndef PHASE_MASK
#define PHASE_MASK 0xffff
#endif
#define RUN(k) ((((PHASE_MASK) & (PHMASK)) >> (k)) & 1)

    if (a.l_lo == 0 && RUN(0)) { PHASE_CTX(); phase_g0(a, C); SEAM(); }
    for (int L = a.l_lo; L < a.l_hi; ++L) {
        const bool moe = L & 1;
        if (RUN(1)) { PHASE_CTX(); phase_cvt(a, C, L); phase_norm(a, C, L, 0, L == 0 ? a.in[C.z + 0] : C.out, L == 0 ? a.in[C.z + 2] : WSP(float, WS_CTXB)); __syncthreads(); SEAM(); }
        if (RUN(2)) { PHASE_CTX(); pg8::Gemm g{WSP(bf16_t, WS_H), WSP(bf16_t, WS_W + W_IN), DM, DM, DM}; pg8::StaticOrder S; S.init(T, INW, C.G, C.bid); pg8::EpiIn E{WSP(bf16_t, WS_P)};
            pg8::gemm_phase(C.lds, C.tid, g, S, E); SEAM(); }
        if (RUN(3)) { PHASE_CTX(); phase_prep(a, C, L); __syncthreads(); SEAM(); }
        if (RUN(4)) { PHASE_CTX(); phase_mix(a, C, L); __syncthreads(); SEAM(); }
        if (RUN(5)) { PHASE_CTX(); phase_ret_scan(a, C, L); SEAM(); }
        if (RUN(6)) { PHASE_CTX(); phase_ret_out(a, C, L); SEAM(); }
        if (RUN(7)) { PHASE_CTX(); pg8::Gemm g{WSP(bf16_t, WS_BR), WSP(bf16_t, WS_W + W_BR), DM, 256, 256}; pg8::MergeOrder S; S.init(T, 4096, C.G, C.bid); pg8::EpiMerge E{WSP(bf16_t, WS_P)};
            pg8::gemm_phase(C.lds, C.tid, g, S, E); SEAM(); }
        if (RUN(8)) { PHASE_CTX(); phase_sum4(a, C); SEAM(); }
        if (RUN(9)) { PHASE_CTX(); pg8::Gemm g{WSP(bf16_t, WS_H), WSP(bf16_t, WS_W + W_OUT), DM, DM, DM}; pg8::StaticOrder S; S.init(T, DM, C.G, C.bid);
            pg8::EpiResid E{L == 0 ? a.in[C.z + 0] : C.out, L == 0 ? a.in[C.z + 2] : WSP(float, WS_CTXB), C.out, WSP(float, WS_CTXB), WSP(float, WS_MOD) + (size_t)L * 3 * 6144 + 2 * DM};
            pg8::gemm_phase(C.lds, C.tid, g, S, E); SEAM(); }
        if (RUN(10)) { PHASE_CTX(); phase_norm(a, C, L, 1, C.out, WSP(float, WS_CTXB)); SEAM(); }
        if (!moe) {
            if (RUN(11)) { PHASE_CTX(); pg8::Gemm g{WSP(bf16_t, WS_H), WSP(bf16_t, WS_W + W_13), DM, DM, DM}; pg8::StaticOrder S; S.init(T, 2 * DFF, C.G, C.bid); pg8::EpiSwiglu E{WSP(bf16_t, WS_P), DFF, 1 << 20};
                pg8::gemm_phase(C.lds, C.tid, g, S, E); SEAM(); }
            if (RUN(12)) { PHASE_CTX(); pg8::Gemm g{WSP(bf16_t, WS_P), WSP(bf16_t, WS_W + W_2), DFF, DFF, DFF}; pg8::StaticOrder S; S.init(T, DM, C.G, C.bid);
                pg8::EpiResid E{C.out, WSP(float, WS_CTXB), C.out, WSP(float, WS_CTXB), WSP(float, WS_MOD) + (size_t)L * 3 * 6144 + 5 * DM};
                pg8::gemm_phase(C.lds, C.tid, g, S, E); SEAM(); }
        } else {
            if (RUN(11)) { PHASE_CTX(); phase_gather(a, C, L); SEAM(); }
            if (RUN(12)) { PHASE_CTX(); pg8::Gemm g{WSP(bf16_t, WS_HG), WSP(bf16_t, WS_W + W_13), DM, DM, DM}; pg8::MoeOrder S{WSP(int, WS_ROUTE) + RT_META, 14, C.G, C.bid}; pg8::EpiSwiglu E{WSP(bf16_t, WS_HIDM), DFE, 14};
                pg8::gemm_phase(C.lds, C.tid, g, S, E); SEAM(); }
            if (RUN(13)) { PHASE_CTX(); pg8::Gemm g{WSP(bf16_t, WS_HIDM), WSP(bf16_t, WS_W + W_2), DFE, DFE, DFE}; pg8::MoeOrder S{WSP(int, WS_ROUTE) + RT_META, 4, C.G, C.bid};
                pg8::EpiMoe2 E{WSP(bf16_t, WS_HG), WSP(float, WS_ROUTE) + RT_ROWP, 4};
                pg8::gemm_phase(C.lds, C.tid, g, S, E); SEAM(); }
            if (RUN(14)) { PHASE_CTX(); phase_combine(a, C, L); SEAM(); }
        }
    }
#undef SEAM
#undef RUN
}

typedef void (*kern_t)(Params);
template <int PH> static kern_t phase_kernel() { return mixer_fwd<(1 << PH), false>; }
static kern_t get_kernel(int ph) {
    switch (ph) {
        case 0: return phase_kernel<0>(); case 1: return phase_kernel<1>(); case 2: return phase_kernel<2>(); case 3: return phase_kernel<3>(); case 4: return phase_kernel<4>();
        case 5: return phase_kernel<5>(); case 6: return phase_kernel<6>(); case 7: return phase_kernel<7>(); case 8: return phase_kernel<8>(); case 9: return phase_kernel<9>();
        case 10: return phase_kernel<10>(); case 11: return phase_kernel<11>(); case 12: return phase_kernel<12>(); case 13: return phase_kernel<13>(); default: return phase_kernel<14>();
    }
}
extern "C" void kernel_launch(void* const* d_in, const int* in_sizes, int n_in, void* d_out, int out_size, void* d_ws, size_t ws_size, hipStream_t stream) {
    static int grid = 0;
    if (grid == 0) {
        if (n_in != 29 || out_size != NBATCH * SEQ * DM || ws_size < WS_END) { fprintf(stderr, "kernel_launch: unexpected shapes (n_in %d, out %d, ws %zu < %zu)\n", n_in, out_size, ws_size, (size_t)WS_END); grid = -1; return; }
        int dev = 0, cus = 0;
        if (hipGetDevice(&dev) != hipSuccess || hipDeviceGetAttribute(&cus, hipDeviceAttributeMultiprocessorCount, dev) != hipSuccess) { grid = -1; return; }
#if MK_FUSED
        if (hipFuncSetAttribute((const void*)mixer_fwd<0x7fff, true>, hipFuncAttributeMaxDynamicSharedMemorySize, LDS_BYTES) != hipSuccess) { grid = -1; return; }
#else
        for (int ph = 0; ph < PH_PER_LAYER; ++ph) if (hipFuncSetAttribute((const void*)get_kernel(ph), hipFuncAttributeMaxDynamicSharedMemorySize, LDS_BYTES) != hipSuccess) { grid = -1; return; }
#endif
        (void)hipGetLastError();
        grid = cus;
    }
    if (grid < 0) return;
    (void)hipMemsetAsync((char*)d_ws + WS_CTL, 0, CTL_ZERO_BYTES, stream);
    Params p{};
    for (int i = 0; i < 29; ++i) p.in[i] = (const float*)d_in[i];
    p.out = (float*)d_out; p.ws = (unsigned char*)d_ws; p.pad = 0; p.ph_lo = 0; p.ph_hi = 0;
#if MK_FUSED
    p.l_lo = 0; p.l_hi = DEPTH; p.fused = 1;
    hipLaunchKernelGGL((mixer_fwd<0x7fff, true>), dim3(grid), dim3(NTHREADS), LDS_BYTES, stream, p);
#else
    p.fused = 0; p.l_lo = 0; p.l_hi = 1;
    hipLaunchKernelGGL(get_kernel(0), dim3(grid), dim3(NTHREADS), LDS_BYTES, stream, p);
#ifndef NL_RUN
#define NL_RUN DEPTH
#endif
    for (int L = 0; L < NL_RUN; ++L)
        for (int ph = 1; ph < PH_PER_LAYER; ++ph) {
            if (!(L & 1) && ph >= 13) continue;
            p.l_lo = L; p.l_hi = L + 1;
            hipLaunchKernelGGL(get_kernel(ph), dim3(grid), dim3(NTHREADS), LDS_BYTES, stream, p);
        }
#endif
}
```

```cpp
#include <hip/hip_runtime.h>
#include <cstdio>
#include <cstdint>

#ifndef MK_FUSED
#define MK_FUSED 1
#endif

#define DI __device__ __forceinline__
#define LAS __attribute__((address_space(3)))
#define GAS __attribute__((address_space(1)))
typedef unsigned short bf16_t;
typedef short bf16x8 __attribute__((ext_vector_type(8)));
typedef short s16x4 __attribute__((ext_vector_type(4)));
typedef float f32x4 __attribute__((ext_vector_type(4)));
typedef float f32x2 __attribute__((ext_vector_type(2)));
typedef float f32x16 __attribute__((ext_vector_type(16)));
typedef unsigned u32x4 __attribute__((ext_vector_type(4)));
typedef unsigned u32x2 __attribute__((ext_vector_type(2)));

constexpr int DM = 1024, NBATCH = 2, SEQ = 8192, CTXL = 256, TPB = SEQ + CTXL, T = NBATCH * TPB, DEPTH = 4;
constexpr int INW = 6656, DFF = 2816, NEXP = 8, DFE = 1792;
constexpr int C_U = 0, C_V = 256, C_WQ = 512, C_WK = 768, C_WV = 896, C_GQ = 1024, C_GK = 1280, C_GV = 1408, C_RQ = 1536, C_RK = 1792, C_RV = 2048, C_RG = 2304, C_GATE = 2560;
constexpr int NCHUNK = TPB / 128;
constexpr int NTILE_M = T / 256;
constexpr int MOE_ROWS = 2 * T + NEXP * 256;
constexpr float EPS = 1e-6f;
constexpr float LOG2E = 1.4426950408889634f;
constexpr float QSCALE = 0.125f * LOG2E;

constexpr size_t MiB = 1u << 20;
constexpr size_t WS_CTL = 0, CTL_ZERO_BYTES = 1 * MiB;
constexpr size_t WS_MOD = 1 * MiB;
constexpr size_t WS_L2G = 1 * MiB + 512 * 1024;
constexpr size_t WS_TAB = 2 * MiB;
constexpr size_t TAB_AXC = 0, TAB_AXS = 8192 * 32 * 4, TAB_SQC = 2 * 8192 * 32 * 4, TAB_SQS = TAB_SQC + 8448 * 32 * 4;
constexpr size_t WS_WSB = 7 * MiB;
constexpr size_t WS_CTXB = 8 * MiB;
constexpr size_t WS_ROUTE = 10 * MiB;
constexpr size_t WS_VT = 12 * MiB;
constexpr size_t WS_KVT = 21 * MiB;
constexpr size_t WS_SIN = 38 * MiB;
constexpr size_t WS_H = 47 * MiB;
constexpr size_t WS_BR = 80 * MiB;
constexpr size_t WS_P = 113 * MiB;
constexpr size_t WS_HG = WS_P, WS_HIDM = WS_P + 70 * MiB;
constexpr size_t WS_W = 328 * MiB;
constexpr size_t W_IN = 0, W_BR = 13 * MiB, W_OUT = 15 * MiB, W_13 = 17 * MiB, W_2 = 73 * MiB;
constexpr size_t WS_END = WS_W + 101 * MiB;
static_assert((size_t)T * INW * 2 <= 215 * MiB && WS_P + 215 * MiB <= WS_W, "P fits");
static_assert((size_t)MOE_ROWS * 1024 * 2 <= 70 * MiB && (size_t)MOE_ROWS * DFE * 2 + 70 * MiB <= 215 * MiB, "moe overlay fits");
constexpr int RT_E = 0;
constexpr int RT_POS = 2 * T;
constexpr int RT_PW = 4 * T;
constexpr int RT_ROWTOK = 6 * T;
constexpr int RT_ROWP = RT_ROWTOK + MOE_ROWS;
constexpr int RT_META = RT_ROWP + MOE_ROWS;
static_assert((size_t)(RT_META + 256) * 4 <= 2 * MiB, "route fits");
constexpr int CW_BAR = 4096;
constexpr int CW_CNT = 16384;

DI float bf2f(unsigned short h) { return __uint_as_float((unsigned)h << 16); }
DI unsigned f2bf(float f) { unsigned u = __float_as_uint(f); return (u + 0x7fffu + ((u >> 16) & 1u)) >> 16; }
DI unsigned pk2(float lo, float hi) { return f2bf(lo) | (f2bf(hi) << 16); }
DI float ex2(float x) { return __builtin_amdgcn_exp2f(x); }
DI float rcpf_(float x) { return __builtin_amdgcn_rcpf(x); }
DI float sigm(float x) { return rcpf_(1.f + ex2(-x * LOG2E)); }
DI float siluf_(float x) { return x * sigm(x); }
DI float gelu_tanh(float x) { const float u = 0.7978845608f * (x + 0.044715f * x * x * x); return x * sigm(2.f * u); }
DI float shx(float v, int o, int lane) { return __int_as_float(__builtin_amdgcn_ds_bpermute((lane ^ o) << 2, __float_as_int(v))); }
DI float wave_sum(float v, int lane) {
#pragma unroll
    for (int o = 1; o < 64; o <<= 1) v += shx(v, o, lane);
    return v;
}
DI int crow(int r, int hi) { return (r & 3) + 8 * (r >> 2) + 4 * hi; }
#define MFMA16(a, b, c) __builtin_amdgcn_mfma_f32_16x16x32_bf16((a), (b), (c), 0, 0, 0)
#define MFMA32(a, b, c) __builtin_amdgcn_mfma_f32_32x32x16_bf16((a), (b), (c), 0, 0, 0)

struct Params {
    const float* in[29];
    float* out; unsigned char* ws;
    int l_lo, l_hi, ph_lo, ph_hi, fused, pad;
};
DI const float* xrow_c(const float* lat, const float* ctx, int r) { const int b = r / TPB, p = r - b * TPB; return p < CTXL ? ctx + (size_t)(b * CTXL + p) * DM : lat + (size_t)(b * SEQ + p - CTXL) * DM; }
DI float* xrow(float* lat, float* ctx, int r) { const int b = r / TPB, p = r - b * TPB; return p < CTXL ? ctx + (size_t)(b * CTXL + p) * DM : lat + (size_t)(b * SEQ + p - CTXL) * DM; }
DI int modrow(int r) { const int b = r / TPB, p = r - b * TPB; return p < CTXL ? 2 : b; }

namespace pg8 {
constexpr int BM = 256, BK = 64, HALF = 128, HTB = HALF * BK * 2, STAGE_BYTES = 8 * HTB, NXCD = 8, WGM = 8;
DI int lds_byte(int r, int c) { const int st = (r >> 4) * 2 + (c >> 5), rr = r & 15, cc = c & 31, ob = rr * 64 + cc * 2; return st * 1024 + (ob ^ (((ob >> 9) & 1) << 5)); }
DI void stage_rc(int b, int& R, int& C) { const int st = b / 1024, sb = b % 1024, swz = sb ^ (((sb >> 9) & 1) << 5); R = (st >> 1) * 16 + swz / 64; C = (st & 1) * 32 + (swz % 64) / 2; }
DI int perm32(int rho) { const int n = rho >> 4, i = rho & 15; return 8 * (i >> 2) + 4 * n + (i & 3); }
struct Unit { int pm, pn; int aoff; };
struct Gemm { const bf16_t* A; const bf16_t* Bt; int lda, ldb, K; };

struct StaticOrder {
    int nM, nN, nwg, G, c;
    DI void init(int M, int N, int G_, int c_) { nM = M / BM; nN = N / BM; nwg = nM * nN; G = G_; c = c_; }
    DI bool next(int i, Unit& u) const {
        const long L = (long)i * G + c; if (L >= nwg) return false;
        int wgid = (int)L; { const int q = nwg / NXCD, r = nwg % NXCD, xcd = wgid % NXCD, off = wgid / NXCD; wgid = (xcd < r ? xcd * (q + 1) : r * (q + 1) + (xcd - r) * q) + off; }
        const int nig = WGM * nN, gid = wgid / nig, fm = gid * WGM, gsz = (nM - fm) < WGM ? (nM - fm) : WGM;
        u.pm = fm + ((wgid % nig) % gsz); u.pn = (wgid % nig) / gsz; u.aoff = 0; return true;
    }
};
struct MergeOrder : StaticOrder {
    DI bool next(int i, Unit& u) const { if (!StaticOrder::next(i, u)) return false; u.aoff = (u.pn >> 2) * 256 * 2; return true; }
};
struct MoeOrder {
    const int* meta; int nNl, G, c;
    DI bool next(int i, Unit& u) const {
        const int nrt = meta[0]; const long L = (long)i * G + c; if (L >= (long)nrt * nNl) return false;
        const int pm = (int)(L / nNl), pl = (int)(L % nNl); u.pm = pm; u.pn = meta[16 + pm] * nNl + pl; u.aoff = 0; return true;
    }
};

DI unsigned cvt_pk_bf16(float lo, float hi) { unsigned r; asm volatile("v_cvt_pk_bf16_f32 %0, %1, %2" : "=v"(r) : "v"(lo), "v"(hi)); return r; }

struct EpiIn {
    static constexpr bool PERM = true;
    bf16_t* O;
    DI void operator()(const f32x4 (&acc)[2][2][4][2], const Unit& u, int wr, int wc, int fr, int fq) const {
        const int row0 = u.pm * BM + wr * 64 + fr, col0 = u.pn * BM + wc * 32 + 8 * fq; const bool g = u.pn < 2;
#pragma unroll
        for (int ai = 0; ai < 2; ++ai)
#pragma unroll
            for (int m = 0; m < 4; ++m) { bf16_t* rowp = O + (size_t)(row0 + ai * HALF + m * 16) * INW + col0;
#pragma unroll
                for (int bj = 0; bj < 2; ++bj) { f32x4 v0 = acc[ai][bj][m][0], v1 = acc[ai][bj][m][1];
                    if (g) {
#pragma unroll
                        for (int e = 0; e < 4; ++e) { v0[e] = gelu_tanh(v0[e]); v1[e] = gelu_tanh(v1[e]); } }
                    u32x4 w; w.x = cvt_pk_bf16(v0[0], v0[1]); w.y = cvt_pk_bf16(v0[2], v0[3]); w.z = cvt_pk_bf16(v1[0], v1[1]); w.w = cvt_pk_bf16(v1[2], v1[3]);
                    *(u32x4*)(rowp + bj * HALF) = w; }
                asm volatile("" ::: "memory"); }
    }
};
struct EpiMerge {
    static constexpr bool PERM = true;
    bf16_t* P;
    DI void operator()(const f32x4 (&acc)[2][2][4][2], const Unit& u, int wr, int wc, int fr, int fq) const {
        const int row0 = u.pm * BM + wr * 64 + fr, col0 = C_GATE + u.pn * BM + wc * 32 + 8 * fq;
#pragma unroll
        for (int ai = 0; ai < 2; ++ai)
#pragma unroll
            for (int m = 0; m < 4; ++m) { bf16_t* rowp = P + (size_t)(row0 + ai * HALF + m * 16) * INW + col0;
#pragma unroll
                for (int bj = 0; bj < 2; ++bj)
#pragma unroll
                    for (int n = 0; n < 2; ++n) { const f32x4 v = acc[ai][bj][m][n];
                        const u32x2 gt = *(const u32x2*)(rowp + bj * HALF + 4 * n);
                        u32x2 w; w.x = cvt_pk_bf16(sigm(__uint_as_float(gt.x << 16)) * v[0], sigm(__uint_as_float(gt.x & 0xffff0000u)) * v[1]);
                        w.y = cvt_pk_bf16(sigm(__uint_as_float(gt.y << 16)) * v[2], sigm(__uint_as_float(gt.y & 0xffff0000u)) * v[3]);
                        *(u32x2*)(rowp + bj * HALF + 4 * n) = w; asm volatile("" ::: "memory"); }
                }
    }
};
struct EpiResid {
    static constexpr bool PERM = false;
    const float* baseLat; const float* baseCtx; float* outLat; float* outCtx; const float* gate;
    DI void operator()(const f32x4 (&acc)[2][2][4][2], const Unit& u, int wr, int wc, int fr, int fq) const {
        const int b = u.pm / 33, j = u.pm - b * 33;
        const float* bs = j == 0 ? baseCtx + (size_t)b * CTXL * DM : baseLat + (size_t)(b * SEQ + (j - 1) * 256) * DM;
        float* os = j == 0 ? outCtx + (size_t)b * CTXL * DM : outLat + (size_t)(b * SEQ + (j - 1) * 256) * DM;
        const float* gt = gate + (size_t)(j == 0 ? 2 : b) * 6144;
        const int col0 = u.pn * BM + wc * 32 + 4 * fq, r0 = wr * 64 + fr;
        f32x4 gv[2][2];
#pragma unroll
        for (int bj = 0; bj < 2; ++bj)
#pragma unroll
            for (int n = 0; n < 2; ++n) gv[bj][n] = *(const f32x4*)(gt + col0 + bj * HALF + n * 16);
#pragma unroll
        for (int ai = 0; ai < 2; ++ai)
#pragma unroll
            for (int m = 0; m < 4; ++m) { const size_t off = (size_t)(r0 + ai * HALF + m * 16) * DM + col0;
#pragma unroll
                for (int bj = 0; bj < 2; ++bj)
#pragma unroll
                    for (int n = 0; n < 2; ++n) { const f32x4 x = *(const f32x4*)(bs + off + bj * HALF + n * 16); *(f32x4*)(os + off + bj * HALF + n * 16) = x + gv[bj][n] * acc[ai][bj][m][n]; }
                asm volatile("" ::: "memory"); }
    }
};
struct EpiSwiglu {
    static constexpr bool PERM = true;
    bf16_t* O; int ldo; int nNl;
    DI void operator()(const f32x4 (&acc)[2][2][4][2], const Unit& u, int wr, int wc, int fr, int fq) const {
        const int row0 = u.pm * BM + wr * 64 + fr, col0 = (u.pn % nNl) * HALF + wc * 32 + 8 * fq;
#pragma unroll
        for (int ai = 0; ai < 2; ++ai)
#pragma unroll
            for (int m = 0; m < 4; ++m) { bf16_t* rowp = O + (size_t)(row0 + ai * HALF + m * 16) * ldo + col0;
                const f32x4 a0 = acc[ai][0][m][0], a1 = acc[ai][0][m][1], b0 = acc[ai][1][m][0], b1 = acc[ai][1][m][1];
                u32x4 w; w.x = cvt_pk_bf16(siluf_(a0[0]) * b0[0], siluf_(a0[1]) * b0[1]); w.y = cvt_pk_bf16(siluf_(a0[2]) * b0[2], siluf_(a0[3]) * b0[3]);
                w.z = cvt_pk_bf16(siluf_(a1[0]) * b1[0], siluf_(a1[1]) * b1[1]); w.w = cvt_pk_bf16(siluf_(a1[2]) * b1[2], siluf_(a1[3]) * b1[3]);
                *(u32x4*)rowp = w; asm volatile("" ::: "memory"); }
    }
};
struct EpiMoe2 {
    static constexpr bool PERM = true;
    bf16_t* Y; const float* rowp; int nNl;
    DI void operator()(const f32x4 (&acc)[2][2][4][2], const Unit& u, int wr, int wc, int fr, int fq) const {
        const int col0 = (u.pn % nNl) * BM + wc * 32 + 8 * fq, r0 = u.pm * BM + wr * 64 + fr;
#pragma unroll
        for (int ai = 0; ai < 2; ++ai)
#pragma unroll
            for (int m = 0; m < 4; ++m) { const int r = r0 + ai * HALF + m * 16; const float pw = rowp[r]; bf16_t* rowq = Y + (size_t)r * DM + col0;
#pragma unroll
                for (int bj = 0; bj < 2; ++bj) { const f32x4 v0 = acc[ai][bj][m][0] * pw, v1 = acc[ai][bj][m][1] * pw;
                    u32x4 w; w.x = cvt_pk_bf16(v0[0], v0[1]); w.y = cvt_pk_bf16(v0[2], v0[3]); w.z = cvt_pk_bf16(v1[0], v1[1]); w.w = cvt_pk_bf16(v1[2], v1[3]);
                    *(u32x4*)(rowq + bj * HALF) = w; }
                asm volatile("" ::: "memory"); }
    }
};

template <class Epi, class Sched>
DI void gemm_phase(LAS unsigned char* lds, const int tid, const Gemm g, const Sched& S, const Epi& E) {
    constexpr bool SP2 = true, ALIGN_EPI = true;
    const int wid = __builtin_amdgcn_readfirstlane(tid >> 6), lane = tid & 63, wr = wid >> 2, wc = wid & 3, fr = lane & 15, fq = lane >> 4;
    const int K = g.K, nt = K / BK;
    unsigned voffA[2], voffB[2];
#pragma unroll
    for (int i = 0; i < 2; ++i) { int R, C; stage_rc(tid * 16 + i * 8192, R, C); const int Rb = Epi::PERM ? ((R & ~31) + perm32(R & 31)) : R;
        voffA[i] = (unsigned)(R * g.lda + C) * 2u; voffB[i] = (unsigned)(Rb * g.ldb + C) * 2u; }
    const size_t kstep = (size_t)(BK * 2);
    const size_t hstepA = (size_t)HALF * g.lda * 2, hstepB = (size_t)HALF * g.ldb * 2;
    const size_t tstepA = 2 * hstepA, tstepB = 2 * hstepB;
    const unsigned ldsw = (unsigned)wid * 1024u;
    const int aoff = lds_byte(wr * 64 + fr, fq * 8), boff = lds_byte(wc * 32 + fr, fq * 8);
#define PG8_SA(b, h) (((b) * 2 + (h)) * HTB)
#define PG8_SB(b, h) ((4 + (b) * 2 + (h)) * HTB)
#define PG8_STAGE(bufoff, gbase, voff) do { _Pragma("unroll") for (int _i = 0; _i < 2; ++_i) \
        __builtin_amdgcn_global_load_lds((const unsigned*)((const char*)(gbase) + (voff)[_i]), (LAS unsigned*)(lds + (bufoff) + ldsw + _i * 8192), 16, 0, 0); } while (0)
#define PG8_LDA(dst, b, h) do { _Pragma("unroll") for (int m = 0; m < 4; ++m) _Pragma("unroll") for (int k = 0; k < 2; ++k) dst[m][k] = *(const LAS bf16x8*)(lds + PG8_SA(b, h) + aoff + m * 2048 + k * 1024); } while (0)
#define PG8_LDB(dst, b, h) do { _Pragma("unroll") for (int n = 0; n < 2; ++n) _Pragma("unroll") for (int k = 0; k < 2; ++k) dst[n][k] = *(const LAS bf16x8*)(lds + PG8_SB(b, h) + boff + n * 2048 + k * 1024); } while (0)
#define PG8_MMA(ai, bj, At, Bt) do { __builtin_amdgcn_s_setprio(1); _Pragma("unroll") for (int m = 0; m < 4; ++m) _Pragma("unroll") for (int n = 0; n < 2; ++n) _Pragma("unroll") for (int k = 0; k < 2; ++k) \
        acc[ai][bj][m][n] = __builtin_amdgcn_mfma_f32_16x16x32_bf16(Bt[n][k], At[m][k], acc[ai][bj][m][n], 0, 0, 0); __builtin_amdgcn_s_setprio(0); } while (0)
#define PG8_WAIT_V(n) asm volatile("s_waitcnt vmcnt(" #n ")" ::: "memory")
#define PG8_WAIT_L(n) asm volatile("s_waitcnt lgkmcnt(" #n ")" ::: "memory")
#define PG8_BAR __builtin_amdgcn_s_barrier()
#define PG8_SCHED __builtin_amdgcn_sched_barrier(0)
    Unit cur, nxt; int ui = 0;
    if (!S.next(0, cur)) return;
    f32x4 acc[2][2][4][2];
#pragma unroll
    for (int a = 0; a < 2; ++a)
#pragma unroll
        for (int b = 0; b < 2; ++b)
#pragma unroll
            for (int m = 0; m < 4; ++m)
#pragma unroll
                for (int n = 0; n < 2; ++n) acc[a][b][m][n] = (f32x4){0.f, 0.f, 0.f, 0.f};
    bf16x8 At[4][2], B0[2][2], B1[2][2];
    const char* cA = (const char*)g.A + (size_t)cur.pm * tstepA + cur.aoff; const char* cB = (const char*)g.Bt + (size_t)cur.pn * tstepB;
    PG8_STAGE(PG8_SB(0, 0), cB, voffB); PG8_STAGE(PG8_SB(0, 1), cB + hstepB, voffB); PG8_STAGE(PG8_SA(0, 0), cA, voffA); PG8_STAGE(PG8_SA(0, 1), cA + hstepA, voffA);
    if (wr == 1) PG8_BAR;
    PG8_WAIT_V(2); PG8_BAR;
    PG8_STAGE(PG8_SB(1, 0), cB + kstep, voffB); PG8_STAGE(PG8_SA(1, 0), cA + kstep, voffA); PG8_STAGE(PG8_SB(1, 1), cB + hstepB + kstep, voffB);
    PG8_WAIT_V(6); PG8_BAR;
    for (;;) {
        const bool has_next = S.next(ui + 1, nxt);
        const char* nA = has_next ? (const char*)g.A + (size_t)nxt.pm * tstepA + nxt.aoff : cA; const char* nB = has_next ? (const char*)g.Bt + (size_t)nxt.pn * tstepB : cB;
        for (int t = 0; t < nt; t += 2) {
            const bool last = (t == nt - 2);
            const char* a1 = cA + (size_t)(t + 1) * kstep;
            const char* a2 = last ? nA : cA + (size_t)(t + 2) * kstep; const char* b2 = last ? nB : cB + (size_t)(t + 2) * kstep;
            const char* a3 = a2 + kstep; const char* b3 = b2 + kstep;
            PG8_LDB(B0, 0, 0); PG8_LDB(B1, 0, 1); PG8_SCHED; PG8_LDA(At, 0, 0); PG8_STAGE(PG8_SA(1, 1), a1 + hstepA, voffA);
            PG8_WAIT_V(8); PG8_WAIT_L(0); PG8_BAR; PG8_MMA(0, 0, At, B0); PG8_MMA(0, 1, At, B1); PG8_BAR; PG8_SCHED;
            PG8_LDA(At, 0, 1); PG8_STAGE(PG8_SB(0, 0), b2, voffB); PG8_STAGE(PG8_SB(0, 1), b2 + hstepB, voffB); PG8_STAGE(PG8_SA(0, 0), a2, voffA);
            PG8_WAIT_V(8); PG8_WAIT_L(0); PG8_BAR; PG8_MMA(1, 0, At, B0); PG8_MMA(1, 1, At, B1); PG8_BAR; PG8_SCHED;
            PG8_LDB(B0, 1, 0); PG8_LDB(B1, 1, 1); PG8_SCHED; PG8_LDA(At, 1, 0); PG8_STAGE(PG8_SA(0, 1), a2 + hstepA, voffA);
            PG8_WAIT_V(8); PG8_WAIT_L(0); PG8_BAR; PG8_MMA(0, 0, At, B0); PG8_MMA(0, 1, At, B1); PG8_BAR; PG8_SCHED;
            PG8_LDA(At, 1, 1); PG8_STAGE(PG8_SB(1, 0), b3, voffB); PG8_STAGE(PG8_SB(1, 1), b3 + hstepB, voffB); PG8_STAGE(PG8_SA(1, 0), a3, voffA);
            PG8_WAIT_V(8); PG8_WAIT_L(0); PG8_BAR; PG8_MMA(1, 0, At, B0); PG8_MMA(1, 1, At, B1); PG8_BAR; PG8_SCHED;
        }
        if constexpr (ALIGN_EPI) { if (wr == 0) PG8_BAR; }
        E(acc, cur, wr, wc, fr, fq);
        if (!has_next) break;
#pragma unroll
        for (int a = 0; a < 2; ++a)
#pragma unroll
            for (int b = 0; b < 2; ++b)
#pragma unroll
                for (int m = 0; m < 4; ++m)
#pragma unroll
                    for (int n = 0; n < 2; ++n) acc[a][b][m][n] = (f32x4){0.f, 0.f, 0.f, 0.f};
        cur = nxt; cA = nA; cB = nB; ++ui;
        if constexpr (ALIGN_EPI) { if (wr == 1) PG8_BAR; }
    }
    PG8_WAIT_V(0);
    if constexpr (!ALIGN_EPI) { if (wr == 0) PG8_BAR; }
    PG8_BAR;
#undef PG8_SA
#undef PG8_SB
#undef PG8_STAGE
#undef PG8_LDA
#undef PG8_LDB
#undef PG8_MMA
#undef PG8_WAIT_V
#undef PG8_WAIT_L
#undef PG8_BAR
#undef PG8_SCHED
}
}

#define XB_TMO      128
#define XB_XCNT(j)  (256  + 64 * (j))
#define XB_XSUB(j)  (1280 + 64 * (j))
#define XB_XGEN(j)  (2304 + 64 * (j))
#define XB_TOP      3328
#define XB_TOPGEN   3392
#define XCD_BAR_WORDS 3456
#define XB_SPIN_CAP (1u << 18)
DI unsigned xb_ld(unsigned* p)              { return __hip_atomic_load(p, __ATOMIC_RELAXED, __HIP_MEMORY_SCOPE_AGENT); }
DI unsigned xb_add(unsigned* p, unsigned v) { return __hip_atomic_fetch_add(p, v, __ATOMIC_RELAXED, __HIP_MEMORY_SCOPE_AGENT); }
DI unsigned xb_xcc_id() { return (unsigned)__builtin_amdgcn_s_getreg((3 << 11) | 20) & 0xFu; }
#define XB_SPIN(cond, bar) do { unsigned _sp = 0; while (cond) { __builtin_amdgcn_s_sleep(1); \
    if ((++_sp & 255u) == 0u) { if (xb_ld(&(bar)[XB_TMO])) break; if (_sp > XB_SPIN_CAP) { atomicAdd(&(bar)[XB_TMO], 1u); break; } } } } while (0)
struct XcdBarrier { unsigned* bar; unsigned x; volatile LAS unsigned* st; };
DI XcdBarrier xcd_barrier_post(unsigned* bar, volatile LAS unsigned* st) {
    XcdBarrier b; b.bar = bar; b.x = xb_xcc_id(); b.st = st;
    if (threadIdx.x == 0) (void)xb_add(&bar[XB_XCNT(b.x)], 1u);
    return b;
}
DI void xcd_barrier_complete(unsigned* bar, unsigned x, unsigned& nloc, unsigned& nx) {
    const unsigned G = gridDim.x * gridDim.y * gridDim.z;
    unsigned sum, cnt, mine, sp = 0u;
    for (;;) {
        sum = 0u; cnt = 0u; mine = 0u;
#pragma unroll
        for (unsigned j = 0; j < 16; ++j) { const unsigned c = xb_ld(&bar[XB_XCNT(j)]); sum += c; cnt += (c > 0u) ? 1u : 0u; mine = (j == x) ? c : mine; }
        if (sum == G) break;
        __builtin_amdgcn_s_sleep(1);
        if ((++sp & 255u) == 0u) { if (xb_ld(&bar[XB_TMO])) break; if (sp > XB_SPIN_CAP) { atomicAdd(&bar[XB_TMO], 1u); break; } }
    }
    nloc = mine > 0u ? mine : 1u; nx = cnt > 0u ? cnt : 1u;
}
__device__ __attribute__((noinline)) void xcd_barrier_fn(unsigned* bar_, unsigned x_, unsigned st_off) {
    XcdBarrier b; { const unsigned hi_ = (unsigned)__builtin_amdgcn_readfirstlane((int)((unsigned long long)bar_ >> 32)), lo_ = (unsigned)__builtin_amdgcn_readfirstlane((int)(unsigned)(unsigned long long)bar_);
      b.bar = (unsigned*)(((unsigned long long)hi_ << 32) | (unsigned long long)lo_); }
    b.x = (unsigned)__builtin_amdgcn_readfirstlane((int)x_); b.st = (volatile LAS unsigned*)(unsigned long long)(unsigned)__builtin_amdgcn_readfirstlane((int)st_off);
    asm volatile("s_waitcnt vmcnt(0)" ::: "memory");
    __syncthreads();
    if (threadIdx.x == 0) {
        unsigned* bar = b.bar;
        __builtin_amdgcn_s_waitcnt(0);
        unsigned nloc = b.st[0], nx = b.st[1];
        if (nloc == 0u) { xcd_barrier_complete(bar, b.x, nloc, nx); b.st[0] = nloc; b.st[1] = nx; }
        const unsigned old = xb_add(&bar[XB_XSUB(b.x)], 1u);
        const unsigned gen = old / nloc;
        if (old + 1u == (gen + 1u) * nloc) {
            __builtin_amdgcn_fence(__ATOMIC_RELEASE, "agent");
            asm volatile("s_waitcnt vmcnt(0)" ::: "memory");
            const unsigned og = xb_add(&bar[XB_TOP], 1u);
            const unsigned tg = og / nx;
            if (og + 1u == (tg + 1u) * nx) xb_add(&bar[XB_TOPGEN], 1u);
            else XB_SPIN(xb_ld(&bar[XB_TOPGEN]) == tg, bar);
            __builtin_amdgcn_fence(__ATOMIC_ACQUIRE, "agent");
            xb_add(&bar[XB_XGEN(b.x)], 1u);
            asm volatile("s_waitcnt vmcnt(0)" ::: "memory");
        } else {
            XB_SPIN(xb_ld(&bar[XB_XGEN(b.x)]) == gen, bar);
            __builtin_amdgcn_fence(__ATOMIC_ACQUIRE, "agent");
            asm volatile("s_waitcnt vmcnt(0)" ::: "memory");
        }
    }
    __syncthreads();
}

#include <hip/hip_bf16.h>
#include <cmath>
namespace attn_body {
using bf16=__hip_bfloat16;
using bf16x8=__attribute__((ext_vector_type(8)))short;
using s16x4=__attribute__((ext_vector_type(4)))short;
using f32x16=__attribute__((ext_vector_type(16)))float;
using u32x4=__attribute__((ext_vector_type(4)))unsigned;
constexpr int D=64,PQ=6656,PO=1024,TPBA=8448,NKT=TPBA/64;
constexpr int NW=8,QBLK=32,QB=QBLK*NW,KVBLK=64;
__device__ __forceinline__ int crow(int r,int hi){return (r&3)+8*(r>>2)+4*hi;}
#define SBAR() __builtin_amdgcn_sched_barrier(0)
__device__ __forceinline__ void cmask(f32x16&p0,f32x16&p1,int jb,int qrel,int hi){
  const float NEG=-INFINITY; int kb=64*jb+4*hi;
  #pragma unroll
  for(int r=0;r<16;++r){int kv=kb+(r&3)+8*(r>>2); if(kv>qrel)p0[r]=NEG; if(kv+32>qrel)p1[r]=NEG;}
}

constexpr int NSLOT=3, SLOTB=8192;
constexpr int LDS_K=0, LDS_V=NSLOT*SLOTB, LDS_WS=2*NSLOT*SLOTB, LDS_OST=LDS_WS+NW*64*4, LDS_BYTES=LDS_OST+NW*4096;
constexpr float C2=0.125f*1.4426950408889634f;
__device__ __forceinline__ void glds16(const void*gsrc,unsigned lds_dst){unsigned keep;
  asm volatile("s_mov_b32 %0, m0\n\ts_mov_b32 m0, %2\n\ts_nop 0\n\tglobal_load_lds_dwordx4 %1, off\n\ts_mov_b32 m0, %0":"=&s"(keep):"v"(gsrc),"s"(lds_dst):"memory");}
__device__ __forceinline__ float max3f(float a,float b,float c){float r;asm("v_max3_f32 %0, %1, %2, %3":"=v"(r):"v"(a),"v"(b),"v"(c));return r;}
__device__ __forceinline__ float max2f(float a,float b){float r;asm("v_max_f32_e32 %0, %1, %2":"=v"(r):"v"(a),"v"(b));return r;}
__device__ __forceinline__ float fadd_s(float a,float b){float r;asm("v_add_f32_e32 %0, %1, %2":"=v"(r):"v"(a),"v"(b));return r;}
__device__ __forceinline__ float fsub_s(float a,float b){float r;asm("v_sub_f32_e32 %0, %1, %2":"=v"(r):"v"(a),"v"(b));return r;}
typedef float f32x2_t __attribute__((ext_vector_type(2))); typedef __bf16 bf16x2_t __attribute__((ext_vector_type(2)));
__device__ __forceinline__ unsigned cvtpk_s(float lo,float hi){f32x2_t v={lo,hi};bf16x2_t b=__builtin_convertvector(v,bf16x2_t);return __builtin_bit_cast(unsigned,b);}
#define WAIT_BAR(N) asm volatile("s_waitcnt vmcnt(" #N ") lgkmcnt(0)\n\ts_barrier":::"memory")

__device__ __forceinline__ void qkt(f32x16&p0,f32x16&p1,const char*Kslot,const bf16x8*qr,const f32x16&negm,int r32,int hi){
  const char*kb=Kslot+hi*1024+r32*16;
  #pragma unroll
  for(int d0=0;d0<4;++d0){
    const bf16x8 b0=*reinterpret_cast<const bf16x8*>(kb+d0*2048);
    const bf16x8 b1=*reinterpret_cast<const bf16x8*>(kb+d0*2048+512);
    if(d0==0){p0=__builtin_amdgcn_mfma_f32_32x32x16_bf16(b0,qr[0],negm,0,0,0);p1=__builtin_amdgcn_mfma_f32_32x32x16_bf16(b1,qr[0],negm,0,0,0);}
    else{p0=__builtin_amdgcn_mfma_f32_32x32x16_bf16(b0,qr[d0],p0,0,0,0);p1=__builtin_amdgcn_mfma_f32_32x32x16_bf16(b1,qr[d0],p1,0,0,0);}}
}
typedef __attribute__((address_space(3))) const char* lds_cptr;
typedef short v4i16_t __attribute__((ext_vector_type(4)));
__device__ __forceinline__ void kload8(bf16x8*kf,lds_cptr kp){
  kf[0]=*(const __attribute__((address_space(3))) bf16x8*)(kp);      kf[1]=*(const __attribute__((address_space(3))) bf16x8*)(kp+512);
  kf[2]=*(const __attribute__((address_space(3))) bf16x8*)(kp+2048); kf[3]=*(const __attribute__((address_space(3))) bf16x8*)(kp+2560);
  kf[4]=*(const __attribute__((address_space(3))) bf16x8*)(kp+4096); kf[5]=*(const __attribute__((address_space(3))) bf16x8*)(kp+4608);
  kf[6]=*(const __attribute__((address_space(3))) bf16x8*)(kp+6144); kf[7]=*(const __attribute__((address_space(3))) bf16x8*)(kp+6656);
}
__device__ __forceinline__ void kload2(bf16x8*kf,lds_cptr kp,int j){ kf[2*j]=*(const __attribute__((address_space(3))) bf16x8*)(kp+j*2048); kf[2*j+1]=*(const __attribute__((address_space(3))) bf16x8*)(kp+j*2048+512); }
__device__ __forceinline__ s16x4 vtr(lds_cptr p){ return __builtin_bit_cast(s16x4,__builtin_amdgcn_ds_read_tr16_b64_v4i16((__attribute__((address_space(3))) v4i16_t*)p)); }
__device__ __forceinline__ float rowmax(const f32x16&p0,const f32x16&p1){
  float a=max3f(p0[0],p0[1],p1[0]),b=max3f(p0[2],p0[3],p1[1]);a=max3f(a,p1[2],p1[3]);
  #pragma unroll
  for(int r=4;r<16;r+=4){a=max3f(a,p0[r],p0[r+1]);b=max3f(b,p0[r+2],p0[r+3]);a=max3f(a,p1[r],p1[r+1]);b=max3f(b,p1[r+2],p1[r+3]);}
  const float m=max2f(a,b);
  auto rr=__builtin_amdgcn_permlane32_swap(__float_as_uint(m),__float_as_uint(m),false,false);
  return max2f(__uint_as_float(rr[0]),__uint_as_float(rr[1]));
}
__device__ __forceinline__ void pv(f32x16*o,int vb,bf16x8 pa0,bf16x8 pa1,bf16x8 pa2,bf16x8 pa3){
  #pragma unroll
  for(int d0=0;d0<2;++d0){s16x4 lo[4],hi[4];
    #pragma unroll
    for(int ks=0;ks<4;++ks){
      asm volatile("ds_read_b64_tr_b16 %0,%1 offset:%c2":"=&v"(lo[ks]):"v"(vb),"i"(d0*4096+ks*1024):"memory");
      asm volatile("ds_read_b64_tr_b16 %0,%1 offset:%c2":"=&v"(hi[ks]):"v"(vb),"i"(d0*4096+ks*1024+512):"memory");}
    asm volatile("s_waitcnt lgkmcnt(0)":::"memory");SBAR();
    #define PK(k) (bf16x8){lo[k][0],lo[k][1],lo[k][2],lo[k][3],hi[k][0],hi[k][1],hi[k][2],hi[k][3]}
    o[d0]=__builtin_amdgcn_mfma_f32_32x32x16_bf16(pa0,PK(0),o[d0],0,0,0);
    o[d0]=__builtin_amdgcn_mfma_f32_32x32x16_bf16(pa1,PK(1),o[d0],0,0,0);
    o[d0]=__builtin_amdgcn_mfma_f32_32x32x16_bf16(pa2,PK(2),o[d0],0,0,0);
    o[d0]=__builtin_amdgcn_mfma_f32_32x32x16_bf16(pa3,PK(3),o[d0],0,0,0);
    #undef PK
  }
}

#ifndef ATTN_STORE16
#define ATTN_STORE16(p,v) (*(u32x4*)(p)=(v))
#endif
template<int THRL> __device__ __forceinline__ void attn_unit(long qrow0,long krow0,int qcol,int kcol,int vcol,int ocol,const bf16*Pb,bf16*Ob,char*shm,const int tid,const float zf){
  const int lane=tid&63,r32=lane&31,hi=lane>>5; const int wid=__builtin_amdgcn_readfirstlane(tid>>6);
  const bf16*Qw=Pb+(qrow0+wid*QBLK)*PQ+qcol;
  const bf16*Kh=Pb+krow0*PQ+kcol,*Vh=Pb+krow0*PQ+vcol;
  const unsigned lds0=(unsigned)(uintptr_t)shm;
  float*wsf=(float*)(shm+LDS_WS)+wid*64;
  const bf16*ksrc=Kh+(long)lane*PQ+wid*8;
  const bf16*vsrc=Vh+(long)(16*(wid&3)+(lane>>2))*PQ+(wid>>2)*32+(lane&3)*8;
  const unsigned kdst=lds0+LDS_K+wid*1024, vdst=lds0+LDS_V+wid*1024;
  #define DMA_K(t,slot) glds16(ksrc+(long)(t)*KVBLK*PQ,(unsigned)__builtin_amdgcn_readfirstlane(kdst+(slot)))
  #define DMA_V(t,slot) glds16(vsrc+(long)(t)*KVBLK*PQ,(unsigned)__builtin_amdgcn_readfirstlane(vdst+(slot)))
  const int vb0=(int)(lds0+LDS_V)+((lane>>4)&1)*32+(lane&3)*8+(4*hi+((lane&15)>>2))*64;
  const char*Kbase=shm+LDS_K; bf16x8 kf[8];
  const lds_cptr shm3=(lds_cptr)shm; const lds_cptr kp0=shm3+LDS_K+hi*1024+r32*16; const lds_cptr vp0=shm3+LDS_V+((lane>>4)&1)*32+(lane&3)*8+(4*hi+((lane&15)>>2))*64;
  const int NT=NKT;
  DMA_K(0,0);DMA_V(0,0);DMA_K(1,SLOTB);
  bf16x8 qr[4];
  #pragma unroll
  for(int d0=0;d0<4;++d0)qr[d0]=*reinterpret_cast<const bf16x8*>(&Qw[(long)r32*PQ+d0*16+hi*8]);
  float mhat=0.f,l_reg=0.f;f32x16 o[2];f32x16 negm;
  _Pragma("unroll") for(int r=0;r<16;++r){o[0][r]=zf;o[1][r]=zf;negm[r]=zf;} asm volatile("":"+v"(negm));
  #define CMASK(P0,P1,t) do{}while(0)
  bool resc=false;
  #define START(P0,P1) do{ const float rm=rowmax(P0,P1); resc=false; \
    { const float dl=rm; mhat=fadd_s(mhat,dl); \
      _Pragma("unroll") for(int r=0;r<16;++r){P0[r]=fsub_s(P0[r],dl);P1[r]=fsub_s(P1[r],dl);} \
      _Pragma("unroll") for(int r=0;r<16;++r)negm[r]=-mhat; asm volatile("":"+v"(negm)); } \
    _Pragma("unroll") for(int r=0;r<16;++r)P0[r]=__builtin_amdgcn_exp2f(P0[r]); }while(0)
  #define RESC() do{ if(resc){ asm volatile("s_waitcnt lgkmcnt(0)":::"memory"); \
      _Pragma("unroll") for(int d_=0;d_<2;++d_) _Pragma("unroll") for(int r=0;r<16;++r)o[d_][r]*=wsf[crow(r,hi)]; } }while(0)
  f32x16 pA0,pA1,pB0,pB1;
  int sl_prev=0,sl_cur=0,sl_next=SLOTB;
  #define ROT() do{sl_prev=sl_cur;sl_cur=sl_next;sl_next=(sl_next==(NSLOT-1)*SLOTB)?0:sl_next+SLOTB;}while(0)
  DMA_K(2,2*SLOTB);
  WAIT_BAR(3);
  qkt(pA0,pA1,Kbase,qr,negm,r32,hi);asm volatile("s_nop 15\n\ts_nop 7":"+v"(pA0),"+v"(pA1));CMASK(pA0,pA1,0);
  START(pA0,pA1);
  _Pragma("unroll") for(int r=0;r<16;++r)pA1[r]=__builtin_amdgcn_exp2f(pA1[r]);
  WAIT_BAR(0);
  DMA_K(3,0);DMA_V(1,SLOTB);
  ROT();
  kload8(kf,kp0+sl_cur);
  WAIT_BAR(2);
  s16x4 vlo[8],vhi[8]; u32x4 pw0,pw1,pw2,pw3;
  #define PKW(P,B) cvtpk_s(P[B],P[B+1])
  #define PAF(k) __builtin_bit_cast(bf16x8,pw##k)
  #define VFR(i) (bf16x8){vlo[i][0],vlo[i][1],vlo[i][2],vlo[i][3],vhi[i][0],vhi[i][1],vhi[i][2],vhi[i][3]}
  #define PIN(x) asm volatile("":"+v"(x))
  #define MX3(a,b,c) __builtin_fmaxf(__builtin_fmaxf((a),(b)),(c))
  #define GAPA(MF,A0,A1,A2,A3,W0,W1,PW) do{ MF; sacc+=A0; sacc+=A1; sacc+=A2; sacc+=A3; PIN(sacc); W0; W1; PIN(PW); SBAR(); }while(0)
  #define EX(v) __builtin_amdgcn_exp2f(v)
  #define GAPB(MF,X,B) do{ MF; X[B]=EX(X[B]); X[B+1]=EX(X[B+1]); X[B+2]=EX(X[B+2]); X[B+3]=EX(X[B+3]); PIN(X); SBAR(); }while(0)
  #define VRD(i) do{ vlo[i]=vtr(vp_+(((i)>>2)*4096+((i)&3)*1024)); vhi[i]=vtr(vp_+(((i)>>2)*4096+((i)&3)*1024+512)); }while(0)
  #define KRD(G,j) do{ if(G){ kload2(kf,kp0+sl_next,j); SBAR(); } }while(0)
  #define STEP(C0,C1,P0,P1,t,GK,GV,GL) do{ SBAR(); \
    const lds_cptr vp_=vp0+sl_prev; \
    VRD(0); SBAR(); float sacc=(P0[0]+P0[1]); \
    GAPA(C0=__builtin_amdgcn_mfma_f32_32x32x16_bf16(kf[0],qr[0],negm,0,0,0), P0[2],P0[3],P0[4],P0[5],     pw0[0]=PKW(P0,0), pw0[1]=PKW(P0,2), pw0); \
    VRD(4); SBAR(); GAPA(C1=__builtin_amdgcn_mfma_f32_32x32x16_bf16(kf[1],qr[0],negm,0,0,0), P0[6],P0[7],P0[8],P0[9],     pw0[2]=PKW(P0,4), pw0[3]=PKW(P0,6), pw0); \
    VRD(1); SBAR(); GAPA(C0=__builtin_amdgcn_mfma_f32_32x32x16_bf16(kf[2],qr[1],C0,0,0,0),   P0[10],P0[11],P0[12],P0[13], pw1[0]=PKW(P0,8), pw1[1]=PKW(P0,10), pw1); \
    VRD(5); SBAR(); GAPA(C1=__builtin_amdgcn_mfma_f32_32x32x16_bf16(kf[3],qr[1],C1,0,0,0),   P0[14],P0[15],P1[0],P1[1],   pw1[2]=PKW(P0,12),pw1[3]=PKW(P0,14), pw1); \
    VRD(2); SBAR(); GAPA(C0=__builtin_amdgcn_mfma_f32_32x32x16_bf16(kf[4],qr[2],C0,0,0,0),   P1[2],P1[3],P1[4],P1[5],     pw2[0]=PKW(P1,0), pw2[1]=PKW(P1,2), pw2); \
    VRD(6); SBAR(); GAPA(C1=__builtin_amdgcn_mfma_f32_32x32x16_bf16(kf[5],qr[2],C1,0,0,0),   P1[6],P1[7],P1[8],P1[9],     pw2[2]=PKW(P1,4), pw2[3]=PKW(P1,6), pw2); \
    VRD(3); SBAR(); GAPA(C0=__builtin_amdgcn_mfma_f32_32x32x16_bf16(kf[6],qr[3],C0,0,0,0),   P1[10],P1[11],P1[12],P1[13], pw3[0]=PKW(P1,8), pw3[1]=PKW(P1,10), pw3); \
    VRD(7); SBAR(); GAPA(C1=__builtin_amdgcn_mfma_f32_32x32x16_bf16(kf[7],qr[3],C1,0,0,0),   P1[14],P1[15],0.f,0.f,       pw3[2]=PKW(P1,12),pw3[3]=PKW(P1,14), pw3); \
    l_reg+=sacc; \
    if(GK){DMA_K((t)+3,sl_cur);} if(GV){DMA_V((t)+1,sl_next);} \
    CMASK(C0,C1,t); \
    { float a=MX3(C0[0],C0[1],C1[0]),b=MX3(C0[2],C0[3],C1[1]); a=MX3(a,C1[2],C1[3]); \
      _Pragma("unroll") for(int r=4;r<16;r+=4){a=MX3(a,C0[r],C0[r+1]);b=MX3(b,C0[r+2],C0[r+3]);a=MX3(a,C1[r],C1[r+1]);b=MX3(b,C1[r+2],C1[r+3]);} \
      float rm=__builtin_fmaxf(a,b); { auto rr=__builtin_amdgcn_permlane32_swap(__float_as_uint(rm),__float_as_uint(rm),false,false); rm=__builtin_fmaxf(__uint_as_float(rr[0]),__uint_as_float(rr[1])); } \
      resc=false; \
      if(__builtin_expect(__any(rm>(float)THRL),0)){ const float dl=__builtin_fmaxf(rm,0.f); mhat+=dl; \
        _Pragma("unroll") for(int r=0;r<16;++r){C0[r]-=dl;C1[r]-=dl;} \
        _Pragma("unroll") for(int r=0;r<16;++r)negm[r]=-mhat; asm volatile("":"+v"(negm)); \
        const float f=__builtin_amdgcn_exp2f(-dl); l_reg*=f; if(hi==0)wsf[r32]=f; resc=true; } } \
    SBAR(); \
    GAPB(o[0]=__builtin_amdgcn_mfma_f32_32x32x16_bf16(PAF(0),VFR(0),o[0],0,0,0), C0,0); \
    GAPB(o[1]=__builtin_amdgcn_mfma_f32_32x32x16_bf16(PAF(0),VFR(4),o[1],0,0,0), C0,4); \
    KRD(GL,0); GAPB(o[0]=__builtin_amdgcn_mfma_f32_32x32x16_bf16(PAF(1),VFR(1),o[0],0,0,0), C0,8); \
    KRD(GL,1); GAPB(o[1]=__builtin_amdgcn_mfma_f32_32x32x16_bf16(PAF(1),VFR(5),o[1],0,0,0), C0,12); \
    KRD(GL,2); GAPB(o[0]=__builtin_amdgcn_mfma_f32_32x32x16_bf16(PAF(2),VFR(2),o[0],0,0,0), C1,0); \
    KRD(GL,3); GAPB(o[1]=__builtin_amdgcn_mfma_f32_32x32x16_bf16(PAF(2),VFR(6),o[1],0,0,0), C1,4); \
    GAPB(o[0]=__builtin_amdgcn_mfma_f32_32x32x16_bf16(PAF(3),VFR(3),o[0],0,0,0), C1,8); \
    GAPB(o[1]=__builtin_amdgcn_mfma_f32_32x32x16_bf16(PAF(3),VFR(7),o[1],0,0,0), C1,12); \
    }while(0)
  int t=1;
  #undef CMASK
  #define CMASK(P0,P1,t) do{}while(0)
  _Pragma("nounroll") for(;t+5<NT;t+=2){
    STEP(pB0,pB1,pA0,pA1,t,true,true,true);     WAIT_BAR(2); RESC(); ROT();
    STEP(pA0,pA1,pB0,pB1,t+1,true,true,true);   WAIT_BAR(2); RESC(); ROT();
  }
  #undef CMASK
  #define CMASK(P0,P1,t) do{}while(0)
  #define ENDW(tt) do{ if((tt)+3<NT){WAIT_BAR(2);} else if((tt)+2<NT){WAIT_BAR(1);} else {WAIT_BAR(0);} }while(0)
  _Pragma("nounroll") for(;t+1<NT;t+=2){
    STEP(pB0,pB1,pA0,pA1,t,(t+3<NT),(t+1<NT),(t+1<NT));       ENDW(t);   RESC(); ROT();
    STEP(pA0,pA1,pB0,pB1,t+1,(t+4<NT),(t+2<NT),(t+2<NT));     ENDW(t+1); RESC(); ROT();
  }
  STEP(pB0,pB1,pA0,pA1,NT-1,false,false,false); RESC();
  { float sacc=pB0[0]+pB0[1]; _Pragma("unroll") for(int r=2;r<16;++r)sacc+=pB0[r]; _Pragma("unroll") for(int r=0;r<16;++r)sacc+=pB1[r]; l_reg+=sacc;
    pw0=(u32x4){PKW(pB0,0),PKW(pB0,2),PKW(pB0,4),PKW(pB0,6)};pw1=(u32x4){PKW(pB0,8),PKW(pB0,10),PKW(pB0,12),PKW(pB0,14)};pw2=(u32x4){PKW(pB1,0),PKW(pB1,2),PKW(pB1,4),PKW(pB1,6)};pw3=(u32x4){PKW(pB1,8),PKW(pB1,10),PKW(pB1,12),PKW(pB1,14)};
    SBAR(); pv(o,vb0+sl_cur,PAF(0),PAF(1),PAF(2),PAF(3)); }
  #undef PKW
  #undef PAF
  #undef VFR
  #undef PIN
  #undef MX3
  #undef GAPA
  #undef GAPB
  #undef EX
  #undef VRD
  #undef KRD
  #undef STEP
  #undef ENDW
  {auto rr=__builtin_amdgcn_permlane32_swap(__float_as_uint(l_reg),__float_as_uint(l_reg),false,false);l_reg=__uint_as_float(rr[0])+__uint_as_float(rr[1]);}
  if(hi==0)wsf[32+r32]=l_reg;asm volatile("s_waitcnt lgkmcnt(0)":::"memory");
  float rli[16];
  #pragma unroll
  for(int r=0;r<16;++r)rli[r]=__builtin_amdgcn_rcpf(wsf[32+crow(r,hi)]);
  bf16*Ow=Ob+(qrow0+wid*QBLK)*PO+ocol;
  { bf16*stg=(bf16*)(shm+LDS_OST)+wid*2048;
    #pragma unroll
    for(int r=0;r<16;++r){const int orow=crow(r,hi);
      #pragma unroll
      for(int d0=0;d0<2;++d0)stg[orow*64+d0*32+r32]=__float2bfloat16(o[d0][r]*rli[r]);}
    asm volatile("s_waitcnt lgkmcnt(0)":::"memory");
    #pragma unroll
    for(int i=0;i<4;++i){const int row=i*8+(lane>>3),ch=lane&7; const u32x4 v=*(const u32x4*)(stg+row*64+ch*8); ATTN_STORE16(Ow+(long)row*PO+ch*8,v);} }
  asm volatile("s_waitcnt lgkmcnt(0)\n\ts_barrier":::"memory");
  #undef DMA_K
  #undef DMA_V
  #undef CMASK
  #undef START
  #undef RESC
  #undef ROT
}
constexpr int ATTN_LDS_BYTES=LDS_BYTES;
#undef SBAR
#undef WAIT_BAR
}

constexpr int NWAVES = 8, NTHREADS = 512;
constexpr int RING_BYTES = 131072, MISC_OFF = RING_BYTES + 320, LDS_BYTES = 147456;

struct Ctx {
    LAS unsigned char* lds; int tid, lane, wave, G, bid, z;
    float* out; unsigned char* ws;
};
#define WSP(T_, off) ((T_*)(C.ws + (off)))

DI float log2_sigmoid(float x) { return -log1pf(expf(-x)) * LOG2E; }
DI void phase_g0(const Params& a, const Ctx& C) {
    const float* cvec = a.in[C.z + 1]; const float* cctx = a.in[C.z + 3]; const float* w_mod = a.in[C.z + 4]; const float* b_mod = a.in[C.z + 5];
    float* mod = WSP(float, WS_MOD);
    LAS float* red = (LAS float*)C.lds;
    for (int u = C.bid; u < DEPTH * 96; u += C.G) {
        const int L = u / 96, cg = u % 96, col = cg * 64 + C.lane;
        float a0 = 0.f, a1 = 0.f, a2 = 0.f;
        const float* w = w_mod + (size_t)L * DM * 6144 + col;
        for (int kk = 0; kk < 128; ++kk) { const int k = C.wave * 128 + kk; const float wv = w[(size_t)k * 6144];
            a0 += siluf_(cvec[k]) * wv; a1 += siluf_(cvec[DM + k]) * wv; a2 += siluf_(cctx[k]) * wv; }
        red[(C.wave * 3 + 0) * 64 + C.lane] = a0; red[(C.wave * 3 + 1) * 64 + C.lane] = a1; red[(C.wave * 3 + 2) * 64 + C.lane] = a2;
        __syncthreads();
        if (C.wave < 3) { float s = 0.f;
#pragma unroll
            for (int w8 = 0; w8 < 8; ++w8) s += red[(w8 * 3 + C.wave) * 64 + C.lane];
            mod[(size_t)(L * 3 + C.wave) * 6144 + col] = s + b_mod[L * 6144 + col]; }
        __syncthreads();
    }
    const int gt = C.bid * NTHREADS + C.tid, GT = C.G * NTHREADS;
    float* tab = WSP(float, WS_TAB);
    for (int i = gt; i < SEQ * 32; i += GT) { const int t = i >> 5, f = i & 31; const float pos = (f < 16) ? (float)(t >> 6) : (float)(t & 63);
        const float inv = exp2f(-(float)(f & 15) * (13.287712379549449f / 16.f)); const float ang = pos * inv; float s, c; sincosf(ang, &s, &c);
        tab[TAB_AXC / 4 + i] = c; tab[TAB_AXS / 4 + i] = s; }
    for (int i = gt; i < TPB * 32; i += GT) { const int p = i >> 5, f = i & 31;
        const float inv = exp2f(-(float)f * (13.287712379549449f / 32.f)); const float ang = (float)p * inv; float s, c; sincosf(ang, &s, &c);
        tab[TAB_SQC / 4 + i] = c; tab[TAB_SQS / 4 + i] = s; }
    if (gt < DEPTH * 8) WSP(float, WS_L2G)[gt] = log2_sigmoid(a.in[C.z + 17][gt]);
    const float* ws_in = a.in[C.z + 10]; bf16_t* wsb = WSP(bf16_t, WS_WSB);
    for (int i = gt; i < DEPTH * 4 * 128 * 128; i += GT) wsb[i] = (bf16_t)f2bf(ws_in[i]);
}

DI void cvt_item(const float* W, int K, int N, bf16_t* WT, int mode, int row_off, LAS float* scr, int item, int lane) {
    const int nblk = N / 32, kb = item / nblk, nb = item % nblk, k0 = 64 * kb, n0 = 32 * nb;
#pragma unroll 8
    for (int i = 0; i < 32; ++i) { const int kk = 2 * i + (lane >> 5); scr[kk * 33 + (lane & 31)] = W[(size_t)(k0 + kk) * N + n0 + (lane & 31)]; }
    asm volatile("s_waitcnt lgkmcnt(0)" ::: "memory");
    const int r0 = (mode == 0) ? row_off + n0 : row_off + 256 * (n0 >> 7) + (n0 & 127) + (mode == 2 ? 128 : 0);
    const int c = lane & 7;
#pragma unroll
    for (int j = 0; j < 4; ++j) { const int n = (lane >> 3) + 8 * j; const LAS float* s = scr + (8 * c) * 33 + n;
        u32x4 o; o.x = pk2(s[0 * 33], s[1 * 33]); o.y = pk2(s[2 * 33], s[3 * 33]); o.z = pk2(s[4 * 33], s[5 * 33]); o.w = pk2(s[6 * 33], s[7 * 33]);
        *(u32x4*)(WT + (size_t)(r0 + n) * K + k0 + 8 * c) = o; }
    asm volatile("s_waitcnt lgkmcnt(0)" ::: "memory");
}
DI void phase_cvt(const Params& a, const Ctx& C, int L) {
    LAS float* scr = (LAS float*)(C.lds + C.wave * 16384);
    const int gw = C.bid * NWAVES + C.wave, NGW = C.G * NWAVES;
    bf16_t* win_t = WSP(bf16_t, WS_W + W_IN); bf16_t* wbr_t = WSP(bf16_t, WS_W + W_BR); bf16_t* wout_t = WSP(bf16_t, WS_W + W_OUT);
    bf16_t* w13_t = WSP(bf16_t, WS_W + W_13); bf16_t* w2_t = WSP(bf16_t, WS_W + W_2);
    const int j = L >> 1; const bool moe = L & 1;
    constexpr int I_IN = 16 * 208, I_BR = 4 * 32, I_OUT = 16 * 32, I_F13 = 16 * 88, I_F2 = 44 * 32, I_M13 = 16 * 56, I_M2 = 28 * 32;
    const int nitems = I_IN + 4 * I_BR + I_OUT + (moe ? NEXP * (2 * I_M13 + I_M2) : 2 * I_F13 + I_F2);
    for (int it = gw; it < nitems; it += NGW) {
        int r = it;
        if (r < I_IN) { cvt_item(a.in[C.z + 8] + (size_t)L * DM * INW, DM, INW, win_t, 0, 0, scr, r, C.lane); continue; } r -= I_IN;
        if (r < 4 * I_BR) { const int i = r / I_BR; cvt_item(a.in[C.z + 19] + (size_t)(L * 4 + i) * 256 * DM, 256, DM, wbr_t, 0, i * DM, scr, r % I_BR, C.lane); continue; } r -= 4 * I_BR;
        if (r < I_OUT) { cvt_item(a.in[C.z + 20] + (size_t)L * DM * DM, DM, DM, wout_t, 0, 0, scr, r, C.lane); continue; } r -= I_OUT;
        if (!moe) {
            if (r < I_F13) { cvt_item(a.in[C.z + 21] + (size_t)j * DM * DFF, DM, DFF, w13_t, 1, 0, scr, r, C.lane); continue; } r -= I_F13;
            if (r < I_F13) { cvt_item(a.in[C.z + 22] + (size_t)j * DM * DFF, DM, DFF, w13_t, 2, 0, scr, r, C.lane); continue; } r -= I_F13;
            cvt_item(a.in[C.z + 23] + (size_t)j * DFF * DM, DFF, DM, w2_t, 0, 0, scr, r, C.lane);
        } else {
            const int e = r / (2 * I_M13 + I_M2); r -= e * (2 * I_M13 + I_M2);
            const size_t eo = (size_t)(j * NEXP + e) * DM * DFE;
            if (r < I_M13) { cvt_item(a.in[C.z + 26] + eo, DM, DFE, w13_t, 1, e * 2 * DFE, scr, r, C.lane); continue; } r -= I_M13;
            if (r < I_M13) { cvt_item(a.in[C.z + 27] + eo, DM, DFE, w13_t, 2, e * 2 * DFE, scr, r, C.lane); continue; } r -= I_M13;
            cvt_item(a.in[C.z + 28] + eo, DFE, DM, w2_t, 0, e * DM, scr, r, C.lane);
        }
    }
}

DI void phase_norm(const Params& a, const Ctx& C, int L, int which, const float* srcLat, const float* srcCtx) {
    const float* gn = a.in[C.z + which ? 7 : 6] + (size_t)L * DM;
    const float* mod = WSP(float, WS_MOD) + (size_t)L * 3 * 6144;
    bf16_t* H = WSP(bf16_t, WS_H);
    const bool route = which && (L & 1);
    const float* rw = a.in[C.z + 24] + (size_t)(L >> 1) * DM * NEXP; const float* rb = a.in[C.z + 25] + (size_t)(L >> 1) * NEXP;
    int* rt_i = WSP(int, WS_ROUTE); float* rt_f = WSP(float, WS_ROUTE);
    unsigned* cnt = WSP(unsigned, WS_CTL) + CW_CNT + (L >> 1) * 8 * 64;
    const int gw = C.bid * NWAVES + C.wave, NGW = C.G * NWAVES;
    for (int r = gw; r < T; r += NGW) {
        const float* xr = xrow_c(srcLat, srcCtx, r); const int mr = modrow(r);
        const float* sh = mod + (size_t)mr * 6144 + (which ? 3 : 0) * DM; const float* sc = sh + DM;
        f32x4 v[4]; float ss = 0.f;
#pragma unroll
        for (int j = 0; j < 4; ++j) { v[j] = *(const f32x4*)(xr + 4 * C.lane + 256 * j); ss += (v[j].x * v[j].x + v[j].y * v[j].y) + (v[j].z * v[j].z + v[j].w * v[j].w); }
        const float rs = __builtin_amdgcn_rsqf(wave_sum(ss, C.lane) * (1.f / DM) + EPS);
        float lg[8];
#pragma unroll
        for (int e = 0; e < 8; ++e) lg[e] = 0.f;
#pragma unroll
        for (int j = 0; j < 4; ++j) { const int c0 = 4 * C.lane + 256 * j; const f32x4 g4 = *(const f32x4*)(gn + c0), s4 = *(const f32x4*)(sc + c0), h4 = *(const f32x4*)(sh + c0);
            f32x4 h = v[j] * rs * g4 * (s4 + 1.f) + h4;
            u32x2 o; o.x = pk2(h.x, h.y); o.y = pk2(h.z, h.w); *(u32x2*)(H + (size_t)r * DM + c0) = o;
            if (route) {
#pragma unroll
                for (int q = 0; q < 4; ++q) { const f32x4 w0 = *(const f32x4*)(rw + (size_t)(c0 + q) * 8), w1 = *(const f32x4*)(rw + (size_t)(c0 + q) * 8 + 4); const float hv = h[q];
                    lg[0] += hv * w0.x; lg[1] += hv * w0.y; lg[2] += hv * w0.z; lg[3] += hv * w0.w; lg[4] += hv * w1.x; lg[5] += hv * w1.y; lg[6] += hv * w1.z; lg[7] += hv * w1.w; } } }
        if (route) {
#pragma unroll
            for (int e = 0; e < 8; ++e) lg[e] = wave_sum(lg[e], C.lane) + rb[e];
            int e1 = 0; float v1 = lg[0];
#pragma unroll
            for (int e = 1; e < 8; ++e) if (lg[e] > v1) { v1 = lg[e]; e1 = e; }
            int e2 = -1; float v2 = -3.0e38f;
#pragma unroll
            for (int e = 0; e < 8; ++e) if (e != e1 && lg[e] > v2) { v2 = lg[e]; e2 = e; }
            if (C.lane == 0) { const float p1 = rcpf_(1.f + ex2((v2 - v1) * LOG2E));
                const unsigned q1 = atomicAdd(cnt + e1 * 64, 1u), q2 = atomicAdd(cnt + e2 * 64, 1u);
                rt_i[RT_E + 2 * r] = e1; rt_i[RT_E + 2 * r + 1] = e2; rt_i[RT_POS + 2 * r] = (int)q1; rt_i[RT_POS + 2 * r + 1] = (int)q2;
                rt_f[RT_PW + 2 * r] = p1; rt_f[RT_PW + 2 * r + 1] = 1.f - p1; }
        }
    }
}

DI void phase_prep(const Params& a, const Ctx& C, int L) {
    bf16_t* P = WSP(bf16_t, WS_P); bf16_t* VT = WSP(bf16_t, WS_VT);
    const float* tab = WSP(float, WS_TAB);
    const float* axc = tab + TAB_AXC / 4; const float* axs = tab + TAB_AXS / 4; const float* sqc = tab + TAB_SQC / 4; const float* sqs = tab + TAB_SQS / 4;
    const float* gvv = a.in[C.z + 9] + (size_t)L * 256; const float* wqn = a.in[C.z + 12] + L * 64; const float* wkn = a.in[C.z + 13] + L * 64; const float* gqn = a.in[C.z + 15] + L * 64; const float* gkn = a.in[C.z + 16] + L * 64;
    const int lane = C.lane, i32 = lane & 31; const bool hiH = lane >= 32;
    for (int u = C.bid; u < T / 64; u += C.G) {
        const int row0 = u * 64;
        for (int rr = 0; rr < 8; ++rr) {
            const int r = row0 + C.wave * 8 + rr; const int b = r / TPB, p = r - b * TPB; const bool lat = p >= CTXL; const int t = p - CTXL;
            bf16_t* pr = P + (size_t)r * INW;
            const float ac = lat ? axc[t * 32 + i32] : 1.f, as = lat ? axs[t * 32 + i32] : 0.f;
            const float sc_ = sqc[p * 32 + i32], ss_ = sqs[p * 32 + i32];
#pragma unroll 1
            for (int it = 0; it < 24; ++it) {
                int col; const float* g = nullptr; float scale = 1.f; int rope = 0;
                if (it < 4) { col = C_WQ + 64 * it; g = wqn; rope = 1; scale = QSCALE; }
                else if (it < 6) { col = C_WK + 64 * (it - 4); g = wkn; rope = 1; }
                else if (it < 10) { col = C_GQ + 64 * (it - 6); g = gqn; rope = 1; scale = QSCALE; }
                else if (it < 12) { col = C_GK + 64 * (it - 10); g = gkn; rope = 1; }
                else if (it < 16) { col = C_RQ + 64 * (it - 12); rope = 2; }
                else if (it < 20) { col = C_RK + 64 * (it - 16); rope = 2; scale = 0.125f; }
                else { col = C_V + 64 * (it - 20); g = gvv + 64 * (it - 20); }
                float x = bf2f(pr[col + lane]);
                if (g) { const float ss = wave_sum(x * x, lane); x = x * __builtin_amdgcn_rsqf(ss * (1.f / 64.f) + EPS) * g[lane]; }
                if (rope) { const float c = rope == 1 ? ac : sc_, s = rope == 1 ? as : ss_; const float o = shx(x, 32, lane);
                    x = hiH ? (o * s + x * c) : (x * c - o * s); }
                pr[col + lane] = (bf16_t)f2bf(x * scale);
            }
        }
        { const int hh = C.tid >> 7, d = (C.tid >> 1) & 63, tg = C.tid & 1; const int kind = hh >> 1, kvh = hh & 1;
          const int b = row0 / TPB, p0 = row0 - b * TPB + 32 * tg; const int col = (kind ? C_GV : C_WV) + 64 * kvh + d;
          const bf16_t* src = P + (size_t)(row0 + 32 * tg) * INW + col;
          bf16_t* dst = VT + ((size_t)((kind * 2 + b) * 2 + kvh) * 64 + d) * TPB + p0;
#pragma unroll
          for (int q = 0; q < 4; ++q) { unsigned w[4];
#pragma unroll
              for (int e = 0; e < 4; ++e) { const unsigned lo = src[(size_t)(8 * q + 2 * e) * INW], hi = src[(size_t)(8 * q + 2 * e + 1) * INW]; w[e] = lo | (hi << 16); }
              *(u32x4*)(dst + 8 * q) = (u32x4){w[0], w[1], w[2], w[3]}; } }
    }
}

DI void mixA_unit(const Params& a, const Ctx& C, int L, int cg, int g) {
    const bf16_t* P = WSP(bf16_t, WS_P); bf16_t* BR = WSP(bf16_t, WS_BR);
    const bf16_t* W = WSP(bf16_t, WS_WSB) + (size_t)(L * 4 + g) * 128 * 128; const float* bs = a.in[C.z + 11] + (size_t)(L * 4 + g) * 128;
    LAS bf16_t* vnT = (LAS bf16_t*)C.lds;
    const int row0 = cg * 128, lane = C.lane, l15 = lane & 15, quad = lane >> 4;
#pragma unroll
    for (int it = 0; it < 2; ++it) { const int idx = C.tid + 512 * it, j = idx >> 3, ch = idx & 7;
        const u32x4 v = *(const u32x4*)(P + (size_t)(row0 + j) * INW + C_V + 64 * g + 8 * ch);
        const unsigned w[4] = {v.x, v.y, v.z, v.w};
#pragma unroll
        for (int e = 0; e < 4; ++e) { vnT[(8 * ch + 2 * e) * 136 + j] = (bf16_t)(w[e] & 0xffffu); vnT[(8 * ch + 2 * e + 1) * 136 + j] = (bf16_t)(w[e] >> 16); } }
    __syncthreads();
    const int i0 = 16 * C.wave;
    f32x4 acc[4];
#pragma unroll
    for (int dt = 0; dt < 4; ++dt) acc[dt] = (f32x4){0.f, 0.f, 0.f, 0.f};
#pragma unroll
    for (int ks = 0; ks < 4; ++ks) { const bf16x8 a = *(const bf16x8*)(W + (size_t)(i0 + l15) * 128 + 32 * ks + 8 * quad);
#pragma unroll
        for (int dt = 0; dt < 4; ++dt) { const bf16x8 bb = *(const LAS bf16x8*)(vnT + (16 * dt + l15) * 136 + 32 * ks + 8 * quad); acc[dt] = MFMA16(a, bb, acc[dt]); } }
#pragma unroll
    for (int dt = 0; dt < 4; ++dt)
#pragma unroll
        for (int j = 0; j < 4; ++j) { const int i = i0 + quad * 4 + j, d = 16 * dt + l15; const float mixed = acc[dt][j] + bs[i];
            const float uv = bf2f(P[(size_t)(row0 + i) * INW + C_U + 64 * g + d]); BR[(size_t)(row0 + i) * DM + 64 * g + d] = (bf16_t)f2bf(uv * mixed); }
    __syncthreads();
}

DI void attn_unit(const Params& a, const Ctx& C, int L, int kind, int b, int kvh, int qrow0, int ntile0, int krow0, int ntile1, int krow1, bool masked, bool has_sink) {
    const bf16_t* P = WSP(bf16_t, WS_P); bf16_t* BR = WSP(bf16_t, WS_BR);
    const bf16_t* VTb = WSP(bf16_t, WS_VT) + (size_t)((kind * 2 + b) * 2 + kvh) * 64 * TPB;
    const int Qcol = kind ? C_GQ : C_WQ, Kcol = (kind ? C_GK : C_WK) + 64 * kvh, Ocol = kind ? 512 : 256;
    LAS bf16_t* Kb = (LAS bf16_t*)C.lds;
    LAS bf16_t* Vb = (LAS bf16_t*)(C.lds + 2 * 64 * 144);
    const int lane = C.lane, r32 = lane & 31, hi = lane >> 5, w = C.wave, hq = 2 * kvh + (w >> 2);
    const int q = qrow0 + 32 * (w & 3) + r32;
    bf16x8 qr[4];
#pragma unroll
    for (int d0 = 0; d0 < 4; ++d0) qr[d0] = *(const bf16x8*)(P + (size_t)q * INW + Qcol + 64 * hq + 16 * d0 + 8 * hi);
    float m = has_sink ? a.in[C.z + 14][L * 4 + hq] * LOG2E : -1e30f, l = (has_sink && hi == 0) ? 1.f : 0.f;
    f32x16 o0, o1;
#pragma unroll
    for (int i = 0; i < 16; ++i) { o0[i] = 0.f; o1[i] = 0.f; }
    const int nt = ntile0 + ntile1; const int lr = C.tid >> 3, lc = C.tid & 7;
    const int qpos = q - (b * TPB + CTXL);
    u32x4 kreg, vreg;
    { const int kr = krow0; kreg = *(const u32x4*)(P + (size_t)(kr + lr) * INW + Kcol + 8 * lc); vreg = *(const u32x4*)(VTb + (size_t)lr * TPB + (kr - b * TPB) + 8 * lc); }
    *(LAS u32x4*)(Kb + lr * 72 + 8 * lc) = kreg; *(LAS u32x4*)(Vb + lr * 72 + 8 * lc) = vreg;
    __syncthreads();
    for (int t = 0; t < nt; ++t) {
        const int cur = t & 1; const bool more = t + 1 < nt;
        if (more) { const int tn = t + 1; const int kr = tn < ntile0 ? krow0 + 64 * tn : krow1 + 64 * (tn - ntile0);
            kreg = *(const u32x4*)(P + (size_t)(kr + lr) * INW + Kcol + 8 * lc); vreg = *(const u32x4*)(VTb + (size_t)lr * TPB + (kr - b * TPB) + 8 * lc); }
        const LAS bf16_t* Kc = Kb + cur * 64 * 72; const LAS bf16_t* Vc = Vb + cur * 64 * 72;
        f32x16 p0, p1;
#pragma unroll
        for (int i = 0; i < 16; ++i) { p0[i] = 0.f; p1[i] = 0.f; }
#pragma unroll
        for (int d0 = 0; d0 < 4; ++d0) { const bf16x8 k0 = *(const LAS bf16x8*)(Kc + r32 * 72 + 16 * d0 + 8 * hi), k1 = *(const LAS bf16x8*)(Kc + (32 + r32) * 72 + 16 * d0 + 8 * hi);
            p0 = MFMA32(k0, qr[d0], p0); p1 = MFMA32(k1, qr[d0], p1); }
        if (masked && t >= ntile0) { const int kp0 = krow1 + 64 * (t - ntile0) - (b * TPB + CTXL);
#pragma unroll
            for (int i = 0; i < 16; ++i) { const int kp = kp0 + crow(i, hi); int d = qpos - kp; d = d < 0 ? -d : d; if (d > 128) p0[i] = -1e30f; int d2 = qpos - (kp + 32); d2 = d2 < 0 ? -d2 : d2; if (d2 > 128) p1[i] = -1e30f; } }
        float mx = p0[0];
#pragma unroll
        for (int i = 1; i < 16; ++i) mx = fmaxf(mx, p0[i]);
#pragma unroll
        for (int i = 0; i < 16; ++i) mx = fmaxf(mx, p1[i]);
        mx = fmaxf(mx, shx(mx, 32, lane));
        const float mn = fmaxf(m, mx), alpha = ex2(m - mn); m = mn; l *= alpha;
        float ps = 0.f;
#pragma unroll
        for (int i = 0; i < 16; ++i) { o0[i] *= alpha; o1[i] *= alpha; p0[i] = ex2(p0[i] - mn); p1[i] = ex2(p1[i] - mn); ps += p0[i] + p1[i]; }
        l += ps;
        bf16x8 pw[4];
        { u32x4 t0 = {pk2(p0[0], p0[1]), pk2(p0[2], p0[3]), pk2(p0[4], p0[5]), pk2(p0[6], p0[7])}; pw[0] = __builtin_bit_cast(bf16x8, t0);
          u32x4 t1 = {pk2(p0[8], p0[9]), pk2(p0[10], p0[11]), pk2(p0[12], p0[13]), pk2(p0[14], p0[15])}; pw[1] = __builtin_bit_cast(bf16x8, t1);
          u32x4 t2 = {pk2(p1[0], p1[1]), pk2(p1[2], p1[3]), pk2(p1[4], p1[5]), pk2(p1[6], p1[7])}; pw[2] = __builtin_bit_cast(bf16x8, t2);
          u32x4 t3 = {pk2(p1[8], p1[9]), pk2(p1[10], p1[11]), pk2(p1[12], p1[13]), pk2(p1[14], p1[15])}; pw[3] = __builtin_bit_cast(bf16x8, t3); }
#pragma unroll
        for (int s = 0; s < 4; ++s) {
            const u32x2 a0 = *(const LAS u32x2*)(Vc + r32 * 72 + 16 * s + 4 * hi), a1 = *(const LAS u32x2*)(Vc + r32 * 72 + 16 * s + 8 + 4 * hi);
            const u32x2 c0 = *(const LAS u32x2*)(Vc + (32 + r32) * 72 + 16 * s + 4 * hi), c1 = *(const LAS u32x2*)(Vc + (32 + r32) * 72 + 16 * s + 8 + 4 * hi);
            const u32x4 va = {a0.x, a0.y, a1.x, a1.y}, vc = {c0.x, c0.y, c1.x, c1.y};
            o0 = MFMA32(__builtin_bit_cast(bf16x8, va), pw[s], o0); o1 = MFMA32(__builtin_bit_cast(bf16x8, vc), pw[s], o1); }
        if (more) { const int nx = cur ^ 1; *(LAS u32x4*)(Kb + nx * 64 * 72 + lr * 72 + 8 * lc) = kreg; *(LAS u32x4*)(Vb + nx * 64 * 72 + lr * 72 + 8 * lc) = vreg; }
        __syncthreads();
    }
    l += shx(l, 32, lane);
    const float inv = rcpf_(l);
    bf16_t* orow = BR + (size_t)q * DM + Ocol + 64 * hq;
#pragma unroll
    for (int g = 0; g < 4; ++g) { const int d = 8 * g + 4 * hi;
        u32x2 w0 = {pk2(o0[4 * g] * inv, o0[4 * g + 1] * inv), pk2(o0[4 * g + 2] * inv, o0[4 * g + 3] * inv)}; *(u32x2*)(orow + d) = w0;
        u32x2 w1 = {pk2(o1[4 * g] * inv, o1[4 * g + 1] * inv), pk2(o1[4 * g + 2] * inv, o1[4 * g + 3] * inv)}; *(u32x2*)(orow + 32 + d) = w1; }
}

DI void ret_kv_unit(const Params& a, const Ctx& C, int L, int cg, int h) {
    const bf16_t* P = WSP(bf16_t, WS_P); float* KVT = WSP(float, WS_KVT);
    const float l2f = WSP(float, WS_L2G)[(L * 2 + 0) * 4 + h], l2b = WSP(float, WS_L2G)[(L * 2 + 1) * 4 + h];
    LAS bf16_t* VTs = (LAS bf16_t*)C.lds; LAS bf16_t* KTf = VTs + 64 * 136; LAS bf16_t* KTb = KTf + 64 * 136;
    const int row0 = cg * 128, lane = C.lane, l15 = lane & 15, quad = lane >> 4;
#pragma unroll
    for (int it = 0; it < 2; ++it) { const int idx = C.tid + 512 * it, j = idx >> 3, ch = idx & 7;
        const u32x4 kv = *(const u32x4*)(P + (size_t)(row0 + j) * INW + C_RK + 64 * h + 8 * ch), vv = *(const u32x4*)(P + (size_t)(row0 + j) * INW + C_RV + 64 * h + 8 * ch);
        const float wf = ex2((float)(127 - j) * l2f), wb = ex2((float)j * l2b);
        const unsigned kw[4] = {kv.x, kv.y, kv.z, kv.w}, vw[4] = {vv.x, vv.y, vv.z, vv.w};
#pragma unroll
        for (int e = 0; e < 4; ++e) { const float k0 = __uint_as_float(kw[e] << 16), k1 = __uint_as_float(kw[e] & 0xffff0000u);
            KTf[(8 * ch + 2 * e) * 136 + j] = (bf16_t)f2bf(k0 * wf); KTf[(8 * ch + 2 * e + 1) * 136 + j] = (bf16_t)f2bf(k1 * wf);
            KTb[(8 * ch + 2 * e) * 136 + j] = (bf16_t)f2bf(k0 * wb); KTb[(8 * ch + 2 * e + 1) * 136 + j] = (bf16_t)f2bf(k1 * wb);
            VTs[(8 * ch + 2 * e) * 136 + j] = (bf16_t)(vw[e] & 0xffffu); VTs[(8 * ch + 2 * e + 1) * 136 + j] = (bf16_t)(vw[e] >> 16); } }
    __syncthreads();
    const int dir = C.wave >> 2, vt = C.wave & 3; const LAS bf16_t* KT = dir ? KTb : KTf;
    f32x4 acc[4];
#pragma unroll
    for (int dt = 0; dt < 4; ++dt) acc[dt] = (f32x4){0.f, 0.f, 0.f, 0.f};
#pragma unroll
    for (int ks = 0; ks < 4; ++ks) { const bf16x8 a = *(const LAS bf16x8*)(VTs + (16 * vt + l15) * 136 + 32 * ks + 8 * quad);
#pragma unroll
        for (int dt = 0; dt < 4; ++dt) { const bf16x8 bb = *(const LAS bf16x8*)(KT + (16 * dt + l15) * 136 + 32 * ks + 8 * quad); acc[dt] = MFMA16(a, bb, acc[dt]); } }
    const int b = cg / NCHUNK, c = cg - b * NCHUNK;
    float* dst = KVT + ((size_t)((dir * 2 + b) * 4 + h) * NCHUNK + c) * 4096;
#pragma unroll
    for (int dt = 0; dt < 4; ++dt)
#pragma unroll
        for (int j = 0; j < 4; ++j) dst[(16 * vt + quad * 4 + j) * 64 + 16 * dt + l15] = acc[dt][j];
    __syncthreads();
}
DI void phase_ret_scan(const Params& a, const Ctx& C, int L) {
    const float* KVT = WSP(float, WS_KVT); bf16_t* SIN = WSP(bf16_t, WS_SIN);
    const int gt = C.bid * NTHREADS + C.tid;
    if (gt < 2 * 2 * 4 * 4096) {
        const int e = gt & 4095, bh = (gt >> 12) & 7, dir = gt >> 15, h = bh & 3;
        const float cd = ex2(128.f * WSP(float, WS_L2G)[(L * 2 + dir) * 4 + h]);
        const size_t base = (size_t)((dir * 2 + (bh >> 2)) * 4 + h) * NCHUNK * 4096 + e;
        float st = 0.f;
        for (int t = 0; t < NCHUNK; ++t) { const int c = dir == 0 ? t : (t == 0 ? 1 : (t == 1 ? 0 : 67 - t));
            SIN[base + (size_t)c * 4096] = (bf16_t)f2bf(st); st = cd * st + KVT[base + (size_t)c * 4096]; }
    }
}
DI void ret_out_unit(const Params& a, const Ctx& C, int L, int cg, int h) {
    const bf16_t* P = WSP(bf16_t, WS_P); bf16_t* BR = WSP(bf16_t, WS_BR); const bf16_t* SIN = WSP(bf16_t, WS_SIN);
    const float l2f = WSP(float, WS_L2G)[(L * 2 + 0) * 4 + h], l2b = WSP(float, WS_L2G)[(L * 2 + 1) * 4 + h];
    const float* gn = a.in[C.z + 18] + (size_t)(L * 4 + h) * 64;
    LAS bf16_t* Qs = (LAS bf16_t*)C.lds;
    LAS bf16_t* Ks = Qs + 128 * 72;
    LAS bf16_t* VTs = Ks + 128 * 72;
    LAS bf16_t* Wd = VTs + 64 * 136;
    LAS bf16_t* SfT = Wd + 128 * 136;
    LAS bf16_t* SbT = SfT + 64 * 72;
    const int row0 = cg * 128, lane = C.lane, l15 = lane & 15, quad = lane >> 4; const int b = cg / NCHUNK, c = cg - b * NCHUNK;
#pragma unroll
    for (int it = 0; it < 2; ++it) { const int idx = C.tid + 512 * it, j = idx >> 3, ch = idx & 7; const bf16_t* pr = P + (size_t)(row0 + j) * INW + 64 * h + 8 * ch;
        *(LAS u32x4*)(Qs + j * 72 + 8 * ch) = *(const u32x4*)(pr + C_RQ); *(LAS u32x4*)(Ks + j * 72 + 8 * ch) = *(const u32x4*)(pr + C_RK);
        const u32x4 vv = *(const u32x4*)(pr + C_RV); const unsigned vw[4] = {vv.x, vv.y, vv.z, vv.w};
#pragma unroll
        for (int e = 0; e < 4; ++e) { VTs[(8 * ch + 2 * e) * 136 + j] = (bf16_t)(vw[e] & 0xffffu); VTs[(8 * ch + 2 * e + 1) * 136 + j] = (bf16_t)(vw[e] >> 16); } }
    { const int v = C.tid >> 3, ch = C.tid & 7;
      *(LAS u32x4*)(SfT + v * 72 + 8 * ch) = *(const u32x4*)(SIN + ((size_t)((0 * 2 + b) * 4 + h) * NCHUNK + c) * 4096 + v * 64 + 8 * ch);
      *(LAS u32x4*)(SbT + v * 72 + 8 * ch) = *(const u32x4*)(SIN + ((size_t)((1 * 2 + b) * 4 + h) * NCHUNK + c) * 4096 + v * 64 + 8 * ch); }
    __syncthreads();
    const int i0 = 16 * C.wave;
    { bf16x8 a[2];
#pragma unroll
      for (int ks = 0; ks < 2; ++ks) a[ks] = *(const LAS bf16x8*)(Qs + (i0 + l15) * 72 + 32 * ks + 8 * quad);
#pragma unroll
      for (int jt = 0; jt < 8; ++jt) { f32x4 acc = {0.f, 0.f, 0.f, 0.f};
#pragma unroll
          for (int ks = 0; ks < 2; ++ks) { const bf16x8 bb = *(const LAS bf16x8*)(Ks + (16 * jt + l15) * 72 + 32 * ks + 8 * quad); acc = MFMA16(a[ks], bb, acc); }
#pragma unroll
          for (int r = 0; r < 4; ++r) { const int i = i0 + quad * 4 + r, j = 16 * jt + l15, dl = i - j;
              const float f = dl >= 0 ? ex2((float)dl * l2f) : ex2((float)(-dl - 1) * l2b); Wd[i * 136 + j] = (bf16_t)f2bf(acc[r] * f); } } }
    __syncthreads();
    f32x4 oi[4], tf[4], tb[4];
#pragma unroll
    for (int vt = 0; vt < 4; ++vt) { oi[vt] = (f32x4){0.f, 0.f, 0.f, 0.f}; tf[vt] = oi[vt]; tb[vt] = oi[vt]; }
#pragma unroll
    for (int ks = 0; ks < 4; ++ks) { const bf16x8 a = *(const LAS bf16x8*)(Wd + (i0 + l15) * 136 + 32 * ks + 8 * quad);
#pragma unroll
        for (int vt = 0; vt < 4; ++vt) { const bf16x8 bb = *(const LAS bf16x8*)(VTs + (16 * vt + l15) * 136 + 32 * ks + 8 * quad); oi[vt] = MFMA16(a, bb, oi[vt]); } }
#pragma unroll
    for (int ks = 0; ks < 2; ++ks) { const bf16x8 a = *(const LAS bf16x8*)(Qs + (i0 + l15) * 72 + 32 * ks + 8 * quad);
#pragma unroll
        for (int vt = 0; vt < 4; ++vt) { const bf16x8 b1 = *(const LAS bf16x8*)(SfT + (16 * vt + l15) * 72 + 32 * ks + 8 * quad), b2 = *(const LAS bf16x8*)(SbT + (16 * vt + l15) * 72 + 32 * ks + 8 * quad);
            tf[vt] = MFMA16(a, b1, tf[vt]); tb[vt] = MFMA16(a, b2, tb[vt]); } }
#pragma unroll
    for (int r = 0; r < 4; ++r) { const int i = i0 + quad * 4 + r; const float qf = ex2((float)(i + 1) * l2f), qb = ex2((float)(127 - i) * l2b);
        float o[4]; float s = 0.f;
#pragma unroll
        for (int vt = 0; vt < 4; ++vt) { o[vt] = oi[vt][r] + qf * tf[vt][r] + qb * tb[vt][r]; s += o[vt]; }
        s += shx(s, 1, lane); s += shx(s, 2, lane); s += shx(s, 4, lane); s += shx(s, 8, lane);
        const float mean = s * (1.f / 64.f); float q2 = 0.f;
#pragma unroll
        for (int vt = 0; vt < 4; ++vt) { o[vt] -= mean; q2 += o[vt] * o[vt]; }
        q2 += shx(q2, 1, lane); q2 += shx(q2, 2, lane); q2 += shx(q2, 4, lane); q2 += shx(q2, 8, lane);
        const float rs = __builtin_amdgcn_rsqf(q2 * (1.f / 64.f) + EPS);
#pragma unroll
        for (int vt = 0; vt < 4; ++vt) { const int v = 16 * vt + l15; const float gt = bf2f(P[(size_t)(row0 + i) * INW + C_RG + 64 * h + v]);
            BR[(size_t)(row0 + i) * DM + 768 + 64 * h + v] = (bf16_t)f2bf(o[vt] * rs * gn[v] * siluf_(gt)); } }
    __syncthreads();
}

DI void phase_attnC(const Params& a, const Ctx& C, unsigned char* lds_generic) {
    for (int r = C.bid; r < 256; r += C.G) { const int b = r >> 7, h = (r >> 5) & 3, qb = r & 31;
        attn_body::attn_unit<8>((long)b * TPB + CTXL + qb * 256, (long)b * TPB, C_GQ + 64 * h, C_GK + 64 * (h >> 1), C_GV + 64 * (h >> 1), 512 + 64 * h, (const attn_body::bf16*)WSP(bf16_t, WS_P), (attn_body::bf16*)WSP(bf16_t, WS_BR), (char*)lds_generic, C.tid, __int_as_float(C.z)); }
}
DI void phase_mix(const Params& a, const Ctx& C, int L) {
    constexpr int N_BL = 256, N_BC = 8, N_CC = 8, N_A = 528, N_KV = 528;
    constexpr int NU = N_BL + N_BC + N_CC + N_A + N_KV;
    for (int u = C.bid; u < NU; u += C.G) {
        int r = u;
        if (r < N_BL) { const int b = r >> 7, kvh = (r >> 6) & 1, n = r & 63; const int ls = (n > 0 ? n - 1 : 0) * 128, le = (n < 63 ? n + 2 : 64) * 128;
            attn_unit(a, C, L, 0, b, kvh, b * TPB + CTXL + n * 128, 4, b * TPB, (le - ls) / 64, b * TPB + CTXL + ls, true, true); continue; } r -= N_BL;
        if (r < N_BC) { const int b = r >> 2, kvh = (r >> 1) & 1, cb = r & 1; attn_unit(a, C, L, 0, b, kvh, b * TPB + cb * 128, 4, b * TPB, 0, 0, false, true); continue; } r -= N_BC;
        if (r < N_CC) { const int b = r >> 2, kvh = (r >> 1) & 1, cb = r & 1; attn_unit(a, C, L, 1, b, kvh, b * TPB + cb * 128, 4, b * TPB, 0, 0, false, false); continue; } r -= N_CC;
        if (r < N_A) { mixA_unit(a, C, L, r >> 2, r & 3); continue; } r -= N_A;
        ret_kv_unit(a, C, L, r >> 2, r & 3);
    }
}
DI void phase_ret_out(const Params& a, const Ctx& C, int L) { for (int u = C.bid; u < 528; u += C.G) ret_out_unit(a, C, L, u >> 2, u & 3); }

DI void phase_sum4(const Params& a, const Ctx& C) {
    const bf16_t* P = WSP(bf16_t, WS_P); bf16_t* A = WSP(bf16_t, WS_H);
    const int gt = C.bid * NTHREADS + C.tid, GT = C.G * NTHREADS;
    for (int i = gt; i < T * 128; i += GT) { const int r = i >> 7, c = (i & 127) * 8; const bf16_t* pr = P + (size_t)r * INW + C_GATE + c;
        float s[8];
#pragma unroll
        for (int e = 0; e < 8; ++e) s[e] = 0.f;
#pragma unroll
        for (int br = 0; br < 4; ++br) { const u32x4 v = *(const u32x4*)(pr + br * 1024); const unsigned w[4] = {v.x, v.y, v.z, v.w};
#pragma unroll
            for (int e = 0; e < 4; ++e) { s[2 * e] += __uint_as_float(w[e] << 16); s[2 * e + 1] += __uint_as_float(w[e] & 0xffff0000u); } }
        *(u32x4*)(A + (size_t)r * DM + c) = (u32x4){pk2(s[0], s[1]), pk2(s[2], s[3]), pk2(s[4], s[5]), pk2(s[6], s[7])}; }
}

DI void phase_gather(const Params& a, const Ctx& C, int L) {
    const unsigned* cnt = WSP(unsigned, WS_CTL) + CW_CNT + (L >> 1) * 8 * 64;
    int* rt_i = WSP(int, WS_ROUTE); float* rt_f = WSP(float, WS_ROUTE);
    const bf16_t* H = WSP(bf16_t, WS_H); bf16_t* HG = WSP(bf16_t, WS_HG);
    int base[NEXP + 1]; int cn[NEXP];
    { int acc = 0;
#pragma unroll
      for (int e = 0; e < NEXP; ++e) { cn[e] = (int)__hip_atomic_load(cnt + e * 64, __ATOMIC_RELAXED, __HIP_MEMORY_SCOPE_AGENT); base[e] = acc; acc += ((cn[e] + 255) >> 8) << 8; } base[NEXP] = acc; }
    if (C.bid == 0) {
        if (C.tid == 0) { rt_i[RT_META] = base[NEXP] >> 8; }
        for (int rt = C.tid; rt < (base[NEXP] >> 8); rt += NTHREADS) { int e = 0;
#pragma unroll
            for (int k = 1; k < NEXP; ++k) if (rt * 256 >= base[k]) e = k;
            rt_i[RT_META + 16 + rt] = e; }
#pragma unroll
        for (int e = 0; e < NEXP; ++e) for (int r = base[e] + cn[e] + C.tid; r < base[e + 1]; r += NTHREADS) rt_i[RT_ROWTOK + r] = -1;
    }
    const int gw = C.bid * NWAVES + C.wave, NGW = C.G * NWAVES;
    for (int t = gw; t < T; t += NGW) {
        const u32x4 h0 = *(const u32x4*)(H + (size_t)t * DM + 8 * C.lane), h1 = *(const u32x4*)(H + (size_t)t * DM + 512 + 8 * C.lane);
#pragma unroll
        for (int k = 0; k < 2; ++k) { const int e = rt_i[RT_E + 2 * t + k], pos = rt_i[RT_POS + 2 * t + k];
            int bs = 0;
#pragma unroll
            for (int q = 0; q < NEXP; ++q) if (q == e) bs = base[q];
            const int row = bs + pos;
            *(u32x4*)(HG + (size_t)row * DM + 8 * C.lane) = h0; *(u32x4*)(HG + (size_t)row * DM + 512 + 8 * C.lane) = h1;
            if (C.lane == 0) { rt_i[RT_ROWTOK + row] = t; rt_f[RT_ROWP + row] = rt_f[RT_PW + 2 * t + k]; } }
    }
}

DI void phase_combine(const Params& a, const Ctx& C, int L) {
    const unsigned* cnt = WSP(unsigned, WS_CTL) + CW_CNT + (L >> 1) * 8 * 64;
    const int* rt_i = WSP(int, WS_ROUTE); const bf16_t* Y = WSP(bf16_t, WS_HG);
    const float* mod = WSP(float, WS_MOD) + (size_t)L * 3 * 6144 + 5 * DM;
    int base[NEXP];
    { int acc = 0;
#pragma unroll
      for (int e = 0; e < NEXP; ++e) { const int cn = (int)__hip_atomic_load(cnt + e * 64, __ATOMIC_RELAXED, __HIP_MEMORY_SCOPE_AGENT); base[e] = acc; acc += ((cn + 255) >> 8) << 8; } }
    const int gw = C.bid * NWAVES + C.wave, NGW = C.G * NWAVES;
    for (int t = gw; t < T; t += NGW) {
        int row[2];
#pragma unroll
        for (int k = 0; k < 2; ++k) { const int e = rt_i[RT_E + 2 * t + k], pos = rt_i[RT_POS + 2 * t + k]; int bs = 0;
#pragma unroll
            for (int q = 0; q < NEXP; ++q) if (q == e) bs = base[q];
            row[k] = bs + pos; }
        float* xr = xrow(C.out, WSP(float, WS_CTXB), t); const float* gt = mod + (size_t)modrow(t) * 6144;
#pragma unroll
        for (int hf = 0; hf < 2; ++hf) { const int c = hf * 512 + 8 * C.lane;
            const u32x4 y0 = *(const u32x4*)(Y + (size_t)row[0] * DM + c), y1 = *(const u32x4*)(Y + (size_t)row[1] * DM + c);
            const unsigned w0[4] = {y0.x, y0.y, y0.z, y0.w}, w1[4] = {y1.x, y1.y, y1.z, y1.w};
#pragma unroll
            for (int q = 0; q < 2; ++q) { const f32x4 g = *(const f32x4*)(gt + c + 4 * q); f32x4 x = *(const f32x4*)(xr + c + 4 * q);
                x[0] += g[0] * (__uint_as_float(w0[2 * q] << 16) + __uint_as_float(w1[2 * q] << 16));
                x[1] += g[1] * (__uint_as_float(w0[2 * q] & 0xffff0000u) + __uint_as_float(w1[2 * q] & 0xffff0000u));
                x[2] += g[2] * (__uint_as_float(w0[2 * q + 1] << 16) + __uint_as_float(w1[2 * q + 1] << 16));
                x[3] += g[3] * (__uint_as_float(w0[2 * q + 1] & 0xffff0000u) + __uint_as_float(w1[2 * q + 1] & 0xffff0000u));
                *(f32x4*)(xr + c + 4 * q) = x; } }
    }
}

constexpr int PH_PER_LAYER = 15;
#define PHASE_CTX() Ctx C; { int z_ = 0; asm volatile("s_mov_b32 %0, 0" : "=s"(z_)); C.z = z_; C.lds = (LAS unsigned char*)lds_raw; { int t_ = threadIdx.x; asm volatile("" : "+v"(t_)); C.tid = t_; } C.lane = C.tid & 63; \
    C.wave = __builtin_amdgcn_readfirstlane(C.tid >> 6); C.G = (int)gridDim.x + z_; C.bid = (int)blockIdx.x + z_; C.out = a.out + z_; C.ws = a.ws + z_; }
template <int PHMASK, bool FUSED>
__global__ void __launch_bounds__(NTHREADS, 2) mixer_fwd(Params a) {
    extern __shared__ __attribute__((aligned(16))) unsigned char lds_raw[];
    volatile LAS unsigned* MISC = (volatile LAS unsigned*)((LAS unsigned char*)lds_raw + MISC_OFF);
    if (threadIdx.x < 32) MISC[threadIdx.x] = 0u;
    __syncthreads();
    XcdBarrier bar; bar.bar = (unsigned*)(a.ws + WS_CTL) + CW_BAR; bar.x = 0; bar.st = nullptr;
    if (FUSED) bar = xcd_barrier_post((unsigned*)(a.ws + WS_CTL) + CW_BAR, MISC + 8);
#define SEAM() do { if (FUSED) xcd_barrier_fn(bar.bar, bar.x, (unsigned)(unsigned long long)bar.st); } while (0)
#ifndef PHASE_MASK
#define PHASE_MASK 0xffff
#endif
#define RUN(k) ((((PHASE_MASK) & (PHMASK)) >> (k)) & 1)

    if (a.l_lo == 0 && RUN(0)) { PHASE_CTX(); phase_g0(a, C); SEAM(); }
    for (int L = a.l_lo; L < a.l_hi; ++L) {
        const bool moe = L & 1;
        if (RUN(1)) { PHASE_CTX(); phase_cvt(a, C, L); phase_norm(a, C, L, 0, L == 0 ? a.in[C.z + 0] : C.out, L == 0 ? a.in[C.z + 2] : WSP(float, WS_CTXB)); __syncthreads(); SEAM(); }
        if (RUN(2)) { PHASE_CTX(); pg8::Gemm g{WSP(bf16_t, WS_H), WSP(bf16_t, WS_W + W_IN), DM, DM, DM}; pg8::StaticOrder S; S.init(T, INW, C.G, C.bid); pg8::EpiIn E{WSP(bf16_t, WS_P)};
            pg8::gemm_phase(C.lds, C.tid, g, S, E); SEAM(); }
        if (RUN(3)) { PHASE_CTX(); phase_prep(a, C, L); __syncthreads(); SEAM(); }
        if (RUN(4)) { { PHASE_CTX(); phase_attnC(a, C, lds_raw); __syncthreads(); } { PHASE_CTX(); phase_mix(a, C, L); __syncthreads(); } SEAM(); }
        if (RUN(5)) { PHASE_CTX(); phase_ret_scan(a, C, L); SEAM(); }
        if (RUN(6)) { PHASE_CTX(); phase_ret_out(a, C, L); SEAM(); }
        if (RUN(7)) { PHASE_CTX(); pg8::Gemm g{WSP(bf16_t, WS_BR), WSP(bf16_t, WS_W + W_BR), DM, 256, 256}; pg8::MergeOrder S; S.init(T, 4096, C.G, C.bid); pg8::EpiMerge E{WSP(bf16_t, WS_P)};
            pg8::gemm_phase(C.lds, C.tid, g, S, E); SEAM(); }
        if (RUN(8)) { PHASE_CTX(); phase_sum4(a, C); SEAM(); }
        if (RUN(9)) { PHASE_CTX(); pg8::Gemm g{WSP(bf16_t, WS_H), WSP(bf16_t, WS_W + W_OUT), DM, DM, DM}; pg8::StaticOrder S; S.init(T, DM, C.G, C.bid);
            pg8::EpiResid E{L == 0 ? a.in[C.z + 0] : C.out, L == 0 ? a.in[C.z + 2] : WSP(float, WS_CTXB), C.out, WSP(float, WS_CTXB), WSP(float, WS_MOD) + (size_t)L * 3 * 6144 + 2 * DM};
            pg8::gemm_phase(C.lds, C.tid, g, S, E); SEAM(); }
        if (RUN(10)) { PHASE_CTX(); phase_norm(a, C, L, 1, C.out, WSP(float, WS_CTXB)); SEAM(); }
        if (!moe) {
            if (RUN(11)) { PHASE_CTX(); pg8::Gemm g{WSP(bf16_t, WS_H), WSP(bf16_t, WS_W + W_13), DM, DM, DM}; pg8::StaticOrder S; S.init(T, 2 * DFF, C.G, C.bid); pg8::EpiSwiglu E{WSP(bf16_t, WS_P), DFF, 1 << 20};
                pg8::gemm_phase(C.lds, C.tid, g, S, E); SEAM(); }
            if (RUN(12)) { PHASE_CTX(); pg8::Gemm g{WSP(bf16_t, WS_P), WSP(bf16_t, WS_W + W_2), DFF, DFF, DFF}; pg8::StaticOrder S; S.init(T, DM, C.G, C.bid);
                pg8::EpiResid E{C.out, WSP(float, WS_CTXB), C.out, WSP(float, WS_CTXB), WSP(float, WS_MOD) + (size_t)L * 3 * 6144 + 5 * DM};
                pg8::gemm_phase(C.lds, C.tid, g, S, E); SEAM(); }
        } else {
            if (RUN(11)) { PHASE_CTX(); phase_gather(a, C, L); SEAM(); }
            if (RUN(12)) { PHASE_CTX(); pg8::Gemm g{WSP(bf16_t, WS_HG), WSP(bf16_t, WS_W + W_13), DM, DM, DM}; pg8::MoeOrder S{WSP(int, WS_ROUTE) + RT_META, 14, C.G, C.bid}; pg8::EpiSwiglu E{WSP(bf16_t, WS_HIDM), DFE, 14};
                pg8::gemm_phase(C.lds, C.tid, g, S, E); SEAM(); }
            if (RUN(13)) { PHASE_CTX(); pg8::Gemm g{WSP(bf16_t, WS_HIDM), WSP(bf16_t, WS_W + W_2), DFE, DFE, DFE}; pg8::MoeOrder S{WSP(int, WS_ROUTE) + RT_META, 4, C.G, C.bid};
                pg8::EpiMoe2 E{WSP(bf16_t, WS_HG), WSP(float, WS_ROUTE) + RT_ROWP, 4};
                pg8::gemm_phase(C.lds, C.tid, g, S, E); SEAM(); }
            if (RUN(14)) { PHASE_CTX(); phase_combine(a, C, L); SEAM(); }
        }
    }
#undef SEAM
#undef RUN
}

typedef void (*kern_t)(Params);
template <int PH> static kern_t phase_kernel() { return mixer_fwd<(1 << PH), false>; }
static kern_t get_kernel(int ph) {
    switch (ph) {
        case 0: return phase_kernel<0>(); case 1: return phase_kernel<1>(); case 2: return phase_kernel<2>(); case 3: return phase_kernel<3>(); case 4: return phase_kernel<4>();
        case 5: return phase_kernel<5>(); case 6: return phase_kernel<6>(); case 7: return phase_kernel<7>(); case 8: return phase_kernel<8>(); case 9: return phase_kernel<9>();
        case 10: return phase_kernel<10>(); case 11: return phase_kernel<11>(); case 12: return phase_kernel<12>(); case 13: return phase_kernel<13>(); default: return phase_kernel<14>();
    }
}
extern "C" void kernel_launch(void* const* d_in, const int* in_sizes, int n_in, void* d_out, int out_size, void* d_ws, size_t ws_size, hipStream_t stream) {
    static int grid = 0;
    if (grid == 0) {
        if (n_in != 29 || out_size != NBATCH * SEQ * DM || ws_size < WS_END) { fprintf(stderr, "kernel_launch: unexpected shapes (n_in %d, out %d, ws %zu < %zu)\n", n_in, out_size, ws_size, (size_t)WS_END); grid = -1; return; }
        int dev = 0, cus = 0;
        if (hipGetDevice(&dev) != hipSuccess || hipDeviceGetAttribute(&cus, hipDeviceAttributeMultiprocessorCount, dev) != hipSuccess) { grid = -1; return; }
#if MK_FUSED
        if (hipFuncSetAttribute((const void*)mixer_fwd<0x7fff, true>, hipFuncAttributeMaxDynamicSharedMemorySize, LDS_BYTES) != hipSuccess) { grid = -1; return; }
#else
        for (int ph = 0; ph < PH_PER_LAYER; ++ph) if (hipFuncSetAttribute((const void*)get_kernel(ph), hipFuncAttributeMaxDynamicSharedMemorySize, LDS_BYTES) != hipSuccess) { grid = -1; return; }
#endif
        (void)hipGetLastError();
        grid = cus;
    }
    if (grid < 0) return;
    (void)hipMemsetAsync((char*)d_ws + WS_CTL, 0, CTL_ZERO_BYTES, stream);
    Params p{};
    for (int i = 0; i < 29; ++i) p.in[i] = (const float*)d_in[i];
    p.out = (float*)d_out; p.ws = (unsigned char*)d_ws; p.pad = 0; p.ph_lo = 0; p.ph_hi = 0;
#if MK_FUSED
    p.l_lo = 0; p.l_hi = DEPTH; p.fused = 1;
    hipLaunchKernelGGL((mixer_fwd<0x7fff, true>), dim3(grid), dim3(NTHREADS), LDS_BYTES, stream, p);
#else
    p.fused = 0; p.l_lo = 0; p.l_hi = 1;
    hipLaunchKernelGGL(get_kernel(0), dim3(grid), dim3(NTHREADS), LDS_BYTES, stream, p);
#ifndef NL_RUN
#define NL_RUN DEPTH
#endif
    for (int L = 0; L < NL_RUN; ++L)
        for (int ph = 1; ph < PH_PER_LAYER; ++ph) {
            if (!(L & 1) && ph >= 13) continue;
            p.l_lo = L; p.l_hi = L + 1;
            hipLaunchKernelGGL(get_kernel(ph), dim3(grid), dim3(NTHREADS), LDS_BYTES, stream, p);
        }
#endif
}
```

```cpp
#include <hip/hip_runtime.h>
#include <cstdio>
#include <cstdint>

#ifndef MK_FUSED
#define MK_FUSED 1
#endif

#define DI __device__ __forceinline__
#define LANE_ID_ASM(dst) asm volatile("v_mbcnt_lo_u32_b32 %0, -1, 0\n\tv_mbcnt_hi_u32_b32 %0, -1, %0" : "=v"(dst))
#define LAS __attribute__((address_space(3)))
#define GAS __attribute__((address_space(1)))
typedef unsigned short bf16_t;
typedef short bf16x8 __attribute__((ext_vector_type(8)));
typedef short s16x4 __attribute__((ext_vector_type(4)));
typedef float f32x4 __attribute__((ext_vector_type(4)));
typedef float f32x2 __attribute__((ext_vector_type(2)));
typedef float f32x16 __attribute__((ext_vector_type(16)));
typedef unsigned u32x4 __attribute__((ext_vector_type(4)));
typedef unsigned u32x2 __attribute__((ext_vector_type(2)));

constexpr int DM = 1024, NBATCH = 2, SEQ = 8192, CTXL = 256, TPB = SEQ + CTXL, T = NBATCH * TPB, DEPTH = 4;
constexpr int INW = 6656, DFF = 2816, NEXP = 8, DFE = 1792;
constexpr int PW = 2560;
constexpr int C_U = 0, C_V = 256, C_WQ = 512, C_WK = 768, C_WV = 896, C_GQ = 1024, C_GK = 1280, C_GV = 1408, C_RQ = 1536, C_RK = 1792, C_RV = 2048, C_RG = 2304, C_GATE = 2560;
constexpr int NCHUNK = TPB / 128;
constexpr int NTILE_M = T / 256;
constexpr int MOE_ROWS = 2 * T + NEXP * 256;
constexpr int MOE2_FULL_RT = 128, MOE2_NP = 7, MOE2_PROWS = 12 * 256;
constexpr float EPS = 1e-6f;
constexpr float LOG2E = 1.4426950408889634f;
constexpr float QSCALE = 0.125f * LOG2E;

constexpr size_t MiB = 1u << 20;
constexpr size_t WS_CTL = 0, CTL_ZERO_BYTES = 1 * MiB;
constexpr size_t WS_MOD = 1 * MiB;
constexpr size_t WS_L2G = 1 * MiB + 512 * 1024;
constexpr size_t WS_TAB = 2 * MiB;
constexpr size_t TAB_AXC = 0, TAB_AXS = 8192 * 32 * 4, TAB_SQC = 2 * 8192 * 32 * 4, TAB_SQS = TAB_SQC + 8448 * 32 * 4;
constexpr size_t WS_WSB = 7 * MiB;
constexpr size_t WS_CTXB = 8 * MiB;
constexpr size_t WS_ROUTE = 10 * MiB;
constexpr size_t WS_VT = 12 * MiB;
constexpr size_t WS_KVT = 21 * MiB;
constexpr size_t WS_SIN = 38 * MiB;
constexpr size_t WS_H = 47 * MiB;
constexpr size_t WS_BR = 80 * MiB;
constexpr size_t WS_P = 113 * MiB;
constexpr size_t WS_HG = WS_P, WS_HIDM = WS_P + 70 * MiB;
constexpr size_t WS_GT = WS_P + 83 * MiB;
static_assert((size_t)T * PW * 2 <= 83 * MiB && WS_GT + (size_t)T * 4096 * 2 <= WS_P + 215 * MiB, "P + GT fit");
constexpr size_t WS_W = 328 * MiB;
constexpr size_t W_IN = 0, W_BR = 13 * MiB, W_OUT = 15 * MiB, W_13 = 17 * MiB, W_2 = 73 * MiB;
constexpr size_t W_BUF = 101 * MiB;
constexpr size_t WS_XS = WS_W + 2 * W_BUF;
constexpr size_t WS_Y2P = WS_XS + 33 * MiB;
constexpr size_t WS_END = WS_Y2P + 44 * MiB;
static_assert((size_t)T * INW * 2 <= 215 * MiB && WS_P + 215 * MiB <= WS_W, "P fits");
static_assert((size_t)MOE_ROWS * 1024 * 2 <= 70 * MiB && (size_t)MOE_ROWS * DFE * 2 + 70 * MiB <= 215 * MiB, "moe overlay fits");
constexpr int RT_E = 0;
constexpr int RT_POS = 2 * T;
constexpr int RT_PW = 4 * T;
constexpr int RT_ROWTOK = 6 * T;
constexpr int RT_ROWP = RT_ROWTOK + MOE_ROWS;
constexpr int RT_META = RT_ROWP + MOE_ROWS;
constexpr int RT_BLK = RT_META + 256;
static_assert((size_t)(RT_BLK + 2 * 1024 * 8) * 4 <= 2 * MiB, "route fits");
constexpr int CW_BAR = 4096;
constexpr int CW_CNT = 16384;

DI float bf2f(unsigned short h) { return __uint_as_float((unsigned)h << 16); }
DI unsigned f2bf(float f) { unsigned u = __float_as_uint(f); return (u + 0x7fffu + ((u >> 16) & 1u)) >> 16; }
typedef float f32x2_c __attribute__((ext_vector_type(2))); typedef __bf16 bf16x2_c __attribute__((ext_vector_type(2)));
DI unsigned pk2(float lo, float hi) { const f32x2_c v = {lo, hi}; return __builtin_bit_cast(unsigned, __builtin_convertvector(v, bf16x2_c)); }
DI float ex2(float x) { return __builtin_amdgcn_exp2f(x); }
DI float rcpf_(float x) { return __builtin_amdgcn_rcpf(x); }
DI float sigm(float x) { return rcpf_(1.f + ex2(-x * LOG2E)); }
DI float siluf_(float x) { return x * sigm(x); }
DI float gelu_tanh(float x) { const float u = 0.7978845608f * (x + 0.044715f * x * x * x); return x * sigm(2.f * u); }
DI float shx(float v, int o, int lane) { return __int_as_float(__builtin_amdgcn_ds_bpermute((lane ^ o) << 2, __float_as_int(v))); }
DI float wave_sum(float v, int lane) {
#pragma unroll
    for (int o = 1; o < 64; o <<= 1) v += shx(v, o, lane);
    return v;
}
DI int crow(int r, int hi) { return (r & 3) + 8 * (r >> 2) + 4 * hi; }
#define MFMA16(a, b, c) __builtin_amdgcn_mfma_f32_16x16x32_bf16((a), (b), (c), 0, 0, 0)
#define MFMA32(a, b, c) __builtin_amdgcn_mfma_f32_32x32x16_bf16((a), (b), (c), 0, 0, 0)

struct Params {
    const float* in[29];
    float* out; unsigned char* ws;
    int l_lo, l_hi, ph_lo, ph_hi, fused, pad;
};
DI const float* xrow_c(const float* lat, const float* ctx, int r) { const int b = r / TPB, p = r - b * TPB; return p < CTXL ? ctx + (size_t)(b * CTXL + p) * DM : lat + (size_t)(b * SEQ + p - CTXL) * DM; }
DI float* xrow(float* lat, float* ctx, int r) { const int b = r / TPB, p = r - b * TPB; return p < CTXL ? ctx + (size_t)(b * CTXL + p) * DM : lat + (size_t)(b * SEQ + p - CTXL) * DM; }
DI f32x4 y2_load4(const bf16_t* Y, const bf16_t* YP, int row, int c) {
    if (row < MOE2_FULL_RT * 256) { const u32x2 q = *(const u32x2*)(Y + (size_t)row * DM + c); return (f32x4){__uint_as_float(q.x << 16), __uint_as_float(q.x & 0xffff0000u), __uint_as_float(q.y << 16), __uint_as_float(q.y & 0xffff0000u)}; }
    f32x4 a = {0.f, 0.f, 0.f, 0.f}; u32x2 q[MOE2_NP];
#pragma unroll
    for (int p = 0; p < MOE2_NP; ++p) q[p] = *(const u32x2*)(YP + ((size_t)p * MOE2_PROWS + row - MOE2_FULL_RT * 256) * DM + c);
#pragma unroll
    for (int p = 0; p < MOE2_NP; ++p) { a[0] += __uint_as_float(q[p].x << 16); a[1] += __uint_as_float(q[p].x & 0xffff0000u); a[2] += __uint_as_float(q[p].y << 16); a[3] += __uint_as_float(q[p].y & 0xffff0000u); }
    return a;
}
DI int modrow(int r) { const int b = r / TPB, p = r - b * TPB; return p < CTXL ? 2 : b; }

namespace pg8 {
constexpr int BM = 256, BK = 64, HALF = 128, HTB = HALF * BK * 2, STAGE_BYTES = 8 * HTB, NXCD = 8, WGM = 8;
DI int lds_byte(int r, int c) { const int st = (r >> 4) * 2 + (c >> 5), rr = r & 15, cc = c & 31, ob = rr * 64 + cc * 2; return st * 1024 + (ob ^ (((ob >> 9) & 1) << 5)); }
DI void stage_rc(int b, int& R, int& C) { const int st = b / 1024, sb = b % 1024, swz = sb ^ (((sb >> 9) & 1) << 5); R = (st >> 1) * 16 + swz / 64; C = (st & 1) * 32 + (swz % 64) / 2; }
DI int perm32(int rho) { const int n = rho >> 4, i = rho & 15; return 8 * (i >> 2) + 4 * n + (i & 3); }
DI int xcd_vc(int G, int c) { return (G % 8 == 0) ? (c % 8) * (G / 8) + c / 8 : c; }
struct Unit { int pm, pn; int aoff, boff, nt, part; };
DI void unit_defaults(Unit& u) { u.aoff = 0; u.boff = 0; u.nt = 0; u.part = -1; }
struct Gemm { const bf16_t* A; const bf16_t* Bt; int lda, ldb, K; };

struct StaticOrder {
    int nM, nN, nwg, G, c;
    DI void init(int M, int N, int G_, int c_) { nM = M / BM; nN = N / BM; nwg = nM * nN; G = G_; c = c_; }
    DI bool next(int i, Unit& u) const {
        const long L = (long)i * G + c; if (L >= nwg) return false;
        int wgid = (int)L; { const int q = nwg / NXCD, r = nwg % NXCD, xcd = wgid % NXCD, off = wgid / NXCD; wgid = (xcd < r ? xcd * (q + 1) : r * (q + 1) + (xcd - r) * q) + off; }
        const int nig = WGM * nN, gid = wgid / nig, fm = gid * WGM, gsz = (nM - fm) < WGM ? (nM - fm) : WGM;
        u.pm = fm + ((wgid % nig) % gsz); u.pn = (wgid % nig) / gsz; unit_defaults(u); return true;
    }
};
struct MergeOrder : StaticOrder {
    DI bool next(int i, Unit& u) const { if (!StaticOrder::next(i, u)) return false; u.aoff = (u.pn >> 2) * 256 * 2; return true; }
};
struct LatOrder {
    int nN, G, c; bool lo;
    DI bool next(int i, Unit& u) const { const int Lx = i * G + xcd_vc(G, c); if (Lx >= (lo ? 64 : NTILE_M) * nN) return false; const int pt = Lx / nN; u.pm = lo ? pt + 1 + (pt >= 32) : pt; u.pn = Lx - pt * nN; unit_defaults(u); return true; }
};
struct CtxSplitOrder {
    int G, c, NP; bool lo;
    DI bool next(int i, Unit& u) const {
        const int Lx = i * G + c; unit_defaults(u);
        if (Lx < 256) { const int pt = Lx >> 2; u.pm = pt + 1 + (pt >= 32); u.pn = Lx & 3; return true; }
        if (lo) return false;
        const int S = Lx - 256; if (S >= 8 * NP) return false;
        const int tile = S / NP, piece = S - tile * NP; u.pm = (tile >> 2) * 33; u.pn = tile & 3; u.aoff = piece * 512; u.boff = piece * 512; u.nt = 4; u.part = piece; return true;
    }
};
struct Moe2Order {
    const int* meta; int G, c;
    DI bool next(int i, Unit& u) const {
        const int nrt = meta[0]; const int Lx = i * G + xcd_vc(G, c); unit_defaults(u);
        const int nfull = (nrt < MOE2_FULL_RT ? nrt : MOE2_FULL_RT) * 4;
        if (Lx < nfull) { u.pm = Lx >> 2; u.pn = meta[16 + u.pm] * 4 + (Lx & 3); return true; }
        const int S = Lx - nfull; if (nrt <= MOE2_FULL_RT || S >= (nrt - MOE2_FULL_RT) * 4 * MOE2_NP) return false;
        const int tile = S / MOE2_NP, piece = S - tile * MOE2_NP; u.pm = MOE2_FULL_RT + (tile >> 2); u.pn = meta[16 + u.pm] * 4 + (tile & 3);
        u.aoff = piece * 512; u.boff = piece * 512; u.nt = 4; u.part = piece; return true;
    }
};
struct InOrder {
    int G, c;
    DI bool next(int i, Unit& u) const {
        const int Lx = i * G + c; unit_defaults(u);
        if (Lx < NTILE_M * 10) { u.pm = Lx / 10; u.pn = Lx - u.pm * 10; return true; }
        const int j = Lx - NTILE_M * 10; if (j >= NTILE_M * 16) return false;
        u.pm = j >> 4; u.pn = 10 + (j & 15); return true;
    }
};
struct MoeOrder {
    const int* meta; int nNl, G, c;
    DI bool next(int i, Unit& u) const {
        const int nrt = meta[0]; const long L = (long)i * G + xcd_vc(G, c); if (L >= (long)nrt * nNl) return false;
        const int pm = (int)(L / nNl), pl = (int)(L % nNl); u.pm = pm; u.pn = meta[16 + pm] * nNl + pl; unit_defaults(u); return true;
    }
};

DI unsigned cvt_pk_bf16(float lo, float hi) { unsigned r; asm volatile("v_cvt_pk_bf16_f32 %0, %1, %2" : "=v"(r) : "v"(lo), "v"(hi)); return r; }

struct EpiIn {
    static constexpr bool PERM = true;
    bf16_t* O; bf16_t* GT; const float* tab; const float* gvv; const float* wqn; const float* wkn; const float* gqn; const float* gkn;
    DI void operator()(const f32x4 (&acc)[2][2][4][2], const Unit& u, int wr, int wc, int fr, int fq) const {
        const int lane = fq * 16 + fr;
        if (u.pn >= 1 && u.pn <= 8) {
            const int H = 4 * (u.pn - 1) + wc;
            int kind; const float* g = gvv + 64 * (H & 3); float scale = 1.f;
            if (H < 4) kind = 1;
            else if (H < 8) { kind = 2; g = wqn; scale = QSCALE; }
            else if (H < 10) { kind = 2; g = wkn; }
            else if (H < 12) kind = 0;
            else if (H < 16) { kind = 2; g = gqn; scale = QSCALE; }
            else if (H < 18) { kind = 2; g = gkn; }
            else if (H < 20) kind = 0;
            else if (H < 24) kind = 3;
            else if (H < 28) { kind = 3; scale = 0.125f; }
            else kind = 0;
            const int bb = u.pm / 33, jj = u.pm - bb * 33; const bool lat = jj != 0;
            f32x4 g0 = {1.f, 1.f, 1.f, 1.f}, g1 = g0, g2 = g0, g3 = g0;
            if (kind == 1 || kind == 2) { g0 = *(const f32x4*)(g + 8 * fq); g1 = *(const f32x4*)(g + 8 * fq + 4); g2 = *(const f32x4*)(g + 32 + 8 * fq); g3 = *(const f32x4*)(g + 32 + 8 * fq + 4); }
            const bool rope = (kind == 2 && lat) || kind == 3;
            const float* ctab = tab + (kind == 2 ? TAB_AXC : TAB_SQC) / 4 + 8 * fq; const float* stab = tab + (kind == 2 ? TAB_AXS : TAB_SQS) / 4 + 8 * fq;
#pragma unroll
            for (int ai = 0; ai < 2; ++ai)
#pragma unroll
                for (int m = 0; m < 4; ++m) {
                    const int rit = ai * HALF + wr * 64 + m * 16 + fr;
                    f32x4 x0 = acc[ai][0][m][0], x1 = acc[ai][0][m][1], y0 = acc[ai][1][m][0], y1 = acc[ai][1][m][1];
                    if (u.pn == 1) {
#pragma unroll
                        for (int e = 0; e < 4; ++e) { x0[e] = gelu_tanh(x0[e]); x1[e] = gelu_tanh(x1[e]); y0[e] = gelu_tanh(y0[e]); y1[e] = gelu_tanh(y1[e]); } }
                    if (kind == 1 || kind == 2) {
                        const f32x4 q = x0 * x0 + x1 * x1 + y0 * y0 + y1 * y1; float ss = (q[0] + q[1]) + (q[2] + q[3]);
                        ss += shx(ss, 16, lane); ss += shx(ss, 32, lane);
                        const float rs = __builtin_amdgcn_rsqf(ss * (1.f / 64.f) + EPS);
                        x0 = x0 * g0 * rs; x1 = x1 * g1 * rs; y0 = y0 * g2 * rs; y1 = y1 * g3 * rs;
                    }
                    if (rope) {
                        const int pos = kind == 2 ? (jj - 1) * 256 + rit : (lat ? CTXL + (jj - 1) * 256 + rit : rit);
                        const f32x4 c0 = *(const f32x4*)(ctab + (size_t)pos * 32), c1 = *(const f32x4*)(ctab + (size_t)pos * 32 + 4), s0 = *(const f32x4*)(stab + (size_t)pos * 32), s1 = *(const f32x4*)(stab + (size_t)pos * 32 + 4);
                        const f32x4 nx0 = x0 * c0 - y0 * s0, nx1 = x1 * c1 - y1 * s1, ny0 = x0 * s0 + y0 * c0, ny1 = x1 * s1 + y1 * c1;
                        x0 = nx0; x1 = nx1; y0 = ny0; y1 = ny1;
                    }
                    x0 = x0 * scale; x1 = x1 * scale; y0 = y0 * scale; y1 = y1 * scale;
                    bf16_t* rowp = O + (size_t)(u.pm * BM + rit) * PW + u.pn * BM + 64 * wc + 8 * fq;
                    u32x4 w; w.x = cvt_pk_bf16(x0[0], x0[1]); w.y = cvt_pk_bf16(x0[2], x0[3]); w.z = cvt_pk_bf16(x1[0], x1[1]); w.w = cvt_pk_bf16(x1[2], x1[3]); *(u32x4*)rowp = w;
                    u32x4 z; z.x = cvt_pk_bf16(y0[0], y0[1]); z.y = cvt_pk_bf16(y0[2], y0[3]); z.z = cvt_pk_bf16(y1[0], y1[1]); z.w = cvt_pk_bf16(y1[2], y1[3]); *(u32x4*)(rowp + 32) = z;
                    asm volatile("" ::: "memory"); }
            return;
        }
        const int row0 = u.pm * BM + wr * 64 + fr, col0 = u.pn * BM + wc * 32 + 8 * fq; const bool g = u.pn < 2, sg = u.pn >= 10;
        if (sg) {
            unsigned char* G8 = (unsigned char*)GT;
#pragma unroll
            for (int ai = 0; ai < 2; ++ai)
#pragma unroll
                for (int m = 0; m < 4; ++m) { u32x4 w;
#pragma unroll
                    for (int bj = 0; bj < 2; ++bj) { const f32x4 v0 = acc[ai][bj][m][0], v1 = acc[ai][bj][m][1]; unsigned lo = 0u, hi = 0u;
#pragma unroll
                        for (int e = 0; e < 4; ++e) { lo = __builtin_amdgcn_cvt_pk_u8_f32(sigm(v0[e]) * 255.f + 0.5f, e, lo); hi = __builtin_amdgcn_cvt_pk_u8_f32(sigm(v1[e]) * 255.f + 0.5f, e, hi); }
                        if (bj == 0) { w.x = lo; w.y = hi; } else { w.z = lo; w.w = hi; } }
                    const size_t blk = ((((size_t)(u.pm * 16 + (u.pn - 10)) * 2 + ai) * 4 + m) * 2 + wr) * 4 + wc; *(u32x4*)(G8 + blk * 1024 + lane * 16) = w;
                    asm volatile("" ::: "memory"); }
            return;
        }
#pragma unroll
        for (int ai = 0; ai < 2; ++ai)
#pragma unroll
            for (int m = 0; m < 4; ++m) { bf16_t* rowp = O + (size_t)(row0 + ai * HALF + m * 16) * PW + col0;
#pragma unroll
                for (int bj = 0; bj < 2; ++bj) { f32x4 v0 = acc[ai][bj][m][0], v1 = acc[ai][bj][m][1];
                    if (g) {
#pragma unroll
                        for (int e = 0; e < 4; ++e) { v0[e] = gelu_tanh(v0[e]); v1[e] = gelu_tanh(v1[e]); } }
                    u32x4 w; w.x = cvt_pk_bf16(v0[0], v0[1]); w.y = cvt_pk_bf16(v0[2], v0[3]); w.z = cvt_pk_bf16(v1[0], v1[1]); w.w = cvt_pk_bf16(v1[2], v1[3]);
                    *(u32x4*)(rowp + bj * HALF) = w; }
                asm volatile("" ::: "memory"); }
    }
};
struct EpiMerge {
    static constexpr bool PERM = true;
    bf16_t* P;
    DI void operator()(const f32x4 (&acc)[2][2][4][2], const Unit& u, int wr, int wc, int fr, int fq) const {
        const int row0 = u.pm * BM + wr * 64 + fr, col0 = C_GATE + u.pn * BM + wc * 32 + 8 * fq;
#pragma unroll
        for (int ai = 0; ai < 2; ++ai)
#pragma unroll
            for (int m = 0; m < 4; ++m) { bf16_t* rowp = P + (size_t)(row0 + ai * HALF + m * 16) * INW + col0;
#pragma unroll
                for (int bj = 0; bj < 2; ++bj)
#pragma unroll
                    for (int n = 0; n < 2; ++n) { const f32x4 v = acc[ai][bj][m][n];
                        const u32x2 gt = *(const u32x2*)(rowp + bj * HALF + 4 * n);
                        u32x2 w; w.x = cvt_pk_bf16(sigm(__uint_as_float(gt.x << 16)) * v[0], sigm(__uint_as_float(gt.x & 0xffff0000u)) * v[1]);
                        w.y = cvt_pk_bf16(sigm(__uint_as_float(gt.y << 16)) * v[2], sigm(__uint_as_float(gt.y & 0xffff0000u)) * v[3]);
                        *(u32x2*)(rowp + bj * HALF + 4 * n) = w; asm volatile("" ::: "memory"); }
                }
    }
};
struct EpiResid {
    static constexpr bool PERM = true;
    bf16_t* xs; const float* gate; bf16_t* part;
    DI void operator()(const f32x4 (&acc)[2][2][4][2], const Unit& u, int wr, int wc, int fr, int fq) const {
        asm volatile("" : "+v"(fr), "+v"(fq));
        const int col0 = u.pn * BM + wc * 32 + 8 * fq, r0 = wr * 64 + fr;
        if (u.part >= 0) {
            bf16_t* ps = part + ((size_t)(u.part * 2 + (u.pm != 0)) * 256) * DM;
#pragma unroll
            for (int ai = 0; ai < 2; ++ai)
#pragma unroll
                for (int m = 0; m < 4; ++m) { bf16_t* rowp = ps + (size_t)(r0 + ai * HALF + m * 16) * DM + col0;
#pragma unroll
                    for (int bj = 0; bj < 2; ++bj) { const f32x4 v0 = acc[ai][bj][m][0], v1 = acc[ai][bj][m][1];
                        u32x4 w; w.x = cvt_pk_bf16(v0[0], v0[1]); w.y = cvt_pk_bf16(v0[2], v0[3]); w.z = cvt_pk_bf16(v1[0], v1[1]); w.w = cvt_pk_bf16(v1[2], v1[3]); *(u32x4*)(rowp + bj * HALF) = w; } }
            return;
        }
        const int b = u.pm / 33, j = u.pm - b * 33;
        const float* gt = gate + (size_t)(j == 0 ? 2 : b) * 6144;
        bf16_t* xt = xs + (size_t)u.pm * BM * DM;
#pragma unroll
        for (int ai = 0; ai < 2; ++ai)
#pragma unroll
            for (int m = 0; m < 4; ++m) { const size_t off = (size_t)(r0 + ai * HALF + m * 16) * DM + col0;
#pragma unroll
                for (int bj = 0; bj < 2; ++bj) { const u32x4 q = *(const u32x4*)(xt + off + bj * HALF);
                    const f32x4 x0 = {__uint_as_float(q.x << 16), __uint_as_float(q.x & 0xffff0000u), __uint_as_float(q.y << 16), __uint_as_float(q.y & 0xffff0000u)};
                    const f32x4 x1 = {__uint_as_float(q.z << 16), __uint_as_float(q.z & 0xffff0000u), __uint_as_float(q.w << 16), __uint_as_float(q.w & 0xffff0000u)};
                    const f32x4 g0 = *(const f32x4*)(gt + col0 + bj * HALF), g1 = *(const f32x4*)(gt + col0 + bj * HALF + 4);
                    const f32x4 v0 = x0 + g0 * acc[ai][bj][m][0], v1 = x1 + g1 * acc[ai][bj][m][1];
                    u32x4 w; w.x = cvt_pk_bf16(v0[0], v0[1]); w.y = cvt_pk_bf16(v0[2], v0[3]); w.z = cvt_pk_bf16(v1[0], v1[1]); w.w = cvt_pk_bf16(v1[2], v1[3]); *(u32x4*)(xt + off + bj * HALF) = w; }
                asm volatile("" ::: "memory"); }
    }
};
struct EpiSwiglu {
    static constexpr bool PERM = true;
    bf16_t* O; int ldo; int nNl;
    DI void operator()(const f32x4 (&acc)[2][2][4][2], const Unit& u, int wr, int wc, int fr, int fq) const {
        const int row0 = u.pm * BM + wr * 64 + fr, col0 = (u.pn % nNl) * HALF + wc * 32 + 8 * fq;
#pragma unroll
        for (int ai = 0; ai < 2; ++ai)
#pragma unroll
            for (int m = 0; m < 4; ++m) { bf16_t* rowp = O + (size_t)(row0 + ai * HALF + m * 16) * ldo + col0;
                const f32x4 a0 = acc[ai][0][m][0], a1 = acc[ai][0][m][1], b0 = acc[ai][1][m][0], b1 = acc[ai][1][m][1];
                u32x4 w; w.x = cvt_pk_bf16(siluf_(a0[0]) * b0[0], siluf_(a0[1]) * b0[1]); w.y = cvt_pk_bf16(siluf_(a0[2]) * b0[2], siluf_(a0[3]) * b0[3]);
                w.z = cvt_pk_bf16(siluf_(a1[0]) * b1[0], siluf_(a1[1]) * b1[1]); w.w = cvt_pk_bf16(siluf_(a1[2]) * b1[2], siluf_(a1[3]) * b1[3]);
                *(u32x4*)rowp = w; asm volatile("" ::: "memory"); }
    }
};
struct EpiMoe2 {
    static constexpr bool PERM = true;
    bf16_t* Y; const float* rowp; int nNl; bf16_t* YP;
    DI void operator()(const f32x4 (&acc)[2][2][4][2], const Unit& u, int wr, int wc, int fr, int fq) const {
        const int col0 = (u.pn % nNl) * BM + wc * 32 + 8 * fq, r0 = u.pm * BM + wr * 64 + fr;
        bf16_t* Yb = u.part < 0 ? Y : YP + ((size_t)u.part * MOE2_PROWS - (size_t)MOE2_FULL_RT * 256) * DM;
#pragma unroll
        for (int ai = 0; ai < 2; ++ai)
#pragma unroll
            for (int m = 0; m < 4; ++m) { const int r = r0 + ai * HALF + m * 16; const float pw = rowp[r]; bf16_t* rowq = Yb + (size_t)r * DM + col0;
#pragma unroll
                for (int bj = 0; bj < 2; ++bj) { const f32x4 v0 = acc[ai][bj][m][0] * pw, v1 = acc[ai][bj][m][1] * pw;
                    u32x4 w; w.x = cvt_pk_bf16(v0[0], v0[1]); w.y = cvt_pk_bf16(v0[2], v0[3]); w.z = cvt_pk_bf16(v1[0], v1[1]); w.w = cvt_pk_bf16(v1[2], v1[3]);
                    *(u32x4*)(rowq + bj * HALF) = w; }
                asm volatile("" ::: "memory"); }
    }
};

template <class Epi, class Sched>
DI void gemm_phase(LAS unsigned char* lds, const int tid, const Gemm g, const Sched& S, const Epi& E) {
    constexpr bool SP2 = true, ALIGN_EPI = true;
    const int wid = __builtin_amdgcn_readfirstlane(tid >> 6), lane = tid & 63, wr = wid >> 2, wc = wid & 3, fr = lane & 15, fq = lane >> 4;
    const int K = g.K, ntf = K / BK;
    unsigned voffA[2], voffB[2];
#pragma unroll
    for (int i = 0; i < 2; ++i) { int R, C; stage_rc(tid * 16 + i * 8192, R, C); const int Rb = Epi::PERM ? ((R & ~31) + perm32(R & 31)) : R;
        voffA[i] = (unsigned)(R * g.lda + C) * 2u; voffB[i] = (unsigned)(Rb * g.ldb + C) * 2u; }
    const size_t kstep = (size_t)(BK * 2);
    const size_t hstepA = (size_t)HALF * g.lda * 2, hstepB = (size_t)HALF * g.ldb * 2;
    const size_t tstepA = 2 * hstepA, tstepB = 2 * hstepB;
    const unsigned ldsw = (unsigned)wid * 1024u;
    const int aoff = lds_byte(wr * 64 + fr, fq * 8), boff = lds_byte(wc * 32 + fr, fq * 8);
#define PG8_SA(b, h) (((b) * 2 + (h)) * HTB)
#define PG8_SB(b, h) ((4 + (b) * 2 + (h)) * HTB)
#define PG8_STAGE(bufoff, gbase, voff) do { _Pragma("unroll") for (int _i = 0; _i < 2; ++_i) \
        __builtin_amdgcn_global_load_lds((const unsigned*)((const char*)(gbase) + (voff)[_i]), (LAS unsigned*)(lds + (bufoff) + ldsw + _i * 8192), 16, 0, 0); } while (0)
#define PG8_LDA(dst, b, h) do { _Pragma("unroll") for (int m = 0; m < 4; ++m) _Pragma("unroll") for (int k = 0; k < 2; ++k) dst[m][k] = *(const LAS bf16x8*)(lds + PG8_SA(b, h) + aoff + m * 2048 + k * 1024); } while (0)
#define PG8_LDB(dst, b, h) do { _Pragma("unroll") for (int n = 0; n < 2; ++n) _Pragma("unroll") for (int k = 0; k < 2; ++k) dst[n][k] = *(const LAS bf16x8*)(lds + PG8_SB(b, h) + boff + n * 2048 + k * 1024); } while (0)
#define PG8_MMA(ai, bj, At, Bt) do { __builtin_amdgcn_s_setprio(1); _Pragma("unroll") for (int m = 0; m < 4; ++m) _Pragma("unroll") for (int n = 0; n < 2; ++n) _Pragma("unroll") for (int k = 0; k < 2; ++k) \
        acc[ai][bj][m][n] = __builtin_amdgcn_mfma_f32_16x16x32_bf16(Bt[n][k], At[m][k], acc[ai][bj][m][n], 0, 0, 0); __builtin_amdgcn_s_setprio(0); } while (0)
#define PG8_WAIT_V(n) asm volatile("s_waitcnt vmcnt(" #n ")" ::: "memory")
#define PG8_WAIT_L(n) asm volatile("s_waitcnt lgkmcnt(" #n ")" ::: "memory")
#define PG8_BAR __builtin_amdgcn_s_barrier()
#define PG8_SCHED __builtin_amdgcn_sched_barrier(0)
    Unit cur, nxt; int ui = 0;
    if (!S.next(0, cur)) return;
    f32x4 acc[2][2][4][2];
#pragma unroll
    for (int a = 0; a < 2; ++a)
#pragma unroll
        for (int b = 0; b < 2; ++b)
#pragma unroll
            for (int m = 0; m < 4; ++m)
#pragma unroll
                for (int n = 0; n < 2; ++n) acc[a][b][m][n] = (f32x4){0.f, 0.f, 0.f, 0.f};
    bf16x8 At[4][2], B0[2][2], B1[2][2];
    const char* cA = (const char*)g.A + (size_t)cur.pm * tstepA + cur.aoff; const char* cB = (const char*)g.Bt + (size_t)cur.pn * tstepB + cur.boff;
    PG8_STAGE(PG8_SB(0, 0), cB, voffB); PG8_STAGE(PG8_SB(0, 1), cB + hstepB, voffB); PG8_STAGE(PG8_SA(0, 0), cA, voffA); PG8_STAGE(PG8_SA(0, 1), cA + hstepA, voffA);
    if (wr == 1) PG8_BAR;
    PG8_WAIT_V(2); PG8_BAR;
    PG8_STAGE(PG8_SB(1, 0), cB + kstep, voffB); PG8_STAGE(PG8_SA(1, 0), cA + kstep, voffA); PG8_STAGE(PG8_SB(1, 1), cB + hstepB + kstep, voffB);
    PG8_WAIT_V(6); PG8_BAR;
    for (;;) {
        const bool has_next = S.next(ui + 1, nxt);
        const char* nA = has_next ? (const char*)g.A + (size_t)nxt.pm * tstepA + nxt.aoff : cA; const char* nB = has_next ? (const char*)g.Bt + (size_t)nxt.pn * tstepB + nxt.boff : cB;
        const int nt = cur.nt ? cur.nt : ntf;
        for (int t = 0; t < nt; t += 2) {
            const bool last = (t == nt - 2);
            const char* a1 = cA + (size_t)(t + 1) * kstep;
            const char* a2 = last ? nA : cA + (size_t)(t + 2) * kstep; const char* b2 = last ? nB : cB + (size_t)(t + 2) * kstep;
            const char* a3 = a2 + kstep; const char* b3 = b2 + kstep;
            PG8_LDB(B0, 0, 0); PG8_LDB(B1, 0, 1); PG8_SCHED; PG8_LDA(At, 0, 0); PG8_STAGE(PG8_SA(1, 1), a1 + hstepA, voffA);
            PG8_WAIT_V(8); PG8_WAIT_L(0); PG8_BAR; PG8_MMA(0, 0, At, B0); PG8_MMA(0, 1, At, B1); PG8_BAR; PG8_SCHED;
            PG8_LDA(At, 0, 1); PG8_STAGE(PG8_SB(0, 0), b2, voffB); PG8_STAGE(PG8_SB(0, 1), b2 + hstepB, voffB); PG8_STAGE(PG8_SA(0, 0), a2, voffA);
            PG8_WAIT_V(8); PG8_WAIT_L(0); PG8_BAR; PG8_MMA(1, 0, At, B0); PG8_MMA(1, 1, At, B1); PG8_BAR; PG8_SCHED;
            PG8_LDB(B0, 1, 0); PG8_LDB(B1, 1, 1); PG8_SCHED; PG8_LDA(At, 1, 0); PG8_STAGE(PG8_SA(0, 1), a2 + hstepA, voffA);
            PG8_WAIT_V(8); PG8_WAIT_L(0); PG8_BAR; PG8_MMA(0, 0, At, B0); PG8_MMA(0, 1, At, B1); PG8_BAR; PG8_SCHED;
            PG8_LDA(At, 1, 1); PG8_STAGE(PG8_SB(1, 0), b3, voffB); PG8_STAGE(PG8_SB(1, 1), b3 + hstepB, voffB); PG8_STAGE(PG8_SA(1, 0), a3, voffA);
            PG8_WAIT_V(8); PG8_WAIT_L(0); PG8_BAR; PG8_MMA(1, 0, At, B0); PG8_MMA(1, 1, At, B1); PG8_BAR; PG8_SCHED;
        }
        if constexpr (ALIGN_EPI) { if (wr == 0) PG8_BAR; }
        E(acc, cur, wr, wc, fr, fq);
        if (!has_next) break;
#pragma unroll
        for (int a = 0; a < 2; ++a)
#pragma unroll
            for (int b = 0; b < 2; ++b)
#pragma unroll
                for (int m = 0; m < 4; ++m)
#pragma unroll
                    for (int n = 0; n < 2; ++n) acc[a][b][m][n] = (f32x4){0.f, 0.f, 0.f, 0.f};
        cur = nxt; cA = nA; cB = nB; ++ui;
        if constexpr (ALIGN_EPI) { if (wr == 1) PG8_BAR; }
    }
    PG8_WAIT_V(0);
    if constexpr (!ALIGN_EPI) { if (wr == 0) PG8_BAR; }
    PG8_BAR;
#undef PG8_SA
#undef PG8_SB
#undef PG8_STAGE
#undef PG8_LDA
#undef PG8_LDB
#undef PG8_MMA
#undef PG8_WAIT_V
#undef PG8_WAIT_L
#undef PG8_BAR
#undef PG8_SCHED
}
DI void gemm_merge_phase(LAS unsigned char* lds, const int tid, const Gemm g, const int G_, const int c_, const bf16_t* Pg, bf16_t* Out, const bool latOnly) {
    typedef EpiIn Epi;
    constexpr bool SP2 = true, ALIGN_EPI = true;
    const int wid = __builtin_amdgcn_readfirstlane(tid >> 6), lane = tid & 63, wr = wid >> 2, wc = wid & 3, fr = lane & 15, fq = lane >> 4;
    const int K = g.K, nt = K / BK;
    unsigned voffA[2], voffB[2];
#pragma unroll
    for (int i = 0; i < 2; ++i) { int R, C; stage_rc(tid * 16 + i * 8192, R, C); const int Rb = Epi::PERM ? ((R & ~31) + perm32(R & 31)) : R;
        voffA[i] = (unsigned)(R * g.lda + C) * 2u; voffB[i] = (unsigned)(Rb * g.ldb + C) * 2u; }
    const size_t kstep = (size_t)(BK * 2);
    const size_t hstepA = (size_t)HALF * g.lda * 2, hstepB_real = (size_t)HALF * g.ldb * 2; const size_t hstepB = 0;
    const size_t tstepA = 2 * hstepA, tstepB = hstepB_real;
    const unsigned ldsw = (unsigned)wid * 1024u;
    const int aoff = lds_byte(wr * 64 + fr, fq * 8), boff = lds_byte(wc * 32 + fr, fq * 8);
#define PG8_SA(b, h) (((b) * 2 + (h)) * HTB)
#define PG8_SB(b, h) ((4 + (b) * 2 + (h)) * HTB)
#define PG8_STAGE(bufoff, gbase, voff) do { _Pragma("unroll") for (int _i = 0; _i < 2; ++_i) \
        __builtin_amdgcn_global_load_lds((const unsigned*)((const char*)(gbase) + (voff)[_i]), (LAS unsigned*)(lds + (bufoff) + ldsw + _i * 8192), 16, 0, 0); } while (0)
#define PG8_LDA(dst, b, h) do { _Pragma("unroll") for (int m = 0; m < 4; ++m) _Pragma("unroll") for (int k = 0; k < 2; ++k) dst[m][k] = *(const LAS bf16x8*)(lds + PG8_SA(b, h) + aoff + m * 2048 + k * 1024); } while (0)
#define PG8_LDB(dst, b, h) do { _Pragma("unroll") for (int n = 0; n < 2; ++n) _Pragma("unroll") for (int k = 0; k < 2; ++k) dst[n][k] = *(const LAS bf16x8*)(lds + PG8_SB(b, h) + boff + n * 2048 + k * 1024); } while (0)
#define PG8_MMA(ai, bj, At, Bt) do { __builtin_amdgcn_s_setprio(1); _Pragma("unroll") for (int m = 0; m < 4; ++m) _Pragma("unroll") for (int n = 0; n < 2; ++n) _Pragma("unroll") for (int k = 0; k < 2; ++k) \
        acc[ai][bj][m][n] = __builtin_amdgcn_mfma_f32_16x16x32_bf16(Bt[n][k], At[m][k], acc[ai][bj][m][n], 0, 0, 0); __builtin_amdgcn_s_setprio(0); } while (0)
#define PG8_WAIT_V(n) asm volatile("s_waitcnt vmcnt(" #n ")" ::: "memory")
#define PG8_WAIT_L(n) asm volatile("s_waitcnt lgkmcnt(" #n ")" ::: "memory")
#define PG8_BAR __builtin_amdgcn_s_barrier()
#define PG8_SCHED __builtin_amdgcn_sched_barrier(0)
    struct MSched { int G, c; bool lo; DI bool next(int i, Unit& u) const { const int Lx = i * G + c; if (Lx >= (lo ? 64 : NTILE_M) * 8) return false; const int pt = Lx >> 3; u.pm = lo ? pt + 1 + (pt >= 32) : pt; u.pn = Lx & 7; unit_defaults(u); return true; } } S{G_, c_, latOnly};
    Unit cur, nxt; int ui = 0;
    if (!S.next(0, cur)) return;
    f32x4 acc[2][1][4][2], fin[2][4][2];
#pragma unroll
    for (int a = 0; a < 2; ++a)
#pragma unroll
        for (int m = 0; m < 4; ++m)
#pragma unroll
            for (int n = 0; n < 2; ++n) { acc[a][0][m][n] = (f32x4){0.f, 0.f, 0.f, 0.f}; fin[a][m][n] = (f32x4){0.f, 0.f, 0.f, 0.f}; }
    bf16x8 At[4][2], B0[2][2]; u32x2 gt[2][4];
    const char* cA = (const char*)g.A + (size_t)cur.pm * tstepA + cur.aoff; const char* cB = (const char*)g.Bt + (size_t)cur.pn * tstepB;
    PG8_STAGE(PG8_SB(0, 0), cB, voffB); PG8_STAGE(PG8_SA(0, 0), cA, voffA); PG8_STAGE(PG8_SA(0, 1), cA + hstepA, voffA);
    if (wr == 1) PG8_BAR;
    PG8_WAIT_V(2); PG8_BAR;
    PG8_STAGE(PG8_SB(1, 0), cB + kstep, voffB); PG8_STAGE(PG8_SA(1, 0), cA + kstep, voffA);
    PG8_WAIT_V(4); PG8_BAR;
    for (;;) {
        const bool has_next = S.next(ui + 1, nxt);
        const char* nA = has_next ? (const char*)g.A + (size_t)nxt.pm * tstepA + nxt.aoff : cA; const char* nB = has_next ? (const char*)g.Bt + (size_t)nxt.pn * tstepB : cB;
        for (int tb = 0; tb < nt; tb += 4) {
#pragma unroll
            for (int hh = 0; hh < 2; ++hh) { const int t = tb + 2 * hh; const bool last = (t == nt - 2);
            if (hh == 1) {
                const int cb = (tb >> 2) * 8 + cur.pn; int frl = fr, fql = fq; asm volatile("" : "+v"(frl), "+v"(fql));
#pragma unroll
                for (int ai = 0; ai < 2; ++ai)
#pragma unroll
                    for (int mm = 0; mm < 4; ++mm) { const size_t blk = ((((size_t)(cur.pm * 16 + (cb >> 1)) * 2 + ai) * 4 + mm) * 2 + wr) * 4 + wc; asm volatile("global_load_dwordx2 %0, %1, off" : "=v"(gt[ai][mm]) : "v"((const unsigned char*)Pg + blk * 1024 + (fql * 16 + frl) * 16 + (cb & 1) * 8) : "memory"); }
            }
            const char* a1 = cA + (size_t)(t + 1) * kstep;
            const char* a2 = last ? nA : cA + (size_t)(t + 2) * kstep; const char* b2 = last ? nB : cB + (size_t)(t + 2) * kstep;
            const char* a3 = a2 + kstep; const char* b3 = b2 + kstep;
            PG8_LDB(B0, 0, 0); PG8_SCHED; PG8_LDA(At, 0, 0); PG8_STAGE(PG8_SA(1, 1), a1 + hstepA, voffA);
            PG8_WAIT_V(6); PG8_WAIT_L(0); PG8_BAR; PG8_MMA(0, 0, At, B0); PG8_BAR; PG8_SCHED;
            PG8_LDA(At, 0, 1); PG8_STAGE(PG8_SB(0, 0), b2, voffB); PG8_STAGE(PG8_SA(0, 0), a2, voffA);
            PG8_WAIT_V(6); PG8_WAIT_L(0); PG8_BAR; PG8_MMA(1, 0, At, B0); PG8_BAR; PG8_SCHED;
            PG8_LDB(B0, 1, 0); PG8_SCHED; PG8_LDA(At, 1, 0); PG8_STAGE(PG8_SA(0, 1), a2 + hstepA, voffA);
            PG8_WAIT_V(6); PG8_WAIT_L(0); PG8_BAR; PG8_MMA(0, 0, At, B0); PG8_BAR; PG8_SCHED;
            PG8_LDA(At, 1, 1); PG8_STAGE(PG8_SB(1, 0), b3, voffB); PG8_STAGE(PG8_SA(1, 0), a3, voffA);
            PG8_WAIT_V(6); PG8_WAIT_L(0); PG8_BAR; PG8_MMA(1, 0, At, B0); PG8_BAR; PG8_SCHED;
            }
            {
                asm volatile("s_waitcnt vmcnt(12)" : "+v"(gt[0][0]), "+v"(gt[0][1]), "+v"(gt[0][2]), "+v"(gt[0][3]), "+v"(gt[1][0]), "+v"(gt[1][1]), "+v"(gt[1][2]), "+v"(gt[1][3]) :: "memory");
#pragma unroll
                for (int ai = 0; ai < 2; ++ai)
#pragma unroll
                    for (int mm = 0; mm < 4; ++mm) { const u32x2 q = gt[ai][mm];
                        const f32x4 s0 = {(float)(q.x & 0xffu), (float)((q.x >> 8) & 0xffu), (float)((q.x >> 16) & 0xffu), (float)(q.x >> 24)};
                        const f32x4 s1 = {(float)(q.y & 0xffu), (float)((q.y >> 8) & 0xffu), (float)((q.y >> 16) & 0xffu), (float)(q.y >> 24)};
                        fin[ai][mm][0] += s0 * acc[ai][0][mm][0]; fin[ai][mm][1] += s1 * acc[ai][0][mm][1];
                        acc[ai][0][mm][0] = (f32x4){0.f, 0.f, 0.f, 0.f}; acc[ai][0][mm][1] = (f32x4){0.f, 0.f, 0.f, 0.f}; }
            }
        }
        if constexpr (ALIGN_EPI) { if (wr == 0) PG8_BAR; }
        { int frl = fr, fql = fq; asm volatile("" : "+v"(frl), "+v"(fql));
          bf16_t* op = Out + (size_t)(cur.pm * BM + wr * 64 + frl) * DM + cur.pn * HALF + wc * 32 + 8 * fql;
#pragma unroll
          for (int ai = 0; ai < 2; ++ai)
#pragma unroll
              for (int mm = 0; mm < 4; ++mm) { const f32x4 v0 = fin[ai][mm][0] * (1.f / 255.f), v1 = fin[ai][mm][1] * (1.f / 255.f);
                  u32x4 w; w.x = cvt_pk_bf16(v0[0], v0[1]); w.y = cvt_pk_bf16(v0[2], v0[3]); w.z = cvt_pk_bf16(v1[0], v1[1]); w.w = cvt_pk_bf16(v1[2], v1[3]);
                  *(u32x4*)(op + (size_t)(ai * HALF + mm * 16) * DM) = w; fin[ai][mm][0] = (f32x4){0.f, 0.f, 0.f, 0.f}; fin[ai][mm][1] = (f32x4){0.f, 0.f, 0.f, 0.f}; } }
        if (!has_next) break;
        cur = nxt; cA = nA; cB = nB; ++ui;
        if constexpr (ALIGN_EPI) { if (wr == 1) PG8_BAR; }
    }
    PG8_WAIT_V(0);
    if constexpr (!ALIGN_EPI) { if (wr == 0) PG8_BAR; }
    PG8_BAR;
#undef PG8_SA
#undef PG8_SB
#undef PG8_STAGE
#undef PG8_LDA
#undef PG8_LDB
#undef PG8_MMA
#undef PG8_WAIT_V
#undef PG8_WAIT_L
#undef PG8_BAR
#undef PG8_SCHED
}
}

#define XB_TMO      128
#define XB_XCNT(j)  (256  + 64 * (j))
#define XB_XSUB(j)  (1280 + 64 * (j))
#define XB_XGEN(j)  (2304 + 64 * (j))
#define XB_TOP      3328
#define XB_TOPGEN   3392
#define XCD_BAR_WORDS 3456
#define XB_SPIN_CAP (1u << 18)
DI unsigned xb_ld(unsigned* p)              { return __hip_atomic_load(p, __ATOMIC_RELAXED, __HIP_MEMORY_SCOPE_AGENT); }
DI unsigned xb_add(unsigned* p, unsigned v) { return __hip_atomic_fetch_add(p, v, __ATOMIC_RELAXED, __HIP_MEMORY_SCOPE_AGENT); }
DI unsigned xb_xcc_id() { return (unsigned)__builtin_amdgcn_s_getreg((3 << 11) | 20) & 0xFu; }
#define XB_SPIN(cond, bar) do { unsigned _sp = 0; while (cond) { __builtin_amdgcn_s_sleep(1); \
    if ((++_sp & 255u) == 0u) { if (xb_ld(&(bar)[XB_TMO])) break; if (_sp > XB_SPIN_CAP) { atomicAdd(&(bar)[XB_TMO], 1u); break; } } } } while (0)
struct XcdBarrier { unsigned* bar; unsigned x; volatile LAS unsigned* st; };
DI XcdBarrier xcd_barrier_post(unsigned* bar, volatile LAS unsigned* st) {
    XcdBarrier b; b.bar = bar; b.x = xb_xcc_id(); b.st = st;
    if (threadIdx.x == 0) (void)xb_add(&bar[XB_XCNT(b.x)], 1u);
    return b;
}
DI void xcd_barrier_complete(unsigned* bar, unsigned x, unsigned& nloc, unsigned& nx) {
    const unsigned G = gridDim.x * gridDim.y * gridDim.z;
    unsigned sum, cnt, mine, sp = 0u;
    for (;;) {
        sum = 0u; cnt = 0u; mine = 0u;
#pragma unroll
        for (unsigned j = 0; j < 16; ++j) { const unsigned c = xb_ld(&bar[XB_XCNT(j)]); sum += c; cnt += (c > 0u) ? 1u : 0u; mine = (j == x) ? c : mine; }
        if (sum == G) break;
        __builtin_amdgcn_s_sleep(1);
        if ((++sp & 255u) == 0u) { if (xb_ld(&bar[XB_TMO])) break; if (sp > XB_SPIN_CAP) { atomicAdd(&bar[XB_TMO], 1u); break; } }
    }
    nloc = mine > 0u ? mine : 1u; nx = cnt > 0u ? cnt : 1u;
}
__device__ __attribute__((noinline)) void xcd_barrier_fn(unsigned* bar_, unsigned x_, unsigned st_off, unsigned tid_) {
    XcdBarrier b; { const unsigned hi_ = (unsigned)__builtin_amdgcn_readfirstlane((int)((unsigned long long)bar_ >> 32)), lo_ = (unsigned)__builtin_amdgcn_readfirstlane((int)(unsigned)(unsigned long long)bar_);
      b.bar = (unsigned*)(((unsigned long long)hi_ << 32) | (unsigned long long)lo_); }
    b.x = (unsigned)__builtin_amdgcn_readfirstlane((int)x_); b.st = (volatile LAS unsigned*)(unsigned long long)(unsigned)__builtin_amdgcn_readfirstlane((int)st_off);
    asm volatile("s_waitcnt vmcnt(0)" ::: "memory");
    __syncthreads();
    if (tid_ == 0u) {
        unsigned* bar = b.bar;
        __builtin_amdgcn_s_waitcnt(0);
        unsigned nloc = b.st[0], nx = b.st[1];
        if (nloc == 0u) { xcd_barrier_complete(bar, b.x, nloc, nx); b.st[0] = nloc; b.st[1] = nx; }
        const unsigned old = xb_add(&bar[XB_XSUB(b.x)], 1u);
        const unsigned gen = old / nloc;
        if (old + 1u == (gen + 1u) * nloc) {
            __builtin_amdgcn_fence(__ATOMIC_RELEASE, "agent");
            asm volatile("s_waitcnt vmcnt(0)" ::: "memory");
            const unsigned og = xb_add(&bar[XB_TOP], 1u);
            const unsigned tg = og / nx;
            if (og + 1u == (tg + 1u) * nx) xb_add(&bar[XB_TOPGEN], 1u);
            else XB_SPIN(xb_ld(&bar[XB_TOPGEN]) == tg, bar);
            __builtin_amdgcn_fence(__ATOMIC_ACQUIRE, "agent");
            xb_add(&bar[XB_XGEN(b.x)], 1u);
            asm volatile("s_waitcnt vmcnt(0)" ::: "memory");
        } else {
            XB_SPIN(xb_ld(&bar[XB_XGEN(b.x)]) == gen, bar);
            __builtin_amdgcn_fence(__ATOMIC_ACQUIRE, "agent");
            asm volatile("s_waitcnt vmcnt(0)" ::: "memory");
        }
    }
    __syncthreads();
}

#include <hip/hip_bf16.h>
#include <cmath>
namespace attn_body {
using bf16=__hip_bfloat16;
using bf16x8=__attribute__((ext_vector_type(8)))short;
using s16x4=__attribute__((ext_vector_type(4)))short;
using f32x16=__attribute__((ext_vector_type(16)))float;
using u32x4=__attribute__((ext_vector_type(4)))unsigned;
constexpr int D=64,PQ=2560,PO=1024,TPBA=8448,NKT=TPBA/64;
constexpr int NW=8,QBLK=32,QB=QBLK*NW,KVBLK=64;
__device__ __forceinline__ int crow(int r,int hi){return (r&3)+8*(r>>2)+4*hi;}
#define SBAR() __builtin_amdgcn_sched_barrier(0)
__device__ __forceinline__ void cmask(f32x16&p0,f32x16&p1,int jb,int qrel,int hi){
  const float NEG=-INFINITY; int kb=64*jb+4*hi;
  #pragma unroll
  for(int r=0;r<16;++r){int kv=kb+(r&3)+8*(r>>2); if(kv>qrel)p0[r]=NEG; if(kv+32>qrel)p1[r]=NEG;}
}

constexpr int NSLOT=3, SLOTB=8192;
constexpr int LDS_K=0, LDS_V=NSLOT*SLOTB, LDS_WS=2*NSLOT*SLOTB, LDS_OST=LDS_WS+NW*64*4, LDS_BYTES=LDS_OST+NW*4096;
constexpr float C2=0.125f*1.4426950408889634f;
__device__ __forceinline__ void glds16(const void*gsrc,unsigned lds_dst){unsigned keep;
  asm volatile("s_mov_b32 %0, m0\n\ts_mov_b32 m0, %2\n\ts_nop 0\n\tglobal_load_lds_dwordx4 %1, off\n\ts_mov_b32 m0, %0":"=&s"(keep):"v"(gsrc),"s"(lds_dst):"memory");}
__device__ __forceinline__ float max3f(float a,float b,float c){float r;asm("v_max3_f32 %0, %1, %2, %3":"=v"(r):"v"(a),"v"(b),"v"(c));return r;}
__device__ __forceinline__ float max2f(float a,float b){float r;asm("v_max_f32_e32 %0, %1, %2":"=v"(r):"v"(a),"v"(b));return r;}
__device__ __forceinline__ float fadd_s(float a,float b){float r;asm("v_add_f32_e32 %0, %1, %2":"=v"(r):"v"(a),"v"(b));return r;}
__device__ __forceinline__ float fsub_s(float a,float b){float r;asm("v_sub_f32_e32 %0, %1, %2":"=v"(r):"v"(a),"v"(b));return r;}
typedef float f32x2_t __attribute__((ext_vector_type(2))); typedef __bf16 bf16x2_t __attribute__((ext_vector_type(2)));
__device__ __forceinline__ unsigned cvtpk_s(float lo,float hi){f32x2_t v={lo,hi};bf16x2_t b=__builtin_convertvector(v,bf16x2_t);return __builtin_bit_cast(unsigned,b);}
#define WAIT_BAR(N) asm volatile("s_waitcnt vmcnt(" #N ") lgkmcnt(0)\n\ts_barrier":::"memory")

__device__ __forceinline__ void qkt(f32x16&p0,f32x16&p1,const char*Kslot,const bf16x8*qr,const f32x16&negm,int r32,int hi){
  const char*kb=Kslot+hi*1024+r32*16;
  #pragma unroll
  for(int d0=0;d0<4;++d0){
    const bf16x8 b0=*reinterpret_cast<const bf16x8*>(kb+d0*2048);
    const bf16x8 b1=*reinterpret_cast<const bf16x8*>(kb+d0*2048+512);
    if(d0==0){p0=__builtin_amdgcn_mfma_f32_32x32x16_bf16(b0,qr[0],negm,0,0,0);p1=__builtin_amdgcn_mfma_f32_32x32x16_bf16(b1,qr[0],negm,0,0,0);}
    else{p0=__builtin_amdgcn_mfma_f32_32x32x16_bf16(b0,qr[d0],p0,0,0,0);p1=__builtin_amdgcn_mfma_f32_32x32x16_bf16(b1,qr[d0],p1,0,0,0);}}
}
typedef __attribute__((address_space(3))) const char* lds_cptr;
typedef short v4i16_t __attribute__((ext_vector_type(4)));
__device__ __forceinline__ void kload8(bf16x8*kf,lds_cptr kp){
  kf[0]=*(const __attribute__((address_space(3))) bf16x8*)(kp);      kf[1]=*(const __attribute__((address_space(3))) bf16x8*)(kp+512);
  kf[2]=*(const __attribute__((address_space(3))) bf16x8*)(kp+2048); kf[3]=*(const __attribute__((address_space(3))) bf16x8*)(kp+2560);
  kf[4]=*(const __attribute__((address_space(3))) bf16x8*)(kp+4096); kf[5]=*(const __attribute__((address_space(3))) bf16x8*)(kp+4608);
  kf[6]=*(const __attribute__((address_space(3))) bf16x8*)(kp+6144); kf[7]=*(const __attribute__((address_space(3))) bf16x8*)(kp+6656);
}
__device__ __forceinline__ void kload2(bf16x8*kf,lds_cptr kp,int j){ kf[2*j]=*(const __attribute__((address_space(3))) bf16x8*)(kp+j*2048); kf[2*j+1]=*(const __attribute__((address_space(3))) bf16x8*)(kp+j*2048+512); }
__device__ __forceinline__ s16x4 vtr(lds_cptr p){ return __builtin_bit_cast(s16x4,__builtin_amdgcn_ds_read_tr16_b64_v4i16((__attribute__((address_space(3))) v4i16_t*)p)); }
__device__ __forceinline__ float rowmax(const f32x16&p0,const f32x16&p1){
  float a=max3f(p0[0],p0[1],p1[0]),b=max3f(p0[2],p0[3],p1[1]);a=max3f(a,p1[2],p1[3]);
  #pragma unroll
  for(int r=4;r<16;r+=4){a=max3f(a,p0[r],p0[r+1]);b=max3f(b,p0[r+2],p0[r+3]);a=max3f(a,p1[r],p1[r+1]);b=max3f(b,p1[r+2],p1[r+3]);}
  const float m=max2f(a,b);
  auto rr=__builtin_amdgcn_permlane32_swap(__float_as_uint(m),__float_as_uint(m),false,false);
  return max2f(__uint_as_float(rr[0]),__uint_as_float(rr[1]));
}
__device__ __forceinline__ void pv(f32x16*o,int vb,bf16x8 pa0,bf16x8 pa1,bf16x8 pa2,bf16x8 pa3){
  #pragma unroll
  for(int d0=0;d0<2;++d0){s16x4 lo[4],hi[4];
    #pragma unroll
    for(int ks=0;ks<4;++ks){
      asm volatile("ds_read_b64_tr_b16 %0,%1 offset:%c2":"=&v"(lo[ks]):"v"(vb),"i"(d0*4096+ks*1024):"memory");
      asm volatile("ds_read_b64_tr_b16 %0,%1 offset:%c2":"=&v"(hi[ks]):"v"(vb),"i"(d0*4096+ks*1024+512):"memory");}
    asm volatile("s_waitcnt lgkmcnt(0)":::"memory");SBAR();
    #define PK(k) (bf16x8){lo[k][0],lo[k][1],lo[k][2],lo[k][3],hi[k][0],hi[k][1],hi[k][2],hi[k][3]}
    o[d0]=__builtin_amdgcn_mfma_f32_32x32x16_bf16(pa0,PK(0),o[d0],0,0,0);
    o[d0]=__builtin_amdgcn_mfma_f32_32x32x16_bf16(pa1,PK(1),o[d0],0,0,0);
    o[d0]=__builtin_amdgcn_mfma_f32_32x32x16_bf16(pa2,PK(2),o[d0],0,0,0);
    o[d0]=__builtin_amdgcn_mfma_f32_32x32x16_bf16(pa3,PK(3),o[d0],0,0,0);
    #undef PK
  }
}

#ifndef ATTN_STORE16
#define ATTN_STORE16(p,v) (*(u32x4*)(p)=(v))
#endif
template<int THRL> __device__ __forceinline__ void attn_unit(long qrow0,long krow0,int qcol,int kcol,int vcol,int ocol,const bf16*Pb,bf16*Ob,char*shm,const int tid,const float zf){
  const int lane=tid&63,r32=lane&31,hi=lane>>5; const int wid=__builtin_amdgcn_readfirstlane(tid>>6);
  const bf16*Qw=Pb+(qrow0+wid*QBLK)*PQ+qcol;
  const bf16*Kh=Pb+krow0*PQ+kcol,*Vh=Pb+krow0*PQ+vcol;
  const unsigned lds0=(unsigned)(uintptr_t)shm;
  float*wsf=(float*)(shm+LDS_WS)+wid*64;
  const bf16*ksrc=Kh+(long)lane*PQ+wid*8;
  const bf16*vsrc=Vh+(long)(16*(wid&3)+(lane>>2))*PQ+(wid>>2)*32+(lane&3)*8;
  const unsigned kdst=lds0+LDS_K+wid*1024, vdst=lds0+LDS_V+wid*1024;
  #define DMA_K(t,slot) glds16(ksrc+(long)(t)*KVBLK*PQ,(unsigned)__builtin_amdgcn_readfirstlane(kdst+(slot)))
  #define DMA_V(t,slot) glds16(vsrc+(long)(t)*KVBLK*PQ,(unsigned)__builtin_amdgcn_readfirstlane(vdst+(slot)))
  const int vb0=(int)(lds0+LDS_V)+((lane>>4)&1)*32+(lane&3)*8+(4*hi+((lane&15)>>2))*64;
  const char*Kbase=shm+LDS_K; bf16x8 kf[8];
  const lds_cptr shm3=(lds_cptr)shm; const lds_cptr kp0=shm3+LDS_K+hi*1024+r32*16; const lds_cptr vp0=shm3+LDS_V+((lane>>4)&1)*32+(lane&3)*8+(4*hi+((lane&15)>>2))*64;
  const int NT=NKT;
  DMA_K(0,0);DMA_V(0,0);DMA_K(1,SLOTB);
  bf16x8 qr[4];
  #pragma unroll
  for(int d0=0;d0<4;++d0)qr[d0]=*reinterpret_cast<const bf16x8*>(&Qw[(long)r32*PQ+d0*16+hi*8]);
  float mhat=0.f,l_reg=0.f;f32x16 o[2];f32x16 negm;
  _Pragma("unroll") for(int r=0;r<16;++r){o[0][r]=zf;o[1][r]=zf;negm[r]=zf;} asm volatile("":"+v"(negm));
  #define CMASK(P0,P1,t) do{}while(0)
  bool resc=false;
  #define START(P0,P1) do{ const float rm=rowmax(P0,P1); resc=false; \
    { const float dl=rm; mhat=fadd_s(mhat,dl); \
      _Pragma("unroll") for(int r=0;r<16;++r){P0[r]=fsub_s(P0[r],dl);P1[r]=fsub_s(P1[r],dl);} \
      _Pragma("unroll") for(int r=0;r<16;++r)negm[r]=-mhat; asm volatile("":"+v"(negm)); } \
    _Pragma("unroll") for(int r=0;r<16;++r)P0[r]=__builtin_amdgcn_exp2f(P0[r]); }while(0)
  #define RESC() do{ if(resc){ asm volatile("s_waitcnt lgkmcnt(0)":::"memory"); \
      _Pragma("unroll") for(int d_=0;d_<2;++d_) _Pragma("unroll") for(int r=0;r<16;++r)o[d_][r]*=wsf[crow(r,hi)]; } }while(0)
  f32x16 pA0,pA1,pB0,pB1;
  int sl_prev=0,sl_cur=0,sl_next=SLOTB;
  #define ROT() do{sl_prev=sl_cur;sl_cur=sl_next;sl_next=(sl_next==(NSLOT-1)*SLOTB)?0:sl_next+SLOTB;}while(0)
  DMA_K(2,2*SLOTB);
  WAIT_BAR(3);
  qkt(pA0,pA1,Kbase,qr,negm,r32,hi);asm volatile("s_nop 15\n\ts_nop 7":"+v"(pA0),"+v"(pA1));CMASK(pA0,pA1,0);
  START(pA0,pA1);
  _Pragma("unroll") for(int r=0;r<16;++r)pA1[r]=__builtin_amdgcn_exp2f(pA1[r]);
  WAIT_BAR(0);
  DMA_K(3,0);DMA_V(1,SLOTB);
  ROT();
  kload8(kf,kp0+sl_cur);
  WAIT_BAR(2);
  s16x4 vlo[8],vhi[8]; u32x4 pw0,pw1,pw2,pw3;
  #define PKW(P,B) cvtpk_s(P[B],P[B+1])
  #define PAF(k) __builtin_bit_cast(bf16x8,pw##k)
  #define VFR(i) (bf16x8){vlo[i][0],vlo[i][1],vlo[i][2],vlo[i][3],vhi[i][0],vhi[i][1],vhi[i][2],vhi[i][3]}
  #define PIN(x) asm volatile("":"+v"(x))
  #define MX3(a,b,c) __builtin_fmaxf(__builtin_fmaxf((a),(b)),(c))
  #define GAPA(MF,A0,A1,A2,A3,W0,W1,PW) do{ MF; sacc+=A0; sacc+=A1; sacc+=A2; sacc+=A3; PIN(sacc); W0; W1; PIN(PW); SBAR(); }while(0)
  #define EX(v) __builtin_amdgcn_exp2f(v)
  #define GAPB(MF,X,B) do{ MF; X[B]=EX(X[B]); X[B+1]=EX(X[B+1]); X[B+2]=EX(X[B+2]); X[B+3]=EX(X[B+3]); PIN(X); SBAR(); }while(0)
  #define VRD(i) do{ vlo[i]=vtr(vp_+(((i)>>2)*4096+((i)&3)*1024)); vhi[i]=vtr(vp_+(((i)>>2)*4096+((i)&3)*1024+512)); }while(0)
  #define KRD(G,j) do{ if(G){ kload2(kf,kp0+sl_next,j); SBAR(); } }while(0)
  #define STEP(C0,C1,P0,P1,t,GK,GV,GL) do{ SBAR(); \
    const lds_cptr vp_=vp0+sl_prev; \
    VRD(0); SBAR(); float sacc=(P0[0]+P0[1]); \
    GAPA(C0=__builtin_amdgcn_mfma_f32_32x32x16_bf16(kf[0],qr[0],negm,0,0,0), P0[2],P0[3],P0[4],P0[5],     pw0[0]=PKW(P0,0), pw0[1]=PKW(P0,2), pw0); \
    VRD(4); SBAR(); GAPA(C1=__builtin_amdgcn_mfma_f32_32x32x16_bf16(kf[1],qr[0],negm,0,0,0), P0[6],P0[7],P0[8],P0[9],     pw0[2]=PKW(P0,4), pw0[3]=PKW(P0,6), pw0); \
    VRD(1); SBAR(); GAPA(C0=__builtin_amdgcn_mfma_f32_32x32x16_bf16(kf[2],qr[1],C0,0,0,0),   P0[10],P0[11],P0[12],P0[13], pw1[0]=PKW(P0,8), pw1[1]=PKW(P0,10), pw1); \
    VRD(5); SBAR(); GAPA(C1=__builtin_amdgcn_mfma_f32_32x32x16_bf16(kf[3],qr[1],C1,0,0,0),   P0[14],P0[15],P1[0],P1[1],   pw1[2]=PKW(P0,12),pw1[3]=PKW(P0,14), pw1); \
    VRD(2); SBAR(); GAPA(C0=__builtin_amdgcn_mfma_f32_32x32x16_bf16(kf[4],qr[2],C0,0,0,0),   P1[2],P1[3],P1[4],P1[5],     pw2[0]=PKW(P1,0), pw2[1]=PKW(P1,2), pw2); \
    VRD(6); SBAR(); GAPA(C1=__builtin_amdgcn_mfma_f32_32x32x16_bf16(kf[5],qr[2],C1,0,0,0),   P1[6],P1[7],P1[8],P1[9],     pw2[2]=PKW(P1,4), pw2[3]=PKW(P1,6), pw2); \
    VRD(3); SBAR(); GAPA(C0=__builtin_amdgcn_mfma_f32_32x32x16_bf16(kf[6],qr[3],C0,0,0,0),   P1[10],P1[11],P1[12],P1[13], pw3[0]=PKW(P1,8), pw3[1]=PKW(P1,10), pw3); \
    VRD(7); SBAR(); GAPA(C1=__builtin_amdgcn_mfma_f32_32x32x16_bf16(kf[7],qr[3],C1,0,0,0),   P1[14],P1[15],0.f,0.f,       pw3[2]=PKW(P1,12),pw3[3]=PKW(P1,14), pw3); \
    l_reg+=sacc; \
    if(GK){DMA_K((t)+3,sl_cur);} if(GV){DMA_V((t)+1,sl_next);} \
    CMASK(C0,C1,t); \
    { float a=MX3(C0[0],C0[1],C1[0]),b=MX3(C0[2],C0[3],C1[1]); a=MX3(a,C1[2],C1[3]); \
      _Pragma("unroll") for(int r=4;r<16;r+=4){a=MX3(a,C0[r],C0[r+1]);b=MX3(b,C0[r+2],C0[r+3]);a=MX3(a,C1[r],C1[r+1]);b=MX3(b,C1[r+2],C1[r+3]);} \
      float rm=__builtin_fmaxf(a,b); { auto rr=__builtin_amdgcn_permlane32_swap(__float_as_uint(rm),__float_as_uint(rm),false,false); rm=__builtin_fmaxf(__uint_as_float(rr[0]),__uint_as_float(rr[1])); } \
      resc=false; \
      if(__builtin_expect(__any(rm>(float)THRL),0)){ const float dl=__builtin_fmaxf(rm,0.f); mhat+=dl; \
        _Pragma("unroll") for(int r=0;r<16;++r){C0[r]-=dl;C1[r]-=dl;} \
        _Pragma("unroll") for(int r=0;r<16;++r)negm[r]=-mhat; asm volatile("":"+v"(negm)); \
        const float f=__builtin_amdgcn_exp2f(-dl); l_reg*=f; if(hi==0)wsf[r32]=f; resc=true; } } \
    SBAR(); \
    GAPB(o[0]=__builtin_amdgcn_mfma_f32_32x32x16_bf16(PAF(0),VFR(0),o[0],0,0,0), C0,0); \
    GAPB(o[1]=__builtin_amdgcn_mfma_f32_32x32x16_bf16(PAF(0),VFR(4),o[1],0,0,0), C0,4); \
    KRD(GL,0); GAPB(o[0]=__builtin_amdgcn_mfma_f32_32x32x16_bf16(PAF(1),VFR(1),o[0],0,0,0), C0,8); \
    KRD(GL,1); GAPB(o[1]=__builtin_amdgcn_mfma_f32_32x32x16_bf16(PAF(1),VFR(5),o[1],0,0,0), C0,12); \
    KRD(GL,2); GAPB(o[0]=__builtin_amdgcn_mfma_f32_32x32x16_bf16(PAF(2),VFR(2),o[0],0,0,0), C1,0); \
    KRD(GL,3); GAPB(o[1]=__builtin_amdgcn_mfma_f32_32x32x16_bf16(PAF(2),VFR(6),o[1],0,0,0), C1,4); \
    GAPB(o[0]=__builtin_amdgcn_mfma_f32_32x32x16_bf16(PAF(3),VFR(3),o[0],0,0,0), C1,8); \
    GAPB(o[1]=__builtin_amdgcn_mfma_f32_32x32x16_bf16(PAF(3),VFR(7),o[1],0,0,0), C1,12); \
    }while(0)
  int t=1;
  #undef CMASK
  #define CMASK(P0,P1,t) do{}while(0)
  _Pragma("nounroll") for(;t+5<NT;t+=2){
    STEP(pB0,pB1,pA0,pA1,t,true,true,true);     WAIT_BAR(2); RESC(); ROT();
    STEP(pA0,pA1,pB0,pB1,t+1,true,true,true);   WAIT_BAR(2); RESC(); ROT();
  }
  #undef CMASK
  #define CMASK(P0,P1,t) do{}while(0)
  #define ENDW(tt) do{ if((tt)+3<NT){WAIT_BAR(2);} else if((tt)+2<NT){WAIT_BAR(1);} else {WAIT_BAR(0);} }while(0)
  _Pragma("nounroll") for(;t+1<NT;t+=2){
    STEP(pB0,pB1,pA0,pA1,t,(t+3<NT),(t+1<NT),(t+1<NT));       ENDW(t);   RESC(); ROT();
    STEP(pA0,pA1,pB0,pB1,t+1,(t+4<NT),(t+2<NT),(t+2<NT));     ENDW(t+1); RESC(); ROT();
  }
  STEP(pB0,pB1,pA0,pA1,NT-1,false,false,false); RESC();
  { float sacc=pB0[0]+pB0[1]; _Pragma("unroll") for(int r=2;r<16;++r)sacc+=pB0[r]; _Pragma("unroll") for(int r=0;r<16;++r)sacc+=pB1[r]; l_reg+=sacc;
    pw0=(u32x4){PKW(pB0,0),PKW(pB0,2),PKW(pB0,4),PKW(pB0,6)};pw1=(u32x4){PKW(pB0,8),PKW(pB0,10),PKW(pB0,12),PKW(pB0,14)};pw2=(u32x4){PKW(pB1,0),PKW(pB1,2),PKW(pB1,4),PKW(pB1,6)};pw3=(u32x4){PKW(pB1,8),PKW(pB1,10),PKW(pB1,12),PKW(pB1,14)};
    SBAR(); pv(o,vb0+sl_cur,PAF(0),PAF(1),PAF(2),PAF(3)); }
  #undef PKW
  #undef PAF
  #undef VFR
  #undef PIN
  #undef MX3
  #undef GAPA
  #undef GAPB
  #undef EX
  #undef VRD
  #undef KRD
  #undef STEP
  #undef ENDW
  {auto rr=__builtin_amdgcn_permlane32_swap(__float_as_uint(l_reg),__float_as_uint(l_reg),false,false);l_reg=__uint_as_float(rr[0])+__uint_as_float(rr[1]);}
  if(hi==0)wsf[32+r32]=l_reg;asm volatile("s_waitcnt lgkmcnt(0)":::"memory");
  float rli[16];
  #pragma unroll
  for(int r=0;r<16;++r)rli[r]=__builtin_amdgcn_rcpf(wsf[32+crow(r,hi)]);
  bf16*Ow=Ob+(qrow0+wid*QBLK)*PO+ocol;
  { bf16*stg=(bf16*)(shm+LDS_OST)+wid*2048;
    #pragma unroll
    for(int r=0;r<16;++r){const int orow=crow(r,hi);
      #pragma unroll
      for(int d0=0;d0<2;++d0)stg[orow*64+d0*32+r32]=__float2bfloat16(o[d0][r]*rli[r]);}
    asm volatile("s_waitcnt lgkmcnt(0)":::"memory");
    #pragma unroll
    for(int i=0;i<4;++i){const int row=i*8+(lane>>3),ch=lane&7; const u32x4 v=*(const u32x4*)(stg+row*64+ch*8); ATTN_STORE16(Ow+(long)row*PO+ch*8,v);} }
  asm volatile("s_waitcnt lgkmcnt(0)\n\ts_barrier":::"memory");
  #undef DMA_K
  #undef DMA_V
  #undef CMASK
  #undef START
  #undef RESC
  #undef ROT
}
constexpr int ATTN_LDS_BYTES=LDS_BYTES;
#undef SBAR
#undef WAIT_BAR
}

constexpr int NWAVES = 8, NTHREADS = 512;
constexpr int RING_BYTES = 131072, MISC_OFF = RING_BYTES + 320, LDS_BYTES = 147456;

struct Ctx {
    LAS unsigned char* lds; int tid, lane, wave, G, bid, z;
    float* out; unsigned char* ws;
};
#define WSP(T_, off) ((T_*)(C.ws + (off)))

DI float log2_sigmoid(float x) { return -log1pf(expf(-x)) * LOG2E; }
DI void phase_g0(const Params& a, const Ctx& C) {
    const float* cvec = a.in[C.z + 1]; const float* cctx = a.in[C.z + 3]; const float* w_mod = a.in[C.z + 4]; const float* b_mod = a.in[C.z + 5];
    float* mod = WSP(float, WS_MOD);
    LAS float* red = (LAS float*)C.lds;
    for (int u = C.bid; u < DEPTH * 48; u += C.G) {
        const int L = u / 48, cg = u % 48, col = cg * 128 + 2 * C.lane;
        f32x2 a0 = {0.f, 0.f}, a1 = a0, a2 = a0;
        const float* w = w_mod + (size_t)L * DM * 6144 + col;
#pragma unroll 16
        for (int kk = 0; kk < 128; ++kk) { const int k = C.wave * 128 + kk; const f32x2 wv = *(const f32x2*)(w + (size_t)k * 6144);
            a0 += wv * siluf_(cvec[k]); a1 += wv * siluf_(cvec[DM + k]); a2 += wv * siluf_(cctx[k]); }
        LAS f32x2* red2 = (LAS f32x2*)red;
        red2[(C.wave * 3 + 0) * 64 + C.lane] = a0; red2[(C.wave * 3 + 1) * 64 + C.lane] = a1; red2[(C.wave * 3 + 2) * 64 + C.lane] = a2;
        __syncthreads();
        if (C.wave < 3) { f32x2 sacc = {0.f, 0.f};
#pragma unroll
            for (int w8 = 0; w8 < 8; ++w8) sacc += red2[(w8 * 3 + C.wave) * 64 + C.lane];
            const f32x2 bm = *(const f32x2*)(b_mod + L * 6144 + col); *(f32x2*)(mod + (size_t)(L * 3 + C.wave) * 6144 + col) = sacc + bm; }
        __syncthreads();
    }
    const int gt = C.bid * NTHREADS + C.tid, GT = C.G * NTHREADS;
    float* tab = WSP(float, WS_TAB);
    for (int i = gt; i < SEQ * 32; i += GT) { const int t = i >> 5, f = i & 31; const float pos = (f < 16) ? (float)(t >> 6) : (float)(t & 63);
        const float inv = exp2f(-(float)(f & 15) * (13.287712379549449f / 16.f)); const float ang = pos * inv; float s, c; sincosf(ang, &s, &c);
        tab[TAB_AXC / 4 + i] = c; tab[TAB_AXS / 4 + i] = s; }
    for (int i = gt; i < TPB * 32; i += GT) { const int p = i >> 5, f = i & 31;
        const float inv = exp2f(-(float)f * (13.287712379549449f / 32.f)); const float ang = (float)p * inv; float s, c; sincosf(ang, &s, &c);
        tab[TAB_SQC / 4 + i] = c; tab[TAB_SQS / 4 + i] = s; }
    if (gt < DEPTH * 8) WSP(float, WS_L2G)[gt] = log2_sigmoid(a.in[C.z + 17][gt]);
    const float* ws_in = a.in[C.z + 10]; bf16_t* wsb = WSP(bf16_t, WS_WSB);
    for (int i = gt; i < DEPTH * 4 * 128 * 128; i += GT) wsb[i] = (bf16_t)f2bf(ws_in[i]);
}

struct CvtJob { const float* W; bf16_t* WT; int K, N, mode, row_off, item, ldw, koff; };
DI int cvt_row0(const CvtJob& j, int n0) {
    return (j.mode == 0) ? j.row_off + n0 : (j.mode == 3) ? ((n0 >= 256 && n0 < 2304) ? (n0 & ~255) + 128 * ((n0 & 63) >> 5) + 32 * ((n0 & 255) >> 6) : n0)
                                          : j.row_off + 256 * (n0 >> 7) + (n0 & 127) + (j.mode == 2 ? 128 : 0);
}
DI void cvt_load(const CvtJob& j, int lane, f32x4 (&v)[8]) {
    const int nblk = j.N / 32, kb = j.item / nblk, nb = j.item - kb * nblk, k0 = 64 * kb, n0 = 32 * nb;
    const float* src = j.W + (size_t)(k0 + 2 * (lane >> 3)) * j.N + n0 + 4 * (lane & 7);
#pragma unroll
    for (int i = 0; i < 4; ++i) { v[2 * i] = *(const f32x4*)(src + (size_t)(16 * i) * j.N); v[2 * i + 1] = *(const f32x4*)(src + (size_t)(16 * i + 1) * j.N); }
}
DI void cvt_store(const CvtJob& j, int lane, const f32x4 (&v)[8], LAS unsigned* scr) {
    const int nblk = j.N / 32, kb = j.item / nblk, nb = j.item - kb * nblk, k0 = 64 * kb, n0 = 32 * nb;
#pragma unroll
    for (int i = 0; i < 4; ++i) { const int kp = (lane >> 3) + 8 * i, nn = 4 * (lane & 7);
#pragma unroll
        for (int e = 0; e < 4; ++e) scr[kp * 33 + nn + e] = pk2(v[2 * i][e], v[2 * i + 1][e]); }
    asm volatile("s_waitcnt lgkmcnt(0)" ::: "memory");
    const int r0 = cvt_row0(j, n0), c = lane & 7;
#pragma unroll
    for (int q = 0; q < 4; ++q) { const int n = (lane >> 3) + 8 * q; const LAS unsigned* sp = scr + (4 * c) * 33 + n;
        u32x4 o; o.x = sp[0]; o.y = sp[33]; o.z = sp[66]; o.w = sp[99];
        *(u32x4*)(j.WT + (size_t)(r0 + n) * j.ldw + j.koff + k0 + 8 * c) = o; }
    asm volatile("s_waitcnt lgkmcnt(0)" ::: "memory");
}
DI void phase_cvt(const Params& a, const Ctx& C, int L, int f_lo, int f_hi, int skip) {
    LAS unsigned* scr = (LAS unsigned*)(C.lds + C.wave * 16384);
    if (C.bid < skip) return;
    const int gw = (C.bid - skip) * NWAVES + C.wave, NGW = (C.G - skip) * NWAVES;
    const size_t wb = WS_W + (size_t)(L & 1) * W_BUF;
    bf16_t* win_t = WSP(bf16_t, wb + W_IN); bf16_t* wbr_t = WSP(bf16_t, wb + W_BR); bf16_t* wout_t = WSP(bf16_t, wb + W_OUT);
    bf16_t* w13_t = WSP(bf16_t, wb + W_13); bf16_t* w2_t = WSP(bf16_t, wb + W_2);
    const int jl = L >> 1; const bool moe = L & 1;
    constexpr int I_IN = 16 * 208, I_BR = 4 * 32, I_OUT = 16 * 32, I_F13 = 16 * 88, I_F2 = 44 * 32, I_M13 = 16 * 56, I_M2 = 28 * 32;
    const int nitems = I_IN + 4 * I_BR + I_OUT + (moe ? NEXP * (2 * I_M13 + I_M2) : 2 * I_F13 + I_F2);
    auto decode = [&](int it) -> CvtJob {
        int r = it;
        if (r < I_IN) return CvtJob{a.in[C.z + 8] + (size_t)L * DM * INW, win_t, DM, INW, 3, 0, r, DM, 0}; r -= I_IN;
        if (r < 4 * I_BR) { const int i = r / I_BR; return CvtJob{a.in[C.z + 19] + (size_t)(L * 4 + i) * 256 * DM, wbr_t, 256, DM, 0, 0, r - i * I_BR, DM, i * 256}; } r -= 4 * I_BR;
        if (r < I_OUT) return CvtJob{a.in[C.z + 20] + (size_t)L * DM * DM, wout_t, DM, DM, 0, 0, r, DM, 0}; r -= I_OUT;
        if (!moe) {
            if (r < I_F13) return CvtJob{a.in[C.z + 21] + (size_t)jl * DM * DFF, w13_t, DM, DFF, 1, 0, r, DM, 0}; r -= I_F13;
            if (r < I_F13) return CvtJob{a.in[C.z + 22] + (size_t)jl * DM * DFF, w13_t, DM, DFF, 2, 0, r, DM, 0}; r -= I_F13;
            return CvtJob{a.in[C.z + 23] + (size_t)jl * DFF * DM, w2_t, DFF, DM, 0, 0, r, DFF, 0};
        }
        const int e = r / (2 * I_M13 + I_M2); r -= e * (2 * I_M13 + I_M2);
        const size_t eo = (size_t)(jl * NEXP + e) * DM * DFE;
        if (r < I_M13) return CvtJob{a.in[C.z + 26] + eo, w13_t, DM, DFE, 1, e * 2 * DFE, r, DM, 0}; r -= I_M13;
        if (r < I_M13) return CvtJob{a.in[C.z + 27] + eo, w13_t, DM, DFE, 2, e * 2 * DFE, r, DM, 0}; r -= I_M13;
        return CvtJob{a.in[C.z + 28] + eo, w2_t, DFE, DM, 0, e * DM, r, DFE, 0};
    };
    const int it_lo = (int)((long)nitems * f_lo / 64), it_hi = (int)((long)nitems * f_hi / 64);
    for (int it = it_lo + gw; it < it_hi; it += 2 * NGW) {
        const bool two = it + NGW < it_hi;
        const CvtJob ja = decode(it), jb = decode(two ? it + NGW : it);
        f32x4 va[8], vb[8];
        cvt_load(ja, C.lane, va); cvt_load(jb, C.lane, vb);
        cvt_store(ja, C.lane, va, scr);
        if (two) cvt_store(jb, C.lane, vb, scr + 2048);
    }
}

DI void unpack8(const u32x4 q, f32x4& a, f32x4& b) {
    a = (f32x4){__uint_as_float(q.x << 16), __uint_as_float(q.x & 0xffff0000u), __uint_as_float(q.y << 16), __uint_as_float(q.y & 0xffff0000u)};
    b = (f32x4){__uint_as_float(q.z << 16), __uint_as_float(q.z & 0xffff0000u), __uint_as_float(q.w << 16), __uint_as_float(q.w & 0xffff0000u)};
}
DI u32x4 pack8(const f32x4 a, const f32x4 b) { return (u32x4){pk2(a[0], a[1]), pk2(a[2], a[3]), pk2(b[0], b[1]), pk2(b[2], b[3])}; }
DI void y2_add8(const bf16_t* Y, const bf16_t* YP, int row, int c, f32x4& a, f32x4& b) {
    if (row < MOE2_FULL_RT * 256) { f32x4 x, y; unpack8(*(const u32x4*)(Y + (size_t)row * DM + c), x, y); a += x; b += y; return; }
    u32x4 q[MOE2_NP];
#pragma unroll
    for (int p = 0; p < MOE2_NP; ++p) q[p] = *(const u32x4*)(YP + ((size_t)p * MOE2_PROWS + row - MOE2_FULL_RT * 256) * DM + c);
#pragma unroll
    for (int p = 0; p < MOE2_NP; ++p) { f32x4 x, y; unpack8(q[p], x, y); a += x; b += y; }
}
DI void y2_pair8(const bf16_t* Y, const bf16_t* YP, int r0, int r1, int c, f32x4& a, f32x4& b) {
    if (r0 < MOE2_FULL_RT * 256 && r1 < MOE2_FULL_RT * 256) { const u32x4 q0 = *(const u32x4*)(Y + (size_t)r0 * DM + c), q1 = *(const u32x4*)(Y + (size_t)r1 * DM + c);
        f32x4 x0, y0, x1, y1; unpack8(q0, x0, y0); unpack8(q1, x1, y1); a = x0 + x1; b = y0 + y1; return; }
    a = (f32x4){0.f, 0.f, 0.f, 0.f}; b = a; y2_add8(Y, YP, r0, c, a, b); y2_add8(Y, YP, r1, c, a, b);
}
template <bool ROUTE, bool COMB>
DI void norm_rows(const Params& a, const Ctx& C, int L, int which, const bool skipCtx, const int ctxNP, const float* ctxGate) {
    bf16_t* XS = WSP(bf16_t, WS_XS);
    const float* inLat = a.in[C.z + 0]; const float* inCtx = a.in[C.z + 2];
    const float* gn = a.in[C.z + (which ? 7 : 6)] + (size_t)L * DM;
    const float* mod = WSP(float, WS_MOD) + (size_t)L * 3 * 6144;
    bf16_t* H = WSP(bf16_t, WS_H);
    const float* rw = a.in[C.z + 24] + (size_t)(L >> 1) * DM * NEXP; const float* rb = a.in[C.z + 25] + (size_t)(L >> 1) * NEXP;
    int* rt_i = WSP(int, WS_ROUTE); float* rt_f = WSP(float, WS_ROUTE);
    const int lane = C.lane, gw = C.bid * NWAVES + C.wave, NGW = C.G * NWAVES;
#define NCOL(jj) (8 * lane + 512 * ((jj) >> 1) + 4 * ((jj) & 1))
    f32x4 gq[4];
#pragma unroll
    for (int jj = 0; jj < 4; ++jj) gq[jj] = *(const f32x4*)(gn + NCOL(jj));
    f32x4 rwt[ROUTE ? 16 : 1][2];
    if (ROUTE) {
#pragma unroll
        for (int jj = 0; jj < 4; ++jj)
#pragma unroll
            for (int q = 0; q < 4; ++q) { const float* wp = rw + (size_t)(NCOL(jj) + q) * 8; rwt[ROUTE ? jj * 4 + q : 0][0] = *(const f32x4*)wp; rwt[ROUTE ? jj * 4 + q : 0][1] = *(const f32x4*)(wp + 4); }
    }
    const bool b5 = lane & 32, b4 = lane & 16, b3 = lane & 8;
    const bf16_t* Y = WSP(bf16_t, WS_HG); const float* modp = WSP(float, WS_MOD) + (size_t)(L - 1) * 3 * 6144 + 5 * DM;
    LAS int* lw = (LAS int*)C.lds;
    int wcnt[NEXP];
#pragma unroll
    for (int e = 0; e < NEXP; ++e) wcnt[e] = 0;
    f32x4 shc[ROUTE ? 1 : 4], scc[ROUTE ? 1 : 4]; int mrc = -1;
    const bool f32src = L == 0 && which == 0;
    u32x4 nq[2][2];
    int nrow[2][2];
    constexpr bool PREF = !ROUTE;
    if (PREF && !f32src) {
#pragma unroll
        for (int k = 0; k < 2; ++k) { const int r = (gw + k * NGW < T) ? gw + k * NGW : gw;
#pragma unroll
            for (int j = 0; j < 2; ++j) nq[k][j] = *(const u32x4*)(XS + (size_t)r * DM + 8 * lane + 512 * j);
            if (COMB) { nrow[k][0] = rt_i[RT_POS + 2 * r]; nrow[k][1] = rt_i[RT_POS + 2 * r + 1]; } } }
    for (int r0 = gw; r0 < T; r0 += 2 * NGW) {
        const int r1 = r0 + NGW; const bool two = r1 < T; const int rr[2] = {r0, two ? r1 : r0};
        f32x4 v[2][4]; float ss[2]; int yrow[2][2];
#pragma unroll
        for (int k = 0; k < 2; ++k) { const int r = rr[k];
            if (f32src) { const float* xr = xrow_c(inLat, inCtx, r);
#pragma unroll
                for (int jj = 0; jj < 4; ++jj) v[k][jj] = *(const f32x4*)(xr + NCOL(jj));
#pragma unroll
                for (int j = 0; j < 2; ++j) *(u32x4*)(XS + (size_t)r * DM + 8 * lane + 512 * j) = pack8(v[k][2 * j], v[k][2 * j + 1]); }
            else {
#pragma unroll
                for (int j = 0; j < 2; ++j) unpack8(PREF ? nq[k][j] : *(const u32x4*)(XS + (size_t)r * DM + 8 * lane + 512 * j), v[k][2 * j], v[k][2 * j + 1]);
                if (COMB) { yrow[k][0] = nrow[k][0]; yrow[k][1] = nrow[k][1]; } } }
        if (PREF && !f32src && r0 + 2 * NGW < T) {
#pragma unroll
            for (int k = 0; k < 2; ++k) { const int rn = r0 + 2 * NGW, r = (rn + k * NGW < T) ? rn + k * NGW : rn;
#pragma unroll
                for (int j = 0; j < 2; ++j) nq[k][j] = *(const u32x4*)(XS + (size_t)r * DM + 8 * lane + 512 * j);
                if (COMB) { nrow[k][0] = rt_i[RT_POS + 2 * r]; nrow[k][1] = rt_i[RT_POS + 2 * r + 1]; } } }
        if (ctxNP) {
            const bf16_t* part = WSP(bf16_t, WS_BR);
#pragma unroll
            for (int k = 0; k < 2; ++k) { const int t = rr[k]; const int bb = t / TPB, pp = t - bb * TPB;
                if (pp < CTXL && (k == 0 || two)) {
                    f32x4 sum[4];
#pragma unroll
                    for (int jj = 0; jj < 4; ++jj) sum[jj] = (f32x4){0.f, 0.f, 0.f, 0.f};
                    constexpr int PIF = ROUTE ? 2 : 6;
                    for (int pc0 = 0; pc0 < ctxNP; pc0 += PIF) {
                        u32x4 tq[PIF][2];
#pragma unroll
                        for (int q = 0; q < PIF; ++q) { const int pc = pc0 + q < ctxNP ? pc0 + q : pc0; const bf16_t* pr = part + ((size_t)(pc * 2 + bb) * 256 + pp) * DM + 8 * lane;
#pragma unroll
                            for (int j = 0; j < 2; ++j) tq[q][j] = *(const u32x4*)(pr + 512 * j); }
#pragma unroll
                        for (int q = 0; q < PIF; ++q) if (pc0 + q < ctxNP) {
#pragma unroll
                            for (int j = 0; j < 2; ++j) { f32x4 x, y; unpack8(tq[q][j], x, y); sum[2 * j] += x; sum[2 * j + 1] += y; } } }
#pragma unroll
                    for (int jj = 0; jj < 4; ++jj) v[k][jj] += *(const f32x4*)(ctxGate + NCOL(jj)) * sum[jj];
#pragma unroll
                    for (int j = 0; j < 2; ++j) *(u32x4*)(XS + (size_t)t * DM + 8 * lane + 512 * j) = pack8(v[k][2 * j], v[k][2 * j + 1]); } }
        }
        if (COMB) {
#pragma unroll
            for (int k = 0; k < 2; ++k) { const int t = rr[k];
                const float* gt = modp + (size_t)modrow(t) * 6144;
#pragma unroll
                for (int j = 0; j < 2; ++j) { f32x4 ya, yb; const int c = 8 * lane + 512 * j;
                    y2_pair8(Y, WSP(bf16_t, WS_Y2P), yrow[k][0], yrow[k][1], c, ya, yb);
                    v[k][2 * j] += *(const f32x4*)(gt + c) * ya; v[k][2 * j + 1] += *(const f32x4*)(gt + c + 4) * yb;
                    if (k == 0 || two) *(u32x4*)(XS + (size_t)t * DM + c) = pack8(v[k][2 * j], v[k][2 * j + 1]); } }
        }
#pragma unroll
        for (int k = 0; k < 2; ++k) { float s = 0.f;
#pragma unroll
            for (int jj = 0; jj < 4; ++jj) s += (v[k][jj].x * v[k][jj].x + v[k][jj].y * v[k][jj].y) + (v[k][jj].z * v[k][jj].z + v[k][jj].w * v[k][jj].w);
            ss[k] = s; }
#pragma unroll
        for (int o = 1; o < 64; o <<= 1) { ss[0] += shx(ss[0], o, lane); ss[1] += shx(ss[1], o, lane); }
#pragma unroll
        for (int k = 0; k < 2; ++k) {
            if (k == 1 && !two) break;
            const int r = rr[k]; const int mr = modrow(r);
            if (skipCtx && mr == 2) continue;
            const float* shp = mod + (size_t)mr * 6144 + (which ? 3 : 0) * DM;
            if (!ROUTE && mr != mrc) { mrc = mr;
#pragma unroll
                for (int jj = 0; jj < 4; ++jj) { shc[ROUTE ? 0 : jj] = *(const f32x4*)(shp + NCOL(jj)); scc[ROUTE ? 0 : jj] = *(const f32x4*)(shp + DM + NCOL(jj)); } }
            const float rs = __builtin_amdgcn_rsqf(ss[k] * (1.f / DM) + EPS);
            float lg[8];
#pragma unroll
            for (int e = 0; e < 8; ++e) lg[e] = 0.f;
#pragma unroll
            for (int j = 0; j < 2; ++j) { f32x4 hp[2];
#pragma unroll
                for (int q2 = 0; q2 < 2; ++q2) { const int jj = 2 * j + q2; const int cc = 8 * lane + 512 * j + 4 * q2;
                    const f32x4 s4 = ROUTE ? *(const f32x4*)(shp + DM + cc) : scc[ROUTE ? 0 : jj], h4 = ROUTE ? *(const f32x4*)(shp + cc) : shc[ROUTE ? 0 : jj];
                    const f32x4 h = v[k][jj] * rs * gq[jj] * (s4 + 1.f) + h4; hp[q2] = h;
                    if (ROUTE) {
#pragma unroll
                        for (int q = 0; q < 4; ++q) { const f32x4 w0 = rwt[ROUTE ? jj * 4 + q : 0][0], w1 = rwt[ROUTE ? jj * 4 + q : 0][1]; const float hv = h[q];
                            lg[0] += hv * w0.x; lg[1] += hv * w0.y; lg[2] += hv * w0.z; lg[3] += hv * w0.w; lg[4] += hv * w1.x; lg[5] += hv * w1.y; lg[6] += hv * w1.z; lg[7] += hv * w1.w; } } }
                *(u32x4*)(H + (size_t)r * DM + 8 * lane + 512 * j) = pack8(hp[0], hp[1]); }
            if (ROUTE) {
                float v4[4], v2[2], v1;
#pragma unroll
                for (int e = 0; e < 4; ++e) { const float keep = b5 ? lg[4 + e] : lg[e], send = b5 ? lg[e] : lg[4 + e]; v4[e] = keep + shx(send, 32, lane); }
#pragma unroll
                for (int e = 0; e < 2; ++e) { const float keep = b4 ? v4[2 + e] : v4[e], send = b4 ? v4[e] : v4[2 + e]; v2[e] = keep + shx(send, 16, lane); }
                { const float keep = b3 ? v2[1] : v2[0], send = b3 ? v2[0] : v2[1]; v1 = keep + shx(send, 8, lane); }
                v1 += shx(v1, 4, lane); v1 += shx(v1, 2, lane); v1 += shx(v1, 1, lane);
                float lf[8];
#pragma unroll
                for (int e = 0; e < 8; ++e) lf[e] = __int_as_float(__builtin_amdgcn_readlane(__float_as_int(v1), 8 * e)) + rb[e];
                int e1 = 0; float t1 = lf[0];
#pragma unroll
                for (int e = 1; e < 8; ++e) if (lf[e] > t1) { t1 = lf[e]; e1 = e; }
                int e2 = -1; float t2 = -3.0e38f;
#pragma unroll
                for (int e = 0; e < 8; ++e) if (e != e1 && lf[e] > t2) { t2 = lf[e]; e2 = e; }
                if (lane == 0) { const float p1 = rcpf_(1.f + ex2((t2 - t1) * LOG2E));
                    int q1 = 0, q2 = 0;
#pragma unroll
                    for (int e = 0; e < NEXP; ++e) { if (e == e1) q1 = wcnt[e]; if (e == e2) q2 = wcnt[e]; }
                    rt_i[RT_E + 2 * r] = e1; rt_i[RT_E + 2 * r + 1] = e2; rt_i[RT_POS + 2 * r] = q1; rt_i[RT_POS + 2 * r + 1] = q2;
                    rt_f[RT_PW + 2 * r] = p1; rt_f[RT_PW + 2 * r + 1] = 1.f - p1; }
#pragma unroll
                for (int e = 0; e < NEXP; ++e) wcnt[e] += (e == e1 || e == e2) ? 1 : 0;
            }
        }
    }
#undef NCOL
    if (ROUTE) {
        if (lane == 0) {
#pragma unroll
            for (int e = 0; e < NEXP; ++e) lw[C.wave * 8 + e] = wcnt[e]; }
        __syncthreads();
        int wb[NEXP];
#pragma unroll
        for (int e = 0; e < NEXP; ++e) { int acc = 0;
#pragma unroll
            for (int w = 0; w < NWAVES; ++w) acc += (w < C.wave) ? lw[w * 8 + e] : 0;
            wb[e] = acc; }
        if (C.tid < NEXP) { int tot = 0;
#pragma unroll
            for (int w = 0; w < NWAVES; ++w) tot += lw[w * 8 + C.tid];
            rt_i[RT_BLK + ((L >> 1) * 1024 + C.bid) * 8 + C.tid] = tot; }
        if (lane == 0) for (int r = gw; r < T; r += NGW) { if (skipCtx && modrow(r) == 2) continue;
            const int ea = rt_i[RT_E + 2 * r], eb = rt_i[RT_E + 2 * r + 1]; int oa = 0, ob = 0;
#pragma unroll
            for (int e = 0; e < NEXP; ++e) { if (e == ea) oa = wb[e]; if (e == eb) ob = wb[e]; }
            rt_i[RT_POS + 2 * r] += oa; rt_i[RT_POS + 2 * r + 1] += ob; }
    }
}
DI void phase_norm(const Params& a, const Ctx& C, int L, int which) {
    const bool skipCtx = which && (L == DEPTH - 1);
    const int ctxNP = which ? (L == DEPTH - 1 ? 0 : 4) : ((L & 1) ? 11 : 0);
    const float* ctxGate = WSP(float, WS_MOD) + (size_t)((which ? L : L - 1) * 3 + 2) * 6144 + (which ? 2 : 5) * DM;
    if (which && (L & 1)) norm_rows<true, false>(a, C, L, which, skipCtx, ctxNP, ctxGate);
    else if (!which && L > 0 && !(L & 1)) norm_rows<false, true>(a, C, L, which, false, 0, ctxGate);
    else norm_rows<false, false>(a, C, L, which, skipCtx, ctxNP, ctxGate);
}

DI void phase_prep(const Params& a, const Ctx& C, int L) {
    bf16_t* P = WSP(bf16_t, WS_P); bf16_t* VT = WSP(bf16_t, WS_VT);
    const float* tab = WSP(float, WS_TAB);
    const float* gvv = a.in[C.z + 9] + (size_t)L * 256; const float* wqn = a.in[C.z + 12] + L * 64; const float* wkn = a.in[C.z + 13] + L * 64; const float* gqn = a.in[C.z + 15] + L * 64; const float* gkn = a.in[C.z + 16] + L * 64;
    const int lane = C.lane, hs = lane >> 3, j = lane & 7, i0 = (8 * j) & 31; const bool hiH = j >= 4;
    for (int u = C.bid; u < T / 64; u += C.G) {
        const int row0 = u * 64;
        for (int rr = 0; rr < 8; ++rr) {
            const int r = row0 + C.wave * 8 + rr; const int b = r / TPB, p = r - b * TPB; const bool lat = p >= CTXL; const int t = p - CTXL;
            bf16_t* pr = P + (size_t)r * PW + C_V;
            u32x4 raws[4];
#pragma unroll
            for (int op = 0; op < 4; ++op) raws[op] = *(const u32x4*)(pr + 64 * (8 * op + hs) + 8 * j);
            const int ta = lat ? t : 0;
            const float* ca = tab + TAB_AXC / 4 + (size_t)ta * 32 + i0; const float* sa = tab + TAB_AXS / 4 + (size_t)ta * 32 + i0;
            const float* cs = tab + TAB_SQC / 4 + (size_t)p * 32 + i0; const float* sq = tab + TAB_SQS / 4 + (size_t)p * 32 + i0;
            const f32x4 tca0 = *(const f32x4*)ca, tca1 = *(const f32x4*)(ca + 4), tsa0 = *(const f32x4*)sa, tsa1 = *(const f32x4*)(sa + 4);
            const f32x4 tcs0 = *(const f32x4*)cs, tcs1 = *(const f32x4*)(cs + 4), tss0 = *(const f32x4*)sq, tss1 = *(const f32x4*)(sq + 4);
#pragma unroll
            for (int op = 0; op < 4; ++op) {
                const int H = 8 * op + hs;
                int kind; const float* g = gvv + 64 * (H & 3); float scale = 1.f;
                if (H < 4) kind = 1;
                else if (H < 8) { kind = 2; g = wqn; scale = QSCALE; }
                else if (H < 10) { kind = 2; g = wkn; }
                else if (H < 12) kind = 0;
                else if (H < 16) { kind = 2; g = gqn; scale = QSCALE; }
                else if (H < 18) { kind = 2; g = gkn; }
                else if (H < 20) kind = 0;
                else if (H < 24) kind = 3;
                else if (H < 28) { kind = 3; scale = 0.125f; }
                else kind = 0;
                const u32x4 raw = raws[op];
                float x[8]; x[0] = __uint_as_float(raw.x << 16); x[1] = __uint_as_float(raw.x & 0xffff0000u); x[2] = __uint_as_float(raw.y << 16); x[3] = __uint_as_float(raw.y & 0xffff0000u);
                x[4] = __uint_as_float(raw.z << 16); x[5] = __uint_as_float(raw.z & 0xffff0000u); x[6] = __uint_as_float(raw.w << 16); x[7] = __uint_as_float(raw.w & 0xffff0000u);
                if (kind == 1 || kind == 2) {
                    float ss = 0.f;
#pragma unroll
                    for (int e = 0; e < 8; ++e) ss += x[e] * x[e];
                    ss += shx(ss, 1, lane); ss += shx(ss, 2, lane); ss += shx(ss, 4, lane);
                    const float rs = __builtin_amdgcn_rsqf(ss * (1.f / 64.f) + EPS);
                    const f32x4 g0 = *(const f32x4*)(g + 8 * j), g1 = *(const f32x4*)(g + 8 * j + 4);
                    x[0] *= rs * g0[0]; x[1] *= rs * g0[1]; x[2] *= rs * g0[2]; x[3] *= rs * g0[3]; x[4] *= rs * g1[0]; x[5] *= rs * g1[1]; x[6] *= rs * g1[2]; x[7] *= rs * g1[3];
                }
                float o[8];
#pragma unroll
                for (int e = 0; e < 8; ++e) o[e] = shx(x[e], 4, lane);
                if ((kind == 2 && lat) || kind == 3) {
                    const bool ax = kind == 2;
                    const f32x4 c0 = ax ? tca0 : tcs0, c1 = ax ? tca1 : tcs1, s0 = ax ? tsa0 : tss0, s1 = ax ? tsa1 : tss1;
                    const float cc[8] = {c0[0], c0[1], c0[2], c0[3], c1[0], c1[1], c1[2], c1[3]}, sn[8] = {s0[0], s0[1], s0[2], s0[3], s1[0], s1[1], s1[2], s1[3]};
#pragma unroll
                    for (int e = 0; e < 8; ++e) x[e] = hiH ? (o[e] * sn[e] + x[e] * cc[e]) : (x[e] * cc[e] - o[e] * sn[e]);
                }
                if (kind != 0) { u32x4 w; w.x = pk2(x[0] * scale, x[1] * scale); w.y = pk2(x[2] * scale, x[3] * scale); w.z = pk2(x[4] * scale, x[5] * scale); w.w = pk2(x[6] * scale, x[7] * scale);
                    *(u32x4*)(pr + 64 * H + 8 * j) = w; }
            }
        }
        { const int hh = C.tid >> 7, d = (C.tid >> 1) & 63, tg = C.tid & 1; const int kind = hh >> 1, kvh = hh & 1;
          const int b = row0 / TPB, p0 = row0 - b * TPB + 32 * tg; const int col = (kind ? C_GV : C_WV) + 64 * kvh + d;
          const bf16_t* src = P + (size_t)(row0 + 32 * tg) * PW + col;
          bf16_t* dst = VT + ((size_t)((kind * 2 + b) * 2 + kvh) * 64 + d) * TPB + p0;
#pragma unroll
          for (int q = 0; q < 4; ++q) { unsigned w[4];
#pragma unroll
              for (int e = 0; e < 4; ++e) { const unsigned lo = src[(size_t)(8 * q + 2 * e) * PW], hi = src[(size_t)(8 * q + 2 * e + 1) * PW]; w[e] = lo | (hi << 16); }
              *(u32x4*)(dst + 8 * q) = (u32x4){w[0], w[1], w[2], w[3]}; } }
    }
}

DI void mixA_unit(const Params& a, const Ctx& C, int L, int cg, int g) {
    const bf16_t* P = WSP(bf16_t, WS_P); bf16_t* BR = WSP(bf16_t, WS_BR);
    const bf16_t* W = WSP(bf16_t, WS_WSB) + (size_t)(L * 4 + g) * 128 * 128; const float* bs = a.in[C.z + 11] + (size_t)(L * 4 + g) * 128;
    LAS bf16_t* vnT = (LAS bf16_t*)C.lds;
    const int row0 = cg * 128, lane = C.lane, l15 = lane & 15, quad = lane >> 4;
#pragma unroll
    for (int it = 0; it < 2; ++it) { const int idx = C.tid + 512 * it, j = idx >> 3, ch = idx & 7;
        const u32x4 v = *(const u32x4*)(P + (size_t)(row0 + j) * PW + C_V + 64 * g + 8 * ch);
        const unsigned w[4] = {v.x, v.y, v.z, v.w};
#pragma unroll
        for (int e = 0; e < 4; ++e) { vnT[(8 * ch + 2 * e) * 136 + j] = (bf16_t)(w[e] & 0xffffu); vnT[(8 * ch + 2 * e + 1) * 136 + j] = (bf16_t)(w[e] >> 16); } }
    __syncthreads();
    const int i0 = 16 * C.wave, iw = i0 + l15;
    u32x2 uq[4];
#pragma unroll
    for (int dt = 0; dt < 4; ++dt) uq[dt] = *(const u32x2*)(P + (size_t)(row0 + iw) * PW + C_U + 64 * g + 16 * dt + 4 * quad);
    const float bsv = bs[iw];
    f32x4 acc[4];
#pragma unroll
    for (int dt = 0; dt < 4; ++dt) acc[dt] = (f32x4){0.f, 0.f, 0.f, 0.f};
#pragma unroll
    for (int ks = 0; ks < 4; ++ks) { const bf16x8 bw = *(const bf16x8*)(W + (size_t)iw * 128 + 32 * ks + 8 * quad);
#pragma unroll
        for (int dt = 0; dt < 4; ++dt) { const bf16x8 av = *(const LAS bf16x8*)(vnT + (16 * dt + l15) * 136 + 32 * ks + 8 * quad); acc[dt] = MFMA16(av, bw, acc[dt]); } }
#pragma unroll
    for (int dt = 0; dt < 4; ++dt) { const u32x2 uu = uq[dt];
        const float o0 = __uint_as_float(uu.x << 16) * (acc[dt][0] + bsv), o1 = __uint_as_float(uu.x & 0xffff0000u) * (acc[dt][1] + bsv);
        const float o2 = __uint_as_float(uu.y << 16) * (acc[dt][2] + bsv), o3 = __uint_as_float(uu.y & 0xffff0000u) * (acc[dt][3] + bsv);
        u32x2 w; w.x = pk2(o0, o1); w.y = pk2(o2, o3); *(u32x2*)(BR + (size_t)(row0 + iw) * DM + 64 * g + 16 * dt + 4 * quad) = w; }
    __syncthreads();
}

DI void attn_unit(const Params& a, const Ctx& C, int L, int kind, int b, int kvh, int qrow0, int ntile0, int krow0, int ntile1, int krow1, bool masked, bool has_sink) {
    const bf16_t* P = WSP(bf16_t, WS_P); bf16_t* BR = WSP(bf16_t, WS_BR);
    const int Qcol = kind ? C_GQ : C_WQ, Kcol = (kind ? C_GK : C_WK) + 64 * kvh, Vcol = (kind ? C_GV : C_WV) + 64 * kvh, Ocol = kind ? 512 : 256;
    LAS bf16_t* Kb = (LAS bf16_t*)C.lds;
    LAS bf16_t* Vb = (LAS bf16_t*)(C.lds + 2 * 64 * 144);
    const int lane = C.lane, r32 = lane & 31, hi = lane >> 5, w = C.wave, hq = 2 * kvh + (w >> 2);
    const int q = qrow0 + 32 * (w & 3) + r32;
    bf16x8 qr[4];
#pragma unroll
    for (int d0 = 0; d0 < 4; ++d0) qr[d0] = *(const bf16x8*)(P + (size_t)q * PW + Qcol + 64 * hq + 16 * d0 + 8 * hi);
    float m = has_sink ? a.in[C.z + 14][L * 4 + hq] * LOG2E : -1e30f, l = (has_sink && hi == 0) ? 1.f : 0.f;
    f32x16 o0, o1;
#pragma unroll
    for (int i = 0; i < 16; ++i) { o0[i] = 0.f; o1[i] = 0.f; }
    const int nt = ntile0 + ntile1; const int lr = C.tid >> 3, lc = C.tid & 7;
    const int qpos = q - (b * TPB + CTXL);
#define VT_STORE2(buf, vr) do { const unsigned vw_[4] = {vr.x, vr.y, vr.z, vr.w}; _Pragma("unroll") for (int e_ = 0; e_ < 4; ++e_) { (buf)[(8 * lc + 2 * e_) * 72 + lr] = (bf16_t)(vw_[e_] & 0xffffu); (buf)[(8 * lc + 2 * e_ + 1) * 72 + lr] = (bf16_t)(vw_[e_] >> 16); } } while (0)
#define TILE_ROW(tn) ((tn) < ntile0 ? krow0 + 64 * (tn) : krow1 + 64 * ((tn) - ntile0))
#define TILE_LOAD(kr_, kq, vq) do { kq = *(const u32x4*)(P + (size_t)((kr_) + lr) * PW + Kcol + 8 * lc); vq = *(const u32x4*)(P + (size_t)((kr_) + lr) * PW + Vcol + 8 * lc); } while (0)
    u32x4 kA, vA, kB, vB;
    TILE_LOAD(TILE_ROW(0), kA, vA); TILE_LOAD(TILE_ROW(1), kB, vB);
    *(LAS u32x4*)(Kb + lr * 72 + 8 * lc) = kA; VT_STORE2(Vb, vA);
    __syncthreads();
    auto tile = [&](const int t, const LAS bf16_t* Kc, const LAS bf16_t* Vc) {
        f32x16 p0, p1;
#pragma unroll
        for (int i = 0; i < 16; ++i) { p0[i] = 0.f; p1[i] = 0.f; }
#pragma unroll
        for (int d0 = 0; d0 < 4; ++d0) { const bf16x8 k0 = *(const LAS bf16x8*)(Kc + r32 * 72 + 16 * d0 + 8 * hi), k1 = *(const LAS bf16x8*)(Kc + (32 + r32) * 72 + 16 * d0 + 8 * hi);
            p0 = MFMA32(k0, qr[d0], p0); p1 = MFMA32(k1, qr[d0], p1); }
        if (masked && t >= ntile0) { const int kp0 = krow1 + 64 * (t - ntile0) - (b * TPB + CTXL);
#pragma unroll
            for (int i = 0; i < 16; ++i) { const int kp = kp0 + crow(i, hi); int d = qpos - kp; d = d < 0 ? -d : d; if (d > 128) p0[i] = -1e30f; int d2 = qpos - (kp + 32); d2 = d2 < 0 ? -d2 : d2; if (d2 > 128) p1[i] = -1e30f; } }
        float mx = p0[0];
#pragma unroll
        for (int i = 1; i < 16; ++i) mx = fmaxf(mx, p0[i]);
#pragma unroll
        for (int i = 0; i < 16; ++i) mx = fmaxf(mx, p1[i]);
        mx = fmaxf(mx, shx(mx, 32, lane));
        const float mn = fmaxf(m, mx), alpha = ex2(m - mn); m = mn; l *= alpha;
        float ps = 0.f;
#pragma unroll
        for (int i = 0; i < 16; ++i) { o0[i] *= alpha; o1[i] *= alpha; p0[i] = ex2(p0[i] - mn); p1[i] = ex2(p1[i] - mn); ps += p0[i] + p1[i]; }
        l += ps;
        bf16x8 pw[4];
        { u32x4 t0 = {pk2(p0[0], p0[1]), pk2(p0[2], p0[3]), pk2(p0[4], p0[5]), pk2(p0[6], p0[7])}; pw[0] = __builtin_bit_cast(bf16x8, t0);
          u32x4 t1 = {pk2(p0[8], p0[9]), pk2(p0[10], p0[11]), pk2(p0[12], p0[13]), pk2(p0[14], p0[15])}; pw[1] = __builtin_bit_cast(bf16x8, t1);
          u32x4 t2 = {pk2(p1[0], p1[1]), pk2(p1[2], p1[3]), pk2(p1[4], p1[5]), pk2(p1[6], p1[7])}; pw[2] = __builtin_bit_cast(bf16x8, t2);
          u32x4 t3 = {pk2(p1[8], p1[9]), pk2(p1[10], p1[11]), pk2(p1[12], p1[13]), pk2(p1[14], p1[15])}; pw[3] = __builtin_bit_cast(bf16x8, t3); }
#pragma unroll
        for (int s = 0; s < 4; ++s) {
            const u32x2 a0 = *(const LAS u32x2*)(Vc + r32 * 72 + 16 * s + 4 * hi), a1 = *(const LAS u32x2*)(Vc + r32 * 72 + 16 * s + 8 + 4 * hi);
            const u32x2 c0 = *(const LAS u32x2*)(Vc + (32 + r32) * 72 + 16 * s + 4 * hi), c1 = *(const LAS u32x2*)(Vc + (32 + r32) * 72 + 16 * s + 8 + 4 * hi);
            const u32x4 va = {a0.x, a0.y, a1.x, a1.y}, vc = {c0.x, c0.y, c1.x, c1.y};
            o0 = MFMA32(__builtin_bit_cast(bf16x8, va), pw[s], o0); o1 = MFMA32(__builtin_bit_cast(bf16x8, vc), pw[s], o1); }
    };
    for (int t = 0; t < nt; t += 2) {
        if (t + 2 < nt) TILE_LOAD(TILE_ROW(t + 2), kA, vA);
        tile(t, Kb, Vb);
        *(LAS u32x4*)(Kb + 64 * 72 + lr * 72 + 8 * lc) = kB; VT_STORE2(Vb + 64 * 72, vB);
        __syncthreads();
        if (t + 3 < nt) TILE_LOAD(TILE_ROW(t + 3), kB, vB);
        tile(t + 1, Kb + 64 * 72, Vb + 64 * 72);
        if (t + 2 < nt) { *(LAS u32x4*)(Kb + lr * 72 + 8 * lc) = kA; VT_STORE2(Vb, vA); }
        __syncthreads();
    }
#undef VT_STORE2
#undef TILE_ROW
#undef TILE_LOAD
    l += shx(l, 32, lane);
    const float inv = rcpf_(l);
    bf16_t* orow = BR + (size_t)q * DM + Ocol + 64 * hq;
#pragma unroll
    for (int g = 0; g < 4; ++g) { const int d = 8 * g + 4 * hi;
        u32x2 w0 = {pk2(o0[4 * g] * inv, o0[4 * g + 1] * inv), pk2(o0[4 * g + 2] * inv, o0[4 * g + 3] * inv)}; *(u32x2*)(orow + d) = w0;
        u32x2 w1 = {pk2(o1[4 * g] * inv, o1[4 * g + 1] * inv), pk2(o1[4 * g + 2] * inv, o1[4 * g + 3] * inv)}; *(u32x2*)(orow + 32 + d) = w1; }
}

DI void ret_kv_unit(const Params& a, const Ctx& C, int L, int cg, int h) {
    const bf16_t* P = WSP(bf16_t, WS_P); float* KVT = WSP(float, WS_KVT);
    const float l2f = WSP(float, WS_L2G)[(L * 2 + 0) * 4 + h], l2b = WSP(float, WS_L2G)[(L * 2 + 1) * 4 + h];
    LAS bf16_t* VTs = (LAS bf16_t*)C.lds; LAS bf16_t* KTf = VTs + 64 * 136; LAS bf16_t* KTb = KTf + 64 * 136;
    const int row0 = cg * 128, lane = C.lane, l15 = lane & 15, quad = lane >> 4;
#pragma unroll
    for (int it = 0; it < 2; ++it) { const int idx = C.tid + 512 * it, j = idx >> 3, ch = idx & 7;
        const u32x4 kv = *(const u32x4*)(P + (size_t)(row0 + j) * PW + C_RK + 64 * h + 8 * ch), vv = *(const u32x4*)(P + (size_t)(row0 + j) * PW + C_RV + 64 * h + 8 * ch);
        const float wf = ex2((float)(127 - j) * l2f), wb = ex2((float)j * l2b);
        const unsigned kw[4] = {kv.x, kv.y, kv.z, kv.w}, vw[4] = {vv.x, vv.y, vv.z, vv.w};
#pragma unroll
        for (int e = 0; e < 4; ++e) { const float k0 = __uint_as_float(kw[e] << 16), k1 = __uint_as_float(kw[e] & 0xffff0000u);
            KTf[(8 * ch + 2 * e) * 136 + j] = (bf16_t)f2bf(k0 * wf); KTf[(8 * ch + 2 * e + 1) * 136 + j] = (bf16_t)f2bf(k1 * wf);
            KTb[(8 * ch + 2 * e) * 136 + j] = (bf16_t)f2bf(k0 * wb); KTb[(8 * ch + 2 * e + 1) * 136 + j] = (bf16_t)f2bf(k1 * wb);
            VTs[(8 * ch + 2 * e) * 136 + j] = (bf16_t)(vw[e] & 0xffffu); VTs[(8 * ch + 2 * e + 1) * 136 + j] = (bf16_t)(vw[e] >> 16); } }
    __syncthreads();
    const int dir = C.wave >> 2, vt = C.wave & 3; const LAS bf16_t* KT = dir ? KTb : KTf;
    f32x4 acc[4];
#pragma unroll
    for (int dt = 0; dt < 4; ++dt) acc[dt] = (f32x4){0.f, 0.f, 0.f, 0.f};
#pragma unroll
    for (int ks = 0; ks < 4; ++ks) { const bf16x8 bv = *(const LAS bf16x8*)(VTs + (16 * vt + l15) * 136 + 32 * ks + 8 * quad);
#pragma unroll
        for (int dt = 0; dt < 4; ++dt) { const bf16x8 ak = *(const LAS bf16x8*)(KT + (16 * dt + l15) * 136 + 32 * ks + 8 * quad); acc[dt] = MFMA16(ak, bv, acc[dt]); } }
    const int b = cg / NCHUNK, c = cg - b * NCHUNK;
    float* dst = KVT + ((size_t)((dir * 2 + b) * 4 + h) * NCHUNK + c) * 4096 + (16 * vt + l15) * 64 + 4 * quad;
#pragma unroll
    for (int dt = 0; dt < 4; ++dt) *(f32x4*)(dst + 16 * dt) = acc[dt];
    __syncthreads();
}
DI void phase_ret_scan(const Params& a, const Ctx& C, int L) {
    const float* KVT = WSP(float, WS_KVT); bf16_t* SIN = WSP(bf16_t, WS_SIN);
    const int gt = C.bid * NTHREADS + C.tid;
    if (gt < 2 * 2 * 4 * 4096) {
        const int e = gt & 4095, bh = (gt >> 12) & 7, dir = gt >> 15, h = bh & 3;
        const float cd = ex2(128.f * WSP(float, WS_L2G)[(L * 2 + dir) * 4 + h]);
        const size_t base = (size_t)((dir * 2 + (bh >> 2)) * 4 + h) * NCHUNK * 4096 + e;
        float kv[NCHUNK];
#pragma unroll
        for (int c = 0; c < NCHUNK; ++c) kv[c] = KVT[base + (size_t)c * 4096];
        float st = 0.f;
        if (dir == 0) {
#pragma unroll
            for (int c = 0; c < NCHUNK; ++c) { SIN[base + (size_t)c * 4096] = (bf16_t)f2bf(st); st = cd * st + kv[c]; }
        } else {
            SIN[base + (size_t)1 * 4096] = (bf16_t)f2bf(st); st = cd * st + kv[1];
            SIN[base + (size_t)0 * 4096] = (bf16_t)f2bf(st); st = cd * st + kv[0];
#pragma unroll
            for (int c = NCHUNK - 1; c >= 2; --c) { SIN[base + (size_t)c * 4096] = (bf16_t)f2bf(st); st = cd * st + kv[c]; }
        }
    }
}
DI void ret_out_unit(const Params& a, const Ctx& C, int L, int cg, int h) {
    const bf16_t* P = WSP(bf16_t, WS_P); bf16_t* BR = WSP(bf16_t, WS_BR); const bf16_t* SIN = WSP(bf16_t, WS_SIN);
    const float l2f = WSP(float, WS_L2G)[(L * 2 + 0) * 4 + h], l2b = WSP(float, WS_L2G)[(L * 2 + 1) * 4 + h];
    const float* gn = a.in[C.z + 18] + (size_t)(L * 4 + h) * 64;
    LAS bf16_t* Qs = (LAS bf16_t*)C.lds;
    LAS bf16_t* Ks = Qs + 128 * 72;
    LAS bf16_t* VTs = Ks + 128 * 72;
    LAS bf16_t* Wd = VTs + 64 * 136;
    LAS bf16_t* SfT = Wd + 128 * 136;
    LAS bf16_t* SbT = SfT + 64 * 72;
    const int row0 = cg * 128, lane = C.lane, l15 = lane & 15, quad = lane >> 4; const int b = cg / NCHUNK, c = cg - b * NCHUNK;
    u32x2 rg[4];
#pragma unroll
    for (int vt = 0; vt < 4; ++vt) rg[vt] = *(const u32x2*)(P + (size_t)(row0 + 16 * C.wave + l15) * PW + C_RG + 64 * h + 16 * vt + 4 * quad);
#pragma unroll
    for (int it = 0; it < 2; ++it) { const int idx = C.tid + 512 * it, j = idx >> 3, ch = idx & 7; const bf16_t* pr = P + (size_t)(row0 + j) * PW + 64 * h + 8 * ch;
        *(LAS u32x4*)(Qs + j * 72 + 8 * ch) = *(const u32x4*)(pr + C_RQ); *(LAS u32x4*)(Ks + j * 72 + 8 * ch) = *(const u32x4*)(pr + C_RK);
        const u32x4 vv = *(const u32x4*)(pr + C_RV); const unsigned vw[4] = {vv.x, vv.y, vv.z, vv.w};
#pragma unroll
        for (int e = 0; e < 4; ++e) { VTs[(8 * ch + 2 * e) * 136 + j] = (bf16_t)(vw[e] & 0xffffu); VTs[(8 * ch + 2 * e + 1) * 136 + j] = (bf16_t)(vw[e] >> 16); } }
    { const int v = C.tid >> 3, ch = C.tid & 7;
      *(LAS u32x4*)(SfT + v * 72 + 8 * ch) = *(const u32x4*)(SIN + ((size_t)((0 * 2 + b) * 4 + h) * NCHUNK + c) * 4096 + v * 64 + 8 * ch);
      *(LAS u32x4*)(SbT + v * 72 + 8 * ch) = *(const u32x4*)(SIN + ((size_t)((1 * 2 + b) * 4 + h) * NCHUNK + c) * 4096 + v * 64 + 8 * ch); }
    __syncthreads();
    const int i0 = 16 * C.wave, iw = i0 + l15;
    { bf16x8 bq[2];
#pragma unroll
      for (int ks = 0; ks < 2; ++ks) bq[ks] = *(const LAS bf16x8*)(Qs + iw * 72 + 32 * ks + 8 * quad);
#pragma unroll
      for (int jt = 0; jt < 8; ++jt) { f32x4 acc = {0.f, 0.f, 0.f, 0.f};
#pragma unroll
          for (int ks = 0; ks < 2; ++ks) { const bf16x8 ak = *(const LAS bf16x8*)(Ks + (16 * jt + l15) * 72 + 32 * ks + 8 * quad); acc = MFMA16(ak, bq[ks], acc); }
          float wv[4];
#pragma unroll
          for (int r = 0; r < 4; ++r) { const int j = 16 * jt + 4 * quad + r, dl = iw - j;
              const float f = dl >= 0 ? ex2((float)dl * l2f) : ex2((float)(-dl - 1) * l2b); wv[r] = acc[r] * f; }
          u32x2 w; w.x = pk2(wv[0], wv[1]); w.y = pk2(wv[2], wv[3]); *(LAS u32x2*)(Wd + iw * 136 + 16 * jt + 4 * quad) = w; } }
    __syncthreads();
    f32x4 oi[4], tf[4], tb[4];
#pragma unroll
    for (int vt = 0; vt < 4; ++vt) { oi[vt] = (f32x4){0.f, 0.f, 0.f, 0.f}; tf[vt] = oi[vt]; tb[vt] = oi[vt]; }
#pragma unroll
    for (int ks = 0; ks < 4; ++ks) { const bf16x8 bw = *(const LAS bf16x8*)(Wd + iw * 136 + 32 * ks + 8 * quad);
#pragma unroll
        for (int vt = 0; vt < 4; ++vt) { const bf16x8 av = *(const LAS bf16x8*)(VTs + (16 * vt + l15) * 136 + 32 * ks + 8 * quad); oi[vt] = MFMA16(av, bw, oi[vt]); } }
#pragma unroll
    for (int ks = 0; ks < 2; ++ks) { const bf16x8 bq = *(const LAS bf16x8*)(Qs + iw * 72 + 32 * ks + 8 * quad);
#pragma unroll
        for (int vt = 0; vt < 4; ++vt) { const bf16x8 a1 = *(const LAS bf16x8*)(SfT + (16 * vt + l15) * 72 + 32 * ks + 8 * quad), a2 = *(const LAS bf16x8*)(SbT + (16 * vt + l15) * 72 + 32 * ks + 8 * quad);
            tf[vt] = MFMA16(a1, bq, tf[vt]); tb[vt] = MFMA16(a2, bq, tb[vt]); } }
    { const float qf = ex2((float)(iw + 1) * l2f), qb = ex2((float)(127 - iw) * l2b);
      f32x4 o[4]; float sm = 0.f;
#pragma unroll
      for (int vt = 0; vt < 4; ++vt) { o[vt] = oi[vt] + tf[vt] * qf + tb[vt] * qb; sm += (o[vt][0] + o[vt][1]) + (o[vt][2] + o[vt][3]); }
      sm += shx(sm, 16, lane); sm += shx(sm, 32, lane);
      const float mean = sm * (1.f / 64.f); float q2 = 0.f;
#pragma unroll
      for (int vt = 0; vt < 4; ++vt) { o[vt] = o[vt] - mean; q2 += (o[vt][0] * o[vt][0] + o[vt][1] * o[vt][1]) + (o[vt][2] * o[vt][2] + o[vt][3] * o[vt][3]); }
      q2 += shx(q2, 16, lane); q2 += shx(q2, 32, lane);
      const float rs = __builtin_amdgcn_rsqf(q2 * (1.f / 64.f) + EPS);
#pragma unroll
      for (int vt = 0; vt < 4; ++vt) { const int v0 = 16 * vt + 4 * quad; const f32x4 g4 = *(const f32x4*)(gn + v0); const u32x2 gq = rg[vt];
          const float y0 = o[vt][0] * rs * g4[0] * siluf_(__uint_as_float(gq.x << 16)), y1 = o[vt][1] * rs * g4[1] * siluf_(__uint_as_float(gq.x & 0xffff0000u));
          const float y2 = o[vt][2] * rs * g4[2] * siluf_(__uint_as_float(gq.y << 16)), y3 = o[vt][3] * rs * g4[3] * siluf_(__uint_as_float(gq.y & 0xffff0000u));
          u32x2 w; w.x = pk2(y0, y1); w.y = pk2(y2, y3); *(u32x2*)(BR + (size_t)(row0 + iw) * DM + 768 + 64 * h + v0) = w; } }
    __syncthreads();
}

DI void phase_attnC(const Params& a, const Ctx& C, unsigned char* lds_generic) {
    for (int r = C.bid; r < 256; r += C.G) { const int b = r >> 7, h = (r >> 5) & 3, qb = r & 31;
        attn_body::attn_unit<8>((long)b * TPB + CTXL + qb * 256, (long)b * TPB, C_GQ + 64 * h, C_GK + 64 * (h >> 1), C_GV + 64 * (h >> 1), 512 + 64 * h, (const attn_body::bf16*)WSP(bf16_t, WS_P), (attn_body::bf16*)WSP(bf16_t, WS_BR), (char*)lds_generic, C.tid, __int_as_float(C.z)); }
}
DI void phase_mix(const Params& a, const Ctx& C, int L) {
    constexpr int N_BL = 256, N_BC = 8, N_CC = 8, N_A = 528, N_KV = 528;
    constexpr int NU = N_BL + N_BC + N_CC + N_A + N_KV;
    for (int u = C.bid; u < NU; u += C.G) {
        int r = u;
        if (r < N_BL) { const int b = r >> 7, kvh = (r >> 6) & 1, n = r & 63; const int ls = (n > 0 ? n - 1 : 0) * 128, le = (n < 63 ? n + 2 : 64) * 128;
            attn_unit(a, C, L, 0, b, kvh, b * TPB + CTXL + n * 128, 4, b * TPB, (le - ls) / 64, b * TPB + CTXL + ls, true, true); continue; } r -= N_BL;
        if (r < N_BC) { const int b = r >> 2, kvh = (r >> 1) & 1, cb = r & 1; attn_unit(a, C, L, 0, b, kvh, b * TPB + cb * 128, 4, b * TPB, 0, 0, false, true); continue; } r -= N_BC;
        if (r < N_CC) { const int b = r >> 2, kvh = (r >> 1) & 1, cb = r & 1; attn_unit(a, C, L, 1, b, kvh, b * TPB + cb * 128, 4, b * TPB, 0, 0, false, false); continue; } r -= N_CC;
        if (r < N_A) { mixA_unit(a, C, L, r >> 2, r & 3); continue; } r -= N_A;
        ret_kv_unit(a, C, L, r >> 2, r & 3);
    }
}
DI void phase_ret_out(const Params& a, const Ctx& C, int L) {
    if (L == DEPTH - 1) { for (int u = C.bid; u < 512; u += C.G) { const int lc = u >> 2, bb = lc >> 6; ret_out_unit(a, C, L, bb * NCHUNK + 2 + (lc & 63), u & 3); } }
    else for (int u = C.bid; u < 528; u += C.G) ret_out_unit(a, C, L, u >> 2, u & 3);
}

DI void phase_sum4(const Params& a, const Ctx& C) {
    const bf16_t* P = WSP(bf16_t, WS_P); bf16_t* A = WSP(bf16_t, WS_H);
    const int gt = C.bid * NTHREADS + C.tid, GT = C.G * NTHREADS;
    for (int i = gt; i < T * 128; i += GT) { const int r = i >> 7, c = (i & 127) * 8; const bf16_t* pr = P + (size_t)r * PW + C_GATE + c;
        float s[8];
#pragma unroll
        for (int e = 0; e < 8; ++e) s[e] = 0.f;
#pragma unroll
        for (int br = 0; br < 4; ++br) { const u32x4 v = *(const u32x4*)(pr + br * 1024); const unsigned w[4] = {v.x, v.y, v.z, v.w};
#pragma unroll
            for (int e = 0; e < 4; ++e) { s[2 * e] += __uint_as_float(w[e] << 16); s[2 * e + 1] += __uint_as_float(w[e] & 0xffff0000u); } }
        *(u32x4*)(A + (size_t)r * DM + c) = (u32x4){pk2(s[0], s[1]), pk2(s[2], s[3]), pk2(s[4], s[5]), pk2(s[6], s[7])}; }
}

DI void phase_gather(const Params& a, const Ctx& C, int L) {
    int* rt_i = WSP(int, WS_ROUTE); float* rt_f = WSP(float, WS_ROUTE);
    const bf16_t* H = WSP(bf16_t, WS_H); bf16_t* HG = WSP(bf16_t, WS_HG);
    LAS int* lt = (LAS int*)C.lds;
    { const int e = C.wave; const int* blk = rt_i + RT_BLK + (L >> 1) * 1024 * 8; int tot = 0, pre = 0;
      for (int b = C.lane; b < C.G; b += 64) { const int v = blk[b * 8 + e]; tot += v; pre += (b < C.bid) ? v : 0; }
#pragma unroll
      for (int o = 1; o < 64; o <<= 1) { tot += __builtin_amdgcn_ds_bpermute((C.lane ^ o) << 2, tot); pre += __builtin_amdgcn_ds_bpermute((C.lane ^ o) << 2, pre); }
      if (C.lane == 0) { lt[e] = tot; lt[8 + e] = pre; } }
    __syncthreads();
    int base[NEXP + 1]; int cn[NEXP]; int mybase[NEXP];
    { int acc = 0;
#pragma unroll
      for (int e = 0; e < NEXP; ++e) { cn[e] = lt[e]; base[e] = acc; mybase[e] = acc + lt[8 + e]; acc += ((cn[e] + 255) >> 8) << 8; } base[NEXP] = acc; }
    if (C.bid == 0) {
        if (C.tid == 0) { rt_i[RT_META] = base[NEXP] >> 8; }
        for (int rt = C.tid; rt < (base[NEXP] >> 8); rt += NTHREADS) { int e = 0;
#pragma unroll
            for (int k = 1; k < NEXP; ++k) if (rt * 256 >= base[k]) e = k;
            rt_i[RT_META + 16 + rt] = e; }
#pragma unroll
        for (int e = 0; e < NEXP; ++e) for (int r = base[e] + cn[e] + C.tid; r < base[e + 1]; r += NTHREADS) rt_i[RT_ROWTOK + r] = -1;
    }
    const int gw = C.bid * NWAVES + C.wave, NGW = C.G * NWAVES; const bool skipc = L == DEPTH - 1;
    int ne[2] = {0, 0}, np[2] = {0, 0}; float npw[2] = {0.f, 0.f}; u32x4 nh0, nh1;
    auto fetch = [&](int t) { ne[0] = rt_i[RT_E + 2 * t]; ne[1] = rt_i[RT_E + 2 * t + 1]; np[0] = rt_i[RT_POS + 2 * t]; np[1] = rt_i[RT_POS + 2 * t + 1]; npw[0] = rt_f[RT_PW + 2 * t]; npw[1] = rt_f[RT_PW + 2 * t + 1];
        nh0 = *(const u32x4*)(H + (size_t)t * DM + 8 * C.lane); nh1 = *(const u32x4*)(H + (size_t)t * DM + 512 + 8 * C.lane); };
    auto next_tok = [&](int t) { t += NGW; while (skipc && t < T && modrow(t) == 2) t += NGW; return t; };
    int t = gw; while (skipc && t < T && modrow(t) == 2) t += NGW;
    if (t < T) fetch(t);
    while (t < T) {
        const int e0 = ne[0], e1 = ne[1], p0 = np[0], p1 = np[1]; const float w0 = npw[0], w1 = npw[1]; const u32x4 h0 = nh0, h1 = nh1;
        const int tn = next_tok(t); if (tn < T) fetch(tn);
#pragma unroll
        for (int k = 0; k < 2; ++k) { const int e = k ? e1 : e0, pos = k ? p1 : p0;
            int bs = 0;
#pragma unroll
            for (int q = 0; q < NEXP; ++q) if (q == e) bs = mybase[q];
            const int row = bs + pos;
            *(u32x4*)(HG + (size_t)row * DM + 8 * C.lane) = h0; *(u32x4*)(HG + (size_t)row * DM + 512 + 8 * C.lane) = h1;
            if (C.lane == 0) { rt_i[RT_ROWTOK + row] = t; rt_f[RT_ROWP + row] = k ? w1 : w0; rt_i[RT_POS + 2 * t + k] = row; } }
        t = tn;
    }
}

DI void phase_combine(const Params& a, const Ctx& C, int L) {
    const int* rt_i = WSP(int, WS_ROUTE); const bf16_t* Y = WSP(bf16_t, WS_HG); const bf16_t* XS = WSP(bf16_t, WS_XS);
    const float* mod = WSP(float, WS_MOD) + (size_t)L * 3 * 6144 + 5 * DM;
    const int lane = C.lane, gw = C.bid * NWAVES + C.wave, NGW = C.G * NWAVES;
    f32x4 gc[4]; int mrc = -1;
    int nrow0 = 0, nrow1 = 0; u32x4 nx[2];
    auto fetch = [&](int t) { nrow0 = rt_i[RT_POS + 2 * t]; nrow1 = rt_i[RT_POS + 2 * t + 1];
#pragma unroll
        for (int hf = 0; hf < 2; ++hf) nx[hf] = *(const u32x4*)(XS + (size_t)t * DM + hf * 512 + 8 * lane); };
    auto next_tok = [&](int t) { t += NGW; while (t < T && modrow(t) == 2) t += NGW; return t; };
    int t = gw; while (t < T && modrow(t) == 2) t += NGW;
    if (t < T) fetch(t);
    while (t < T) {
        const int row0 = nrow0, row1 = nrow1; const u32x4 xq0 = nx[0], xq1 = nx[1];
        const int tn = next_tok(t); if (tn < T) fetch(tn);
        const int bb = t / TPB, pp = t - bb * TPB; float* orow = C.out + (size_t)(bb * SEQ + pp - CTXL) * DM;
        if (bb != mrc) { mrc = bb; const float* gt = mod + (size_t)bb * 6144;
#pragma unroll
            for (int hf = 0; hf < 2; ++hf) { gc[2 * hf] = *(const f32x4*)(gt + hf * 512 + 8 * lane); gc[2 * hf + 1] = *(const f32x4*)(gt + hf * 512 + 8 * lane + 4); } }
        f32x4 ya[2], yb[2];
#pragma unroll
        for (int hf = 0; hf < 2; ++hf) y2_pair8(Y, WSP(bf16_t, WS_Y2P), row0, row1, hf * 512 + 8 * lane, ya[hf], yb[hf]);
#pragma unroll
        for (int hf = 0; hf < 2; ++hf) { const int c = hf * 512 + 8 * lane; f32x4 x0, x1; unpack8(hf ? xq1 : xq0, x0, x1);
            *(f32x4*)(orow + c) = x0 + gc[2 * hf] * ya[hf]; *(f32x4*)(orow + c + 4) = x1 + gc[2 * hf + 1] * yb[hf]; }
        t = tn;
    }
}

constexpr int PH_PER_LAYER = 15;
#define PHASE_CTX() Ctx C; { int z_ = 0; asm volatile("s_mov_b32 %0, 0" : "=s"(z_)); C.z = z_; C.lds = (LAS unsigned char*)lds_raw; { int t_; LANE_ID_ASM(t_); t_ += wave_s * 64; C.tid = t_; } C.lane = C.tid & 63; \
    C.wave = __builtin_amdgcn_readfirstlane(C.tid >> 6); C.G = (int)gridDim.x + z_; C.bid = (int)blockIdx.x + z_; C.out = a.out + z_; C.ws = a.ws + z_; }
template <int PHMASK, bool FUSED>
__global__ void __launch_bounds__(NTHREADS, 2) mixer_fwd(Params a) {
    extern __shared__ __attribute__((aligned(16))) unsigned char lds_raw[];
    volatile LAS unsigned* MISC = (volatile LAS unsigned*)((LAS unsigned char*)lds_raw + MISC_OFF);
    if (threadIdx.x < 32) MISC[threadIdx.x] = 0u;
    const int wave_s = __builtin_amdgcn_readfirstlane((int)(threadIdx.x >> 6));
    __syncthreads();
    XcdBarrier bar; bar.bar = (unsigned*)(a.ws + WS_CTL) + CW_BAR; bar.x = 0; bar.st = nullptr;
    if (FUSED) bar = xcd_barrier_post((unsigned*)(a.ws + WS_CTL) + CW_BAR, MISC + 8);
#define SEAM() do { if (FUSED) { unsigned l_; LANE_ID_ASM(l_); xcd_barrier_fn(bar.bar, bar.x, (unsigned)(unsigned long long)bar.st, (unsigned)(wave_s * 64) + l_); } } while (0)
#ifndef PHASE_MASK
#define PHASE_MASK 0xffff
#endif
#define RUN(k) ((((PHASE_MASK) & (PHMASK)) >> (k)) & 1)
#ifndef PROBE_MASK
#define PROBE_MASK 0
#endif
#ifndef PROBE_MULT
#define PROBE_MULT 4
#endif
    unsigned long long pr_acc = 0, pr_t0 = 0;
#define PB(k) do { if ((PROBE_MASK >> (k)) & 1) pr_t0 = __builtin_amdgcn_s_memrealtime(); } while (0)
#define PE(k) do { if ((PROBE_MASK >> (k)) & 1) pr_acc += __builtin_amdgcn_s_memrealtime() - pr_t0; } while (0)

    if (a.l_lo == 0 && RUN(0)) { PB(0); PHASE_CTX(); phase_g0(a, C); __syncthreads(); phase_cvt(a, C, 0, 0, 25, 0); __syncthreads(); SEAM(); PE(0); }
    for (int L = a.l_lo; L < a.l_hi; ++L) {
        const bool moe = L & 1;
        if (RUN(1)) { PB(1); PHASE_CTX();  phase_norm(a, C, L, 0); __syncthreads(); SEAM(); PE(1); }
        if (RUN(2)) { PB(2); PHASE_CTX(); pg8::Gemm g{WSP(bf16_t, WS_H), WSP(bf16_t, WS_W + (size_t)(L & 1) * W_BUF + W_IN), DM, DM, DM}; pg8::InOrder S{C.G, C.bid}; pg8::EpiIn E{WSP(bf16_t, WS_P), WSP(bf16_t, WS_GT), WSP(float, WS_TAB), a.in[C.z + 9] + (size_t)L * 256, a.in[C.z + 12] + L * 64, a.in[C.z + 13] + L * 64, a.in[C.z + 15] + L * 64, a.in[C.z + 16] + L * 64};
            pg8::gemm_phase(C.lds, C.tid, g, S, E); if (L == 0) phase_cvt(a, C, 0, 25, 64, 180); __syncthreads(); SEAM(); PE(2); }
        if (RUN(4)) { PB(4); { PB(15); PHASE_CTX(); phase_attnC(a, C, lds_raw); __syncthreads(); PE(15); } { PB(16); PHASE_CTX(); phase_mix(a, C, L); __syncthreads(); PE(16); } SEAM(); PE(4); }
        if (RUN(5)) { PB(5); PHASE_CTX(); phase_ret_scan(a, C, L); SEAM(); PE(5); }
        if (RUN(6)) { PB(6); PHASE_CTX(); phase_ret_out(a, C, L); if (L + 1 < DEPTH) phase_cvt(a, C, L + 1, 0, (L & 1) ? 20 : 14, 16); __syncthreads(); SEAM(); PE(6); }
        if (RUN(7)) { PB(7); PHASE_CTX(); pg8::Gemm g{WSP(bf16_t, WS_BR), WSP(bf16_t, WS_W + (size_t)(L & 1) * W_BUF + W_BR), DM, DM, DM};
            pg8::gemm_merge_phase(C.lds, C.tid, g, C.G, C.bid, WSP(bf16_t, WS_GT), WSP(bf16_t, WS_H), L == DEPTH - 1); if (L + 1 < DEPTH) phase_cvt(a, C, L + 1, (L & 1) ? 20 : 14, (L & 1) ? 64 : 40, 16); __syncthreads(); SEAM(); PE(7); }
        if (RUN(9)) { PB(9); PHASE_CTX(); pg8::Gemm g{WSP(bf16_t, WS_H), WSP(bf16_t, WS_W + (size_t)(L & 1) * W_BUF + W_OUT), DM, DM, DM}; pg8::CtxSplitOrder S{C.G, C.bid, 4, L == DEPTH - 1};
            pg8::EpiResid E{WSP(bf16_t, WS_XS), WSP(float, WS_MOD) + (size_t)L * 3 * 6144 + 2 * DM, WSP(bf16_t, WS_BR)};
            pg8::gemm_phase(C.lds, C.tid, g, S, E); if (!(L & 1)) phase_cvt(a, C, L + 1, 40, 52, 32); __syncthreads(); SEAM(); PE(9); }
        if (RUN(10)) { PB(10); PHASE_CTX(); phase_norm(a, C, L, 1); SEAM(); PE(10); }
        if (!moe) {
            if (RUN(11)) { PB(11); PHASE_CTX(); pg8::Gemm g{WSP(bf16_t, WS_H), WSP(bf16_t, WS_W + (size_t)(L & 1) * W_BUF + W_13), DM, DM, DM}; pg8::StaticOrder S; S.init(T, 2 * DFF, C.G, C.bid); pg8::EpiSwiglu E{WSP(bf16_t, WS_P), DFF, 1 << 20};
                pg8::gemm_phase(C.lds, C.tid, g, S, E); SEAM(); PE(11); }
            if (RUN(12)) { PB(12); PHASE_CTX(); pg8::Gemm g{WSP(bf16_t, WS_P), WSP(bf16_t, WS_W + (size_t)(L & 1) * W_BUF + W_2), DFF, DFF, DFF}; pg8::CtxSplitOrder S{C.G, C.bid, 11, false};
                pg8::EpiResid E{WSP(bf16_t, WS_XS), WSP(float, WS_MOD) + (size_t)L * 3 * 6144 + 5 * DM, WSP(bf16_t, WS_BR)};
                pg8::gemm_phase(C.lds, C.tid, g, S, E); phase_cvt(a, C, L + 1, 52, 64, 88); __syncthreads(); SEAM(); PE(12); }
        } else {
            if (RUN(11)) { PB(11); PHASE_CTX(); phase_gather(a, C, L); SEAM(); PE(11); }
            if (RUN(12)) { PB(12); PHASE_CTX(); pg8::Gemm g{WSP(bf16_t, WS_HG), WSP(bf16_t, WS_W + (size_t)(L & 1) * W_BUF + W_13), DM, DM, DM}; pg8::MoeOrder S{WSP(int, WS_ROUTE) + RT_META, 14, C.G, C.bid}; pg8::EpiSwiglu E{WSP(bf16_t, WS_HIDM), DFE, 14};
                pg8::gemm_phase(C.lds, C.tid, g, S, E); SEAM(); PE(12); }
            if (RUN(13)) { PB(13); PHASE_CTX(); pg8::Gemm g{WSP(bf16_t, WS_HIDM), WSP(bf16_t, WS_W + (size_t)(L & 1) * W_BUF + W_2), DFE, DFE, DFE}; pg8::Moe2Order S{WSP(int, WS_ROUTE) + RT_META, C.G, C.bid};
                pg8::EpiMoe2 E{WSP(bf16_t, WS_HG), WSP(float, WS_ROUTE) + RT_ROWP, 4, WSP(bf16_t, WS_Y2P)};
                pg8::gemm_phase(C.lds, C.tid, g, S, E); SEAM(); PE(13); }
            if (RUN(14) && L == DEPTH - 1) { PB(14); PHASE_CTX(); phase_combine(a, C, L); SEAM(); PE(14); }
        }
    }
    if (PROBE_MASK) { const unsigned long long t1 = __builtin_amdgcn_s_memrealtime(); while (__builtin_amdgcn_s_memrealtime() - t1 < (unsigned long long)PROBE_MULT * pr_acc) __builtin_amdgcn_s_sleep(8); }
#undef SEAM
#undef RUN
}

#if !MK_FUSED
typedef void (*kern_t)(Params);
template <int PH> static kern_t phase_kernel() { return mixer_fwd<(1 << PH), false>; }
static kern_t get_kernel(int ph) {
    switch (ph) {
        case 0: return phase_kernel<0>(); case 1: return phase_kernel<1>(); case 2: return phase_kernel<2>(); case 3: return phase_kernel<3>(); case 4: return phase_kernel<4>();
        case 5: return phase_kernel<5>(); case 6: return phase_kernel<6>(); case 7: return phase_kernel<7>(); case 8: return phase_kernel<8>(); case 9: return phase_kernel<9>();
        case 10: return phase_kernel<10>(); case 11: return phase_kernel<11>(); case 12: return phase_kernel<12>(); case 13: return phase_kernel<13>(); default: return phase_kernel<14>();
    }
}
#endif
extern "C" void kernel_launch(void* const* d_in, const int* in_sizes, int n_in, void* d_out, int out_size, void* d_ws, size_t ws_size, hipStream_t stream) {
    static int grid = 0;
    if (grid == 0) {
        if (n_in != 29 || out_size != NBATCH * SEQ * DM || ws_size < WS_END) { fprintf(stderr, "kernel_launch: unexpected shapes (n_in %d, out %d, ws %zu < %zu)\n", n_in, out_size, ws_size, (size_t)WS_END); grid = -1; return; }
        int dev = 0, cus = 0;
        if (hipGetDevice(&dev) != hipSuccess || hipDeviceGetAttribute(&cus, hipDeviceAttributeMultiprocessorCount, dev) != hipSuccess) { grid = -1; return; }
#if MK_FUSED
        if (hipFuncSetAttribute((const void*)mixer_fwd<0x7fff, true>, hipFuncAttributeMaxDynamicSharedMemorySize, LDS_BYTES) != hipSuccess) { grid = -1; return; }
#else
        for (int ph = 0; ph < PH_PER_LAYER; ++ph) if (hipFuncSetAttribute((const void*)get_kernel(ph), hipFuncAttributeMaxDynamicSharedMemorySize, LDS_BYTES) != hipSuccess) { grid = -1; return; }
#endif
        (void)hipGetLastError();
        grid = cus;
    }
    if (grid < 0) return;
    (void)hipMemsetAsync((char*)d_ws + WS_CTL, 0, CTL_ZERO_BYTES, stream);
    Params p{};
    for (int i = 0; i < 29; ++i) p.in[i] = (const float*)d_in[i];
    p.out = (float*)d_out; p.ws = (unsigned char*)d_ws; p.pad = 0; p.ph_lo = 0; p.ph_hi = 0;
#if MK_FUSED
    p.l_lo = 0; p.l_hi = DEPTH; p.fused = 1;
    hipLaunchKernelGGL((mixer_fwd<0x7fff, true>), dim3(grid), dim3(NTHREADS), LDS_BYTES, stream, p);
#else
    p.fused = 0; p.l_lo = 0; p.l_hi = 1;
    hipLaunchKernelGGL(get_kernel(0), dim3(grid), dim3(NTHREADS), LDS_BYTES, stream, p);
#ifndef NL_RUN
#define NL_RUN DEPTH
#endif
    for (int L = 0; L < NL_RUN; ++L)
        for (int ph = 1; ph < PH_PER_LAYER; ++ph) {
            if (!(L & 1) && ph >= 13) continue;
            p.l_lo = L; p.l_hi = L + 1;
            hipLaunchKernelGGL(get_kernel(ph), dim3(grid), dim3(NTHREADS), LDS_BYTES, stream, p);
        }
#endif
}
```

```cpp
#include <hip/hip_runtime.h>
#include <cstdio>
#include <cstdint>

#ifndef MK_FUSED
#define MK_FUSED 1
#endif

#define DI __device__ __forceinline__
#define LANE_ID_ASM(dst) asm volatile("v_mbcnt_lo_u32_b32 %0, -1, 0\n\tv_mbcnt_hi_u32_b32 %0, -1, %0" : "=v"(dst))
#define LAS __attribute__((address_space(3)))
#define GAS __attribute__((address_space(1)))
typedef unsigned short bf16_t;
typedef short bf16x8 __attribute__((ext_vector_type(8)));
typedef short s16x4 __attribute__((ext_vector_type(4)));
typedef float f32x4 __attribute__((ext_vector_type(4)));
typedef float f32x2 __attribute__((ext_vector_type(2)));
typedef float f32x16 __attribute__((ext_vector_type(16)));
typedef unsigned u32x4 __attribute__((ext_vector_type(4)));
typedef unsigned u32x2 __attribute__((ext_vector_type(2)));

constexpr int DM = 1024, NBATCH = 2, SEQ = 8192, CTXL = 256, TPB = SEQ + CTXL, T = NBATCH * TPB, DEPTH = 4;
constexpr int INW = 6656, DFF = 2816, NEXP = 8, DFE = 1792;
constexpr int PW = 2560;
constexpr int C_U = 0, C_V = 256, C_WQ = 512, C_WK = 768, C_WV = 896, C_GQ = 1024, C_GK = 1280, C_GV = 1408, C_RQ = 1536, C_RK = 1792, C_RV = 2048, C_RG = 2304, C_GATE = 2560;
constexpr int NCHUNK = TPB / 128;
constexpr int NTILE_M = T / 256;
constexpr int MOE_ROWS = 2 * T + NEXP * 256;
constexpr int MOE2_FULL_RT = 128, MOE2_NP = 7, MOE2_PROWS = 12 * 256;
constexpr float EPS = 1e-6f;
constexpr float LOG2E = 1.4426950408889634f;
constexpr float QSCALE = 0.125f * LOG2E;

constexpr size_t MiB = 1u << 20;
constexpr size_t WS_CTL = 0, CTL_ZERO_BYTES = 1 * MiB;
constexpr size_t WS_MOD = 1 * MiB;
constexpr size_t WS_L2G = 1 * MiB + 512 * 1024;
constexpr size_t WS_TAB = 2 * MiB;
constexpr size_t TAB_AXC = 0, TAB_AXS = 8192 * 32 * 4, TAB_SQC = 2 * 8192 * 32 * 4, TAB_SQS = TAB_SQC + 8448 * 32 * 4;
constexpr size_t WS_WSB = 7 * MiB;
constexpr size_t WS_CTXB = 8 * MiB;
constexpr size_t WS_ROUTE = 10 * MiB;
constexpr size_t WS_VT = 12 * MiB;
constexpr size_t WS_KVT = 21 * MiB;
constexpr size_t WS_SIN = 38 * MiB;
constexpr size_t WS_H = 47 * MiB;
constexpr size_t WS_BR = 80 * MiB;
constexpr size_t WS_P = 113 * MiB;
constexpr size_t WS_HG = WS_P, WS_HIDM = WS_P + 70 * MiB;
constexpr size_t WS_GT = WS_P + 83 * MiB;
static_assert((size_t)T * PW * 2 <= 83 * MiB && WS_GT + (size_t)T * 4096 * 2 <= WS_P + 215 * MiB, "P + GT fit");
constexpr size_t WS_W = 328 * MiB;
constexpr size_t W_IN = 0, W_BR = 13 * MiB, W_OUT = 15 * MiB, W_13 = 17 * MiB, W_2 = 73 * MiB;
constexpr size_t W_BUF = 101 * MiB;
constexpr size_t WS_XS = WS_W + 2 * W_BUF;
constexpr size_t WS_Y2P = WS_XS + 33 * MiB;
constexpr size_t WS_END = WS_Y2P + 44 * MiB;
static_assert((size_t)T * INW * 2 <= 215 * MiB && WS_P + 215 * MiB <= WS_W, "P fits");
static_assert((size_t)MOE_ROWS * 1024 * 2 <= 70 * MiB && (size_t)MOE_ROWS * DFE * 2 + 70 * MiB <= 215 * MiB, "moe overlay fits");
constexpr int RT_E = 0;
constexpr int RT_POS = 2 * T;
constexpr int RT_PW = 4 * T;
constexpr int RT_ROWTOK = 6 * T;
constexpr int RT_ROWP = RT_ROWTOK + MOE_ROWS;
constexpr int RT_META = RT_ROWP + MOE_ROWS;
constexpr int RT_BLK = RT_META + 256;
static_assert((size_t)(RT_BLK + 2 * 1024 * 8) * 4 <= 2 * MiB, "route fits");
constexpr int CW_BAR = 4096;
constexpr int CW_CNT = 16384;

DI float bf2f(unsigned short h) { return __uint_as_float((unsigned)h << 16); }
DI unsigned f2bf(float f) { unsigned u = __float_as_uint(f); return (u + 0x7fffu + ((u >> 16) & 1u)) >> 16; }
typedef float f32x2_c __attribute__((ext_vector_type(2))); typedef __bf16 bf16x2_c __attribute__((ext_vector_type(2)));
DI unsigned pk2(float lo, float hi) { const f32x2_c v = {lo, hi}; return __builtin_bit_cast(unsigned, __builtin_convertvector(v, bf16x2_c)); }
DI float ex2(float x) { return __builtin_amdgcn_exp2f(x); }
DI float rcpf_(float x) { return __builtin_amdgcn_rcpf(x); }
DI float sigm(float x) { return rcpf_(1.f + ex2(-x * LOG2E)); }
DI float siluf_(float x) { return x * sigm(x); }
DI float gelu_tanh(float x) { const float u = 0.7978845608f * (x + 0.044715f * x * x * x); return x * sigm(2.f * u); }
#define LDS_BARRIER() asm volatile("s_waitcnt lgkmcnt(0)\n\ts_barrier" ::: "memory")
DI float shx(float v, int o, int lane) { return __int_as_float(__builtin_amdgcn_ds_bpermute((lane ^ o) << 2, __float_as_int(v))); }
DI float wave_sum(float v, int lane) {
#pragma unroll
    for (int o = 1; o < 64; o <<= 1) v += shx(v, o, lane);
    return v;
}
DI int crow(int r, int hi) { return (r & 3) + 8 * (r >> 2) + 4 * hi; }
#define MFMA16(a, b, c) __builtin_amdgcn_mfma_f32_16x16x32_bf16((a), (b), (c), 0, 0, 0)
#define MFMA32(a, b, c) __builtin_amdgcn_mfma_f32_32x32x16_bf16((a), (b), (c), 0, 0, 0)

struct Params {
    const float* in[29];
    float* out; unsigned char* ws;
    int l_lo, l_hi, ph_lo, ph_hi, fused, pad;
};
DI const float* xrow_c(const float* lat, const float* ctx, int r) { const int b = r / TPB, p = r - b * TPB; return p < CTXL ? ctx + (size_t)(b * CTXL + p) * DM : lat + (size_t)(b * SEQ + p - CTXL) * DM; }
DI float* xrow(float* lat, float* ctx, int r) { const int b = r / TPB, p = r - b * TPB; return p < CTXL ? ctx + (size_t)(b * CTXL + p) * DM : lat + (size_t)(b * SEQ + p - CTXL) * DM; }
DI f32x4 y2_load4(const bf16_t* Y, const bf16_t* YP, int row, int c) {
    if (row < MOE2_FULL_RT * 256) { const u32x2 q = *(const u32x2*)(Y + (size_t)row * DM + c); return (f32x4){__uint_as_float(q.x << 16), __uint_as_float(q.x & 0xffff0000u), __uint_as_float(q.y << 16), __uint_as_float(q.y & 0xffff0000u)}; }
    f32x4 a = {0.f, 0.f, 0.f, 0.f}; u32x2 q[MOE2_NP];
#pragma unroll
    for (int p = 0; p < MOE2_NP; ++p) q[p] = *(const u32x2*)(YP + ((size_t)p * MOE2_PROWS + row - MOE2_FULL_RT * 256) * DM + c);
#pragma unroll
    for (int p = 0; p < MOE2_NP; ++p) { a[0] += __uint_as_float(q[p].x << 16); a[1] += __uint_as_float(q[p].x & 0xffff0000u); a[2] += __uint_as_float(q[p].y << 16); a[3] += __uint_as_float(q[p].y & 0xffff0000u); }
    return a;
}
DI int modrow(int r) { const int b = r / TPB, p = r - b * TPB; return p < CTXL ? 2 : b; }

namespace pg8 {
constexpr int BM = 256, BK = 64, HALF = 128, HTB = HALF * BK * 2, STAGE_BYTES = 8 * HTB, NXCD = 8, WGM = 8;
DI int lds_byte(int r, int c) { const int st = (r >> 4) * 2 + (c >> 5), rr = r & 15, cc = c & 31, ob = rr * 64 + cc * 2; return st * 1024 + (ob ^ (((ob >> 9) & 1) << 5)); }
DI void stage_rc(int b, int& R, int& C) { const int st = b / 1024, sb = b % 1024, swz = sb ^ (((sb >> 9) & 1) << 5); R = (st >> 1) * 16 + swz / 64; C = (st & 1) * 32 + (swz % 64) / 2; }
DI int perm32(int rho) { const int n = rho >> 4, i = rho & 15; return 8 * (i >> 2) + 4 * n + (i & 3); }
DI int xcd_vc(int G, int c) { return (G % 8 == 0) ? (c % 8) * (G / 8) + c / 8 : c; }
struct Unit { int pm, pn; int aoff, boff, nt, part; };
DI void unit_defaults(Unit& u) { u.aoff = 0; u.boff = 0; u.nt = 0; u.part = -1; }
struct Gemm { const bf16_t* A; const bf16_t* Bt; int lda, ldb, K; };

struct StaticOrder {
    static constexpr bool GATHER = false;
    int nM, nN, nwg, G, c;
    DI void init(int M, int N, int G_, int c_) { nM = M / BM; nN = N / BM; nwg = nM * nN; G = G_; c = c_; }
    DI bool next(int i, Unit& u) const {
        const long L = (long)i * G + c; if (L >= nwg) return false;
        int wgid = (int)L; { const int q = nwg / NXCD, r = nwg % NXCD, xcd = wgid % NXCD, off = wgid / NXCD; wgid = (xcd < r ? xcd * (q + 1) : r * (q + 1) + (xcd - r) * q) + off; }
        const int nig = WGM * nN, gid = wgid / nig, fm = gid * WGM, gsz = (nM - fm) < WGM ? (nM - fm) : WGM;
        u.pm = fm + ((wgid % nig) % gsz); u.pn = (wgid % nig) / gsz; unit_defaults(u); return true;
    }
};
struct MergeOrder : StaticOrder {
    DI bool next(int i, Unit& u) const { if (!StaticOrder::next(i, u)) return false; u.aoff = (u.pn >> 2) * 256 * 2; return true; }
};
struct LatOrder {
    static constexpr bool GATHER = false;
    int nN, G, c; bool lo;
    DI bool next(int i, Unit& u) const { const int Lx = i * G + xcd_vc(G, c); if (Lx >= (lo ? 64 : NTILE_M) * nN) return false; const int pt = Lx / nN; u.pm = lo ? pt + 1 + (pt >= 32) : pt; u.pn = Lx - pt * nN; unit_defaults(u); return true; }
};
struct RowOrder {
    static constexpr bool GATHER = false;
    int nN, G, c;
    DI bool next(int i, Unit& u) const { const int tot = NTILE_M * nN; const int Lx = i * G + ((i + 1) * G <= tot ? xcd_vc(G, c) : c); if (Lx >= tot) return false; u.pm = Lx / nN; u.pn = Lx - u.pm * nN; unit_defaults(u); return true; }
};
struct CtxSplitOrder {
    static constexpr bool GATHER = false;
    int G, c, NP; bool lo;
    DI bool next(int i, Unit& u) const {
        const int Lx = i * G + (i == 0 ? xcd_vc(G, c) : c); unit_defaults(u);
        if (Lx < 256) { const int pt = Lx >> 2; u.pm = pt + 1 + (pt >= 32); u.pn = Lx & 3; return true; }
        if (lo) return false;
        const int S = Lx - 256; if (S >= 8 * NP) return false;
        const int tile = S / NP, piece = S - tile * NP; u.pm = (tile >> 2) * 33; u.pn = tile & 3; u.aoff = piece * 512; u.boff = piece * 512; u.nt = 4; u.part = piece; return true;
    }
};
struct Moe2Order {
    static constexpr bool GATHER = false;
    const int* meta; int G, c;
    DI bool next(int i, Unit& u) const {
        const int nrt = meta[0]; const int Lx = i * G + xcd_vc(G, c); unit_defaults(u);
        const int nfull = (nrt < MOE2_FULL_RT ? nrt : MOE2_FULL_RT) * 4;
        if (Lx < nfull) { u.pm = Lx >> 2; u.pn = meta[16 + u.pm] * 4 + (Lx & 3); return true; }
        const int S = Lx - nfull; if (nrt <= MOE2_FULL_RT || S >= (nrt - MOE2_FULL_RT) * 4 * MOE2_NP) return false;
        const int tile = S / MOE2_NP, piece = S - tile * MOE2_NP; u.pm = MOE2_FULL_RT + (tile >> 2); u.pn = meta[16 + u.pm] * 4 + (tile & 3);
        u.aoff = piece * 512; u.boff = piece * 512; u.nt = 4; u.part = piece; return true;
    }
};
struct InOrder {
    static constexpr bool GATHER = false;
    int G, c;
    DI bool next(int i, Unit& u) const {
        const int tot = NTILE_M * 26; const int Lx = i * G + ((i + 1) * G <= tot ? xcd_vc(G, c) : c); unit_defaults(u);
        if (Lx >= tot) return false;
        u.pm = Lx / 26; u.pn = Lx - u.pm * 26; return true;
    }
};
struct MoeOrder {
    static constexpr bool GATHER = true;
    const int* meta; int nNl, G, c; const int* rowtok;
    DI bool next(int i, Unit& u) const {
        const int nrt = meta[0]; const long L = (long)i * G + xcd_vc(G, c); if (L >= (long)nrt * nNl) return false;
        const int pm = (int)(L / nNl), pl = (int)(L % nNl); u.pm = pm; u.pn = meta[16 + pm] * nNl + pl; unit_defaults(u); return true;
    }
};

DI unsigned cvt_pk_bf16(float lo, float hi) { unsigned r; asm volatile("v_cvt_pk_bf16_f32 %0, %1, %2" : "=v"(r) : "v"(lo), "v"(hi)); return r; }

struct EpiIn {
    static constexpr bool PERM = true;
    bf16_t* O; bf16_t* GT; const float* tab; const float* gvv; const float* wqn; const float* wkn; const float* gqn; const float* gkn;
    DI void operator()(const f32x4 (&acc)[2][2][4][2], const Unit& u, int wr, int wc, int fr, int fq) const {
        const int lane = fq * 16 + fr;
        if (u.pn >= 1 && u.pn <= 8) {
            const int H = 4 * (u.pn - 1) + wc;
            int kind; const float* g = gvv + 64 * (H & 3); float scale = 1.f;
            if (H < 4) kind = 1;
            else if (H < 8) { kind = 2; g = wqn; scale = QSCALE; }
            else if (H < 10) { kind = 2; g = wkn; }
            else if (H < 12) kind = 0;
            else if (H < 16) { kind = 2; g = gqn; scale = QSCALE; }
            else if (H < 18) { kind = 2; g = gkn; }
            else if (H < 20) kind = 0;
            else if (H < 24) kind = 3;
            else if (H < 28) { kind = 3; scale = 0.125f; }
            else kind = 0;
            const int bb = u.pm / 33, jj = u.pm - bb * 33; const bool lat = jj != 0;
            f32x4 g0 = {1.f, 1.f, 1.f, 1.f}, g1 = g0, g2 = g0, g3 = g0;
            if (kind == 1 || kind == 2) { g0 = *(const f32x4*)(g + 8 * fq); g1 = *(const f32x4*)(g + 8 * fq + 4); g2 = *(const f32x4*)(g + 32 + 8 * fq); g3 = *(const f32x4*)(g + 32 + 8 * fq + 4); }
            const bool rope = (kind == 2 && lat) || kind == 3;
            const float* ctab = tab + (kind == 2 ? TAB_AXC : TAB_SQC) / 4 + 8 * fq; const float* stab = tab + (kind == 2 ? TAB_AXS : TAB_SQS) / 4 + 8 * fq;
#pragma unroll
            for (int ai = 0; ai < 2; ++ai)
#pragma unroll
                for (int m = 0; m < 4; ++m) {
                    const int rit = ai * HALF + wr * 64 + m * 16 + fr;
                    f32x4 x0 = acc[ai][0][m][0], x1 = acc[ai][0][m][1], y0 = acc[ai][1][m][0], y1 = acc[ai][1][m][1];
                    if (u.pn == 1) {
#pragma unroll
                        for (int e = 0; e < 4; ++e) { x0[e] = gelu_tanh(x0[e]); x1[e] = gelu_tanh(x1[e]); y0[e] = gelu_tanh(y0[e]); y1[e] = gelu_tanh(y1[e]); } }
                    if (kind == 1 || kind == 2) {
                        const f32x4 q = x0 * x0 + x1 * x1 + y0 * y0 + y1 * y1; float ss = (q[0] + q[1]) + (q[2] + q[3]);
                        ss += shx(ss, 16, lane); ss += shx(ss, 32, lane);
                        const float rs = __builtin_amdgcn_rsqf(ss * (1.f / 64.f) + EPS);
                        x0 = x0 * g0 * rs; x1 = x1 * g1 * rs; y0 = y0 * g2 * rs; y1 = y1 * g3 * rs;
                    }
                    if (rope) {
                        const int pos = kind == 2 ? (jj - 1) * 256 + rit : (lat ? CTXL + (jj - 1) * 256 + rit : rit);
                        const f32x4 c0 = *(const f32x4*)(ctab + (size_t)pos * 32), c1 = *(const f32x4*)(ctab + (size_t)pos * 32 + 4), s0 = *(const f32x4*)(stab + (size_t)pos * 32), s1 = *(const f32x4*)(stab + (size_t)pos * 32 + 4);
                        const f32x4 nx0 = x0 * c0 - y0 * s0, nx1 = x1 * c1 - y1 * s1, ny0 = x0 * s0 + y0 * c0, ny1 = x1 * s1 + y1 * c1;
                        x0 = nx0; x1 = nx1; y0 = ny0; y1 = ny1;
                    }
                    x0 = x0 * scale; x1 = x1 * scale; y0 = y0 * scale; y1 = y1 * scale;
                    bf16_t* rowp = O + (size_t)(u.pm * BM + rit) * PW + u.pn * BM + 64 * wc + 8 * fq;
                    u32x4 w; w.x = cvt_pk_bf16(x0[0], x0[1]); w.y = cvt_pk_bf16(x0[2], x0[3]); w.z = cvt_pk_bf16(x1[0], x1[1]); w.w = cvt_pk_bf16(x1[2], x1[3]); *(u32x4*)rowp = w;
                    u32x4 z; z.x = cvt_pk_bf16(y0[0], y0[1]); z.y = cvt_pk_bf16(y0[2], y0[3]); z.z = cvt_pk_bf16(y1[0], y1[1]); z.w = cvt_pk_bf16(y1[2], y1[3]); *(u32x4*)(rowp + 32) = z;
                    asm volatile("" ::: "memory"); }
            return;
        }
        const int row0 = u.pm * BM + wr * 64 + fr, col0 = u.pn * BM + wc * 32 + 8 * fq; const bool g = u.pn < 2, sg = u.pn >= 10;
        if (sg) {
            unsigned char* G8 = (unsigned char*)GT;
#pragma unroll
            for (int ai = 0; ai < 2; ++ai)
#pragma unroll
                for (int m = 0; m < 4; ++m) { u32x4 w;
#pragma unroll
                    for (int bj = 0; bj < 2; ++bj) { const f32x4 v0 = acc[ai][bj][m][0], v1 = acc[ai][bj][m][1]; unsigned lo = 0u, hi = 0u;
#pragma unroll
                        for (int e = 0; e < 4; ++e) { lo = __builtin_amdgcn_cvt_pk_u8_f32(sigm(v0[e]) * 255.f + 0.5f, e, lo); hi = __builtin_amdgcn_cvt_pk_u8_f32(sigm(v1[e]) * 255.f + 0.5f, e, hi); }
                        if (bj == 0) { w.x = lo; w.y = hi; } else { w.z = lo; w.w = hi; } }
                    const size_t blk = ((((size_t)(u.pm * 16 + (u.pn - 10)) * 2 + ai) * 4 + m) * 2 + wr) * 4 + wc; *(u32x4*)(G8 + blk * 1024 + lane * 16) = w;
                    asm volatile("" ::: "memory"); }
            return;
        }
#pragma unroll
        for (int ai = 0; ai < 2; ++ai)
#pragma unroll
            for (int m = 0; m < 4; ++m) { bf16_t* rowp = O + (size_t)(row0 + ai * HALF + m * 16) * PW + col0;
#pragma unroll
                for (int bj = 0; bj < 2; ++bj) { f32x4 v0 = acc[ai][bj][m][0], v1 = acc[ai][bj][m][1];
                    if (g) {
#pragma unroll
                        for (int e = 0; e < 4; ++e) { v0[e] = gelu_tanh(v0[e]); v1[e] = gelu_tanh(v1[e]); } }
                    u32x4 w; w.x = cvt_pk_bf16(v0[0], v0[1]); w.y = cvt_pk_bf16(v0[2], v0[3]); w.z = cvt_pk_bf16(v1[0], v1[1]); w.w = cvt_pk_bf16(v1[2], v1[3]);
                    *(u32x4*)(rowp + bj * HALF) = w; }
                asm volatile("" ::: "memory"); }
    }
};
struct EpiMerge {
    static constexpr bool PERM = true;
    bf16_t* P;
    DI void operator()(const f32x4 (&acc)[2][2][4][2], const Unit& u, int wr, int wc, int fr, int fq) const {
        const int row0 = u.pm * BM + wr * 64 + fr, col0 = C_GATE + u.pn * BM + wc * 32 + 8 * fq;
#pragma unroll
        for (int ai = 0; ai < 2; ++ai)
#pragma unroll
            for (int m = 0; m < 4; ++m) { bf16_t* rowp = P + (size_t)(row0 + ai * HALF + m * 16) * INW + col0;
#pragma unroll
                for (int bj = 0; bj < 2; ++bj)
#pragma unroll
                    for (int n = 0; n < 2; ++n) { const f32x4 v = acc[ai][bj][m][n];
                        const u32x2 gt = *(const u32x2*)(rowp + bj * HALF + 4 * n);
                        u32x2 w; w.x = cvt_pk_bf16(sigm(__uint_as_float(gt.x << 16)) * v[0], sigm(__uint_as_float(gt.x & 0xffff0000u)) * v[1]);
                        w.y = cvt_pk_bf16(sigm(__uint_as_float(gt.y << 16)) * v[2], sigm(__uint_as_float(gt.y & 0xffff0000u)) * v[3]);
                        *(u32x2*)(rowp + bj * HALF + 4 * n) = w; asm volatile("" ::: "memory"); }
                }
    }
};
struct EpiResid {
    static constexpr bool PERM = true;
    bf16_t* xs; const float* gate; bf16_t* part;
    DI void operator()(const f32x4 (&acc)[2][2][4][2], const Unit& u, int wr, int wc, int fr, int fq) const {
        asm volatile("" : "+v"(fr), "+v"(fq));
        const int col0 = u.pn * BM + wc * 32 + 8 * fq, r0 = wr * 64 + fr;
        if (u.part >= 0) {
            bf16_t* ps = part + ((size_t)(u.part * 2 + (u.pm != 0)) * 256) * DM;
#pragma unroll
            for (int ai = 0; ai < 2; ++ai)
#pragma unroll
                for (int m = 0; m < 4; ++m) { bf16_t* rowp = ps + (size_t)(r0 + ai * HALF + m * 16) * DM + col0;
#pragma unroll
                    for (int bj = 0; bj < 2; ++bj) { const f32x4 v0 = acc[ai][bj][m][0], v1 = acc[ai][bj][m][1];
                        u32x4 w; w.x = cvt_pk_bf16(v0[0], v0[1]); w.y = cvt_pk_bf16(v0[2], v0[3]); w.z = cvt_pk_bf16(v1[0], v1[1]); w.w = cvt_pk_bf16(v1[2], v1[3]); *(u32x4*)(rowp + bj * HALF) = w; } }
            return;
        }
        const int b = u.pm / 33, j = u.pm - b * 33;
        const float* gt = gate + (size_t)(j == 0 ? 2 : b) * 6144;
        bf16_t* xt = xs + (size_t)u.pm * BM * DM;
        f32x4 gq[2][2];
#pragma unroll
        for (int bj = 0; bj < 2; ++bj) { gq[bj][0] = *(const f32x4*)(gt + col0 + bj * HALF); gq[bj][1] = *(const f32x4*)(gt + col0 + bj * HALF + 4); }
#pragma unroll
        for (int ai = 0; ai < 2; ++ai) { u32x4 xq[4][2];
#pragma unroll
            for (int m = 0; m < 4; ++m)
#pragma unroll
                for (int bj = 0; bj < 2; ++bj) xq[m][bj] = *(const u32x4*)(xt + (size_t)(r0 + ai * HALF + m * 16) * DM + col0 + bj * HALF);
#pragma unroll
            for (int m = 0; m < 4; ++m) { const size_t off = (size_t)(r0 + ai * HALF + m * 16) * DM + col0;
#pragma unroll
                for (int bj = 0; bj < 2; ++bj) { const u32x4 q = xq[m][bj];
                    const f32x4 x0 = {__uint_as_float(q.x << 16), __uint_as_float(q.x & 0xffff0000u), __uint_as_float(q.y << 16), __uint_as_float(q.y & 0xffff0000u)};
                    const f32x4 x1 = {__uint_as_float(q.z << 16), __uint_as_float(q.z & 0xffff0000u), __uint_as_float(q.w << 16), __uint_as_float(q.w & 0xffff0000u)};
                    const f32x4 v0 = x0 + gq[bj][0] * acc[ai][bj][m][0], v1 = x1 + gq[bj][1] * acc[ai][bj][m][1];
                    u32x4 w; w.x = cvt_pk_bf16(v0[0], v0[1]); w.y = cvt_pk_bf16(v0[2], v0[3]); w.z = cvt_pk_bf16(v1[0], v1[1]); w.w = cvt_pk_bf16(v1[2], v1[3]); *(u32x4*)(xt + off + bj * HALF) = w; } }
            asm volatile("" ::: "memory"); }
    }
};
struct EpiSwiglu {
    static constexpr bool PERM = true;
    bf16_t* O; int ldo; int nNl;
    DI void operator()(const f32x4 (&acc)[2][2][4][2], const Unit& u, int wr, int wc, int fr, int fq) const {
        const int row0 = u.pm * BM + wr * 64 + fr, col0 = (u.pn % nNl) * HALF + wc * 32 + 8 * fq;
#pragma unroll
        for (int ai = 0; ai < 2; ++ai)
#pragma unroll
            for (int m = 0; m < 4; ++m) { bf16_t* rowp = O + (size_t)(row0 + ai * HALF + m * 16) * ldo + col0;
                const f32x4 a0 = acc[ai][0][m][0], a1 = acc[ai][0][m][1], b0 = acc[ai][1][m][0], b1 = acc[ai][1][m][1];
                u32x4 w; w.x = cvt_pk_bf16(siluf_(a0[0]) * b0[0], siluf_(a0[1]) * b0[1]); w.y = cvt_pk_bf16(siluf_(a0[2]) * b0[2], siluf_(a0[3]) * b0[3]);
                w.z = cvt_pk_bf16(siluf_(a1[0]) * b1[0], siluf_(a1[1]) * b1[1]); w.w = cvt_pk_bf16(siluf_(a1[2]) * b1[2], siluf_(a1[3]) * b1[3]);
                *(u32x4*)rowp = w; asm volatile("" ::: "memory"); }
    }
};
struct EpiMoe2 {
    static constexpr bool PERM = true;
    bf16_t* Y; const float* rowp; int nNl; bf16_t* YP;
    DI void operator()(const f32x4 (&acc)[2][2][4][2], const Unit& u, int wr, int wc, int fr, int fq) const {
        const int col0 = (u.pn % nNl) * BM + wc * 32 + 8 * fq, r0 = u.pm * BM + wr * 64 + fr;
        bf16_t* Yb = u.part < 0 ? Y : YP + ((size_t)u.part * MOE2_PROWS - (size_t)MOE2_FULL_RT * 256) * DM;
#pragma unroll
        for (int ai = 0; ai < 2; ++ai)
#pragma unroll
            for (int m = 0; m < 4; ++m) { const int r = r0 + ai * HALF + m * 16; const float pw = rowp[r]; bf16_t* rowq = Yb + (size_t)r * DM + col0;
#pragma unroll
                for (int bj = 0; bj < 2; ++bj) { const f32x4 v0 = acc[ai][bj][m][0] * pw, v1 = acc[ai][bj][m][1] * pw;
                    u32x4 w; w.x = cvt_pk_bf16(v0[0], v0[1]); w.y = cvt_pk_bf16(v0[2], v0[3]); w.z = cvt_pk_bf16(v1[0], v1[1]); w.w = cvt_pk_bf16(v1[2], v1[3]);
                    *(u32x4*)(rowq + bj * HALF) = w; }
                asm volatile("" ::: "memory"); }
    }
};

template <class Epi, class Sched>
DI void gemm_phase(LAS unsigned char* lds, const int tid, const Gemm g, const Sched& S, const Epi& E) {
    constexpr bool SP2 = true, ALIGN_EPI = true, GATHER = Sched::GATHER;
    const int wid = __builtin_amdgcn_readfirstlane(tid >> 6), lane = tid & 63, wr = wid >> 2, wc = wid & 3, fr = lane & 15, fq = lane >> 4;
    const int K = g.K, ntf = K / BK;
    unsigned voffA[2], voffB[2];
#pragma unroll
    for (int i = 0; i < 2; ++i) { int R, C; stage_rc(tid * 16 + i * 8192, R, C); const int Rb = Epi::PERM ? ((R & ~31) + perm32(R & 31)) : R;
        voffA[i] = (unsigned)(R * g.lda + C) * 2u; voffB[i] = (unsigned)(Rb * g.ldb + C) * 2u; }
    const size_t kstep = (size_t)(BK * 2);
    const size_t hstepA = GATHER ? 0 : (size_t)HALF * g.lda * 2, hstepB = (size_t)HALF * g.ldb * 2;
    const size_t tstepA = GATHER ? 0 : 2 * hstepA, tstepB = 2 * hstepB;
    unsigned gA0[2] = {0u, 0u}, gA1[2] = {0u, 0u}, nA0[2] = {0u, 0u}, nA1[2] = {0u, 0u}; int Rr[2] = {0, 0}; unsigned Cb[2] = {0u, 0u}; int ni0[2] = {0, 0}, ni1[2] = {0, 0};
    if constexpr (GATHER) {
#pragma unroll
        for (int i = 0; i < 2; ++i) { int R, C; stage_rc(tid * 16 + i * 8192, R, C); Rr[i] = R; Cb[i] = (unsigned)C * 2u; } }
#define PG8_TOKOFF(tok, i) ((unsigned)((tok) < 0 ? 0 : (tok)) * (unsigned)(g.lda * 2) + Cb[i])
    unsigned (&vA0)[2] = GATHER ? gA0 : voffA; unsigned (&vA1)[2] = GATHER ? gA1 : voffA;
    const unsigned ldsw = (unsigned)wid * 1024u;
    const int aoff = lds_byte(wr * 64 + fr, fq * 8), boff = lds_byte(wc * 32 + fr, fq * 8);
#define PG8_SA(b, h) (((b) * 2 + (h)) * HTB)
#define PG8_SB(b, h) ((4 + (b) * 2 + (h)) * HTB)
#define PG8_STAGE(bufoff, gbase, voff) do { _Pragma("unroll") for (int _i = 0; _i < 2; ++_i) \
        __builtin_amdgcn_global_load_lds((const unsigned*)((const char*)(gbase) + (voff)[_i]), (LAS unsigned*)(lds + (bufoff) + ldsw + _i * 8192), 16, 0, 0); } while (0)
#define PG8_LDA(dst, b, h) do { _Pragma("unroll") for (int m = 0; m < 4; ++m) _Pragma("unroll") for (int k = 0; k < 2; ++k) dst[m][k] = *(const LAS bf16x8*)(lds + PG8_SA(b, h) + aoff + m * 2048 + k * 1024); } while (0)
#define PG8_LDB(dst, b, h) do { _Pragma("unroll") for (int n = 0; n < 2; ++n) _Pragma("unroll") for (int k = 0; k < 2; ++k) dst[n][k] = *(const LAS bf16x8*)(lds + PG8_SB(b, h) + boff + n * 2048 + k * 1024); } while (0)
#define PG8_MMA(ai, bj, At, Bt) do { __builtin_amdgcn_s_setprio(1); _Pragma("unroll") for (int m = 0; m < 4; ++m) _Pragma("unroll") for (int n = 0; n < 2; ++n) _Pragma("unroll") for (int k = 0; k < 2; ++k) \
        acc[ai][bj][m][n] = __builtin_amdgcn_mfma_f32_16x16x32_bf16(Bt[n][k], At[m][k], acc[ai][bj][m][n], 0, 0, 0); __builtin_amdgcn_s_setprio(0); } while (0)
#define PG8_WAIT_V(n) asm volatile("s_waitcnt vmcnt(" #n ")" ::: "memory")
#define PG8_WAIT_L(n) asm volatile("s_waitcnt lgkmcnt(" #n ")" ::: "memory")
#define PG8_BAR __builtin_amdgcn_s_barrier()
#define PG8_SCHED __builtin_amdgcn_sched_barrier(0)
    Unit cur, nxt; int ui = 0;
    if (!S.next(0, cur)) return;
    f32x4 acc[2][2][4][2];
#pragma unroll
    for (int a = 0; a < 2; ++a)
#pragma unroll
        for (int b = 0; b < 2; ++b)
#pragma unroll
            for (int m = 0; m < 4; ++m)
#pragma unroll
                for (int n = 0; n < 2; ++n) acc[a][b][m][n] = (f32x4){0.f, 0.f, 0.f, 0.f};
    bf16x8 At[4][2], B0[2][2], B1[2][2];
    if constexpr (GATHER) {
#pragma unroll
        for (int i = 0; i < 2; ++i) { const int t0 = S.rowtok[cur.pm * BM + Rr[i]], t1 = S.rowtok[cur.pm * BM + HALF + Rr[i]]; gA0[i] = PG8_TOKOFF(t0, i); gA1[i] = PG8_TOKOFF(t1, i); } }
    const char* cA = (const char*)g.A + (size_t)cur.pm * tstepA + cur.aoff; const char* cB = (const char*)g.Bt + (size_t)cur.pn * tstepB + cur.boff;
    PG8_STAGE(PG8_SB(0, 0), cB, voffB); PG8_STAGE(PG8_SB(0, 1), cB + hstepB, voffB); PG8_STAGE(PG8_SA(0, 0), cA, vA0); PG8_STAGE(PG8_SA(0, 1), cA + hstepA, vA1);
    if (wr == 1) PG8_BAR;
    PG8_WAIT_V(2); PG8_BAR;
    PG8_STAGE(PG8_SB(1, 0), cB + kstep, voffB); PG8_STAGE(PG8_SA(1, 0), cA + kstep, vA0); PG8_STAGE(PG8_SB(1, 1), cB + hstepB + kstep, voffB);
    PG8_WAIT_V(6); PG8_BAR;
    for (;;) {
        const bool has_next = S.next(ui + 1, nxt);
        const char* nA = has_next ? (const char*)g.A + (size_t)nxt.pm * tstepA + nxt.aoff : cA; const char* nB = has_next ? (const char*)g.Bt + (size_t)nxt.pn * tstepB + nxt.boff : cB;
        const int nt = cur.nt ? cur.nt : ntf;
        if constexpr (GATHER) {
            const int pmn = has_next ? nxt.pm : cur.pm;
#pragma unroll
            for (int i = 0; i < 2; ++i) { const int* p0 = S.rowtok + pmn * BM + Rr[i];
                asm volatile("global_load_dword %0, %1, off" : "=v"(ni0[i]) : "v"(p0) : "memory"); asm volatile("global_load_dword %0, %1, off offset:512" : "=v"(ni1[i]) : "v"(p0) : "memory"); } }
        for (int t = 0; t < nt; t += 2) {
            const bool last = (t == nt - 2);
            unsigned sA0[2] = {0u, 0u}, sA1[2] = {0u, 0u};
            if constexpr (GATHER) {
#pragma unroll
                for (int i = 0; i < 2; ++i) { sA0[i] = last ? nA0[i] : gA0[i]; sA1[i] = last ? nA1[i] : gA1[i]; } }
            unsigned (&wA0)[2] = GATHER ? sA0 : voffA; unsigned (&wA1)[2] = GATHER ? sA1 : voffA;
            const char* a1 = cA + (size_t)(t + 1) * kstep;
            const char* a2 = last ? nA : cA + (size_t)(t + 2) * kstep; const char* b2 = last ? nB : cB + (size_t)(t + 2) * kstep;
            const char* a3 = a2 + kstep; const char* b3 = b2 + kstep;
            PG8_LDB(B0, 0, 0); PG8_LDB(B1, 0, 1); PG8_SCHED; PG8_LDA(At, 0, 0); PG8_STAGE(PG8_SA(1, 1), a1 + hstepA, vA1);
            PG8_WAIT_V(8); PG8_WAIT_L(0); PG8_BAR; PG8_MMA(0, 0, At, B0); PG8_MMA(0, 1, At, B1); PG8_BAR; PG8_SCHED;
            PG8_LDA(At, 0, 1); PG8_STAGE(PG8_SB(0, 0), b2, voffB); PG8_STAGE(PG8_SB(0, 1), b2 + hstepB, voffB); PG8_STAGE(PG8_SA(0, 0), a2, wA0);
            PG8_WAIT_V(8); PG8_WAIT_L(0); PG8_BAR; PG8_MMA(1, 0, At, B0); PG8_MMA(1, 1, At, B1); PG8_BAR; PG8_SCHED;
            if constexpr (GATHER) {
                asm volatile("" : "+v"(ni0[0]), "+v"(ni0[1]), "+v"(ni1[0]), "+v"(ni1[1]));
#pragma unroll
                for (int i = 0; i < 2; ++i) { nA0[i] = PG8_TOKOFF(ni0[i], i); nA1[i] = PG8_TOKOFF(ni1[i], i); } }
            PG8_LDB(B0, 1, 0); PG8_LDB(B1, 1, 1); PG8_SCHED; PG8_LDA(At, 1, 0); PG8_STAGE(PG8_SA(0, 1), a2 + hstepA, wA1);
            PG8_WAIT_V(8); PG8_WAIT_L(0); PG8_BAR; PG8_MMA(0, 0, At, B0); PG8_MMA(0, 1, At, B1); PG8_BAR; PG8_SCHED;
            PG8_LDA(At, 1, 1); PG8_STAGE(PG8_SB(1, 0), b3, voffB); PG8_STAGE(PG8_SB(1, 1), b3 + hstepB, voffB); PG8_STAGE(PG8_SA(1, 0), a3, wA0);
            PG8_WAIT_V(8); PG8_WAIT_L(0); PG8_BAR; PG8_MMA(1, 0, At, B0); PG8_MMA(1, 1, At, B1); PG8_BAR; PG8_SCHED;
        }
        if constexpr (ALIGN_EPI) { if (wr == 0) PG8_BAR; }
        E(acc, cur, wr, wc, fr, fq);
        if (!has_next) break;
#pragma unroll
        for (int a = 0; a < 2; ++a)
#pragma unroll
            for (int b = 0; b < 2; ++b)
#pragma unroll
                for (int m = 0; m < 4; ++m)
#pragma unroll
                    for (int n = 0; n < 2; ++n) acc[a][b][m][n] = (f32x4){0.f, 0.f, 0.f, 0.f};
        cur = nxt; cA = nA; cB = nB; ++ui;
        if constexpr (GATHER) {
#pragma unroll
            for (int i = 0; i < 2; ++i) { gA0[i] = nA0[i]; gA1[i] = nA1[i]; } }
        if constexpr (ALIGN_EPI) { if (wr == 1) PG8_BAR; }
    }
    PG8_WAIT_V(0);
    if constexpr (!ALIGN_EPI) { if (wr == 0) PG8_BAR; }
    PG8_BAR;
#undef PG8_TOKOFF
#undef PG8_SA
#undef PG8_SB
#undef PG8_STAGE
#undef PG8_LDA
#undef PG8_LDB
#undef PG8_MMA
#undef PG8_WAIT_V
#undef PG8_WAIT_L
#undef PG8_BAR
#undef PG8_SCHED
}
DI void gemm_merge_phase(LAS unsigned char* lds, const int tid, const Gemm g, const int G_, const int c_, const bf16_t* Pg, bf16_t* Out, const bool latOnly) {
    typedef EpiIn Epi;
    constexpr bool SP2 = true, ALIGN_EPI = true;
    const int wid = __builtin_amdgcn_readfirstlane(tid >> 6), lane = tid & 63, wr = wid >> 2, wc = wid & 3, fr = lane & 15, fq = lane >> 4;
    const int K = g.K, nt = K / BK;
    unsigned voffA[2], voffB[2];
#pragma unroll
    for (int i = 0; i < 2; ++i) { int R, C; stage_rc(tid * 16 + i * 8192, R, C); const int Rb = Epi::PERM ? ((R & ~31) + perm32(R & 31)) : R;
        voffA[i] = (unsigned)(R * g.lda + C) * 2u; voffB[i] = (unsigned)(Rb * g.ldb + C) * 2u; }
    const size_t kstep = (size_t)(BK * 2);
    const size_t hstepA = (size_t)HALF * g.lda * 2, hstepB = (size_t)HALF * g.ldb * 2;
    const size_t tstepA = 2 * hstepA, tstepB = 2 * hstepB;
    const unsigned ldsw = (unsigned)wid * 1024u;
    const int aoff = lds_byte(wr * 64 + fr, fq * 8), boff = lds_byte(wc * 32 + fr, fq * 8);
#define PG8_SA(b, h) (((b) * 2 + (h)) * HTB)
#define PG8_SB(b, h) ((4 + (b) * 2 + (h)) * HTB)
#define PG8_STAGE(bufoff, gbase, voff) do { _Pragma("unroll") for (int _i = 0; _i < 2; ++_i) \
        __builtin_amdgcn_global_load_lds((const unsigned*)((const char*)(gbase) + (voff)[_i]), (LAS unsigned*)(lds + (bufoff) + ldsw + _i * 8192), 16, 0, 0); } while (0)
#define PG8_LDA(dst, b, h) do { _Pragma("unroll") for (int m = 0; m < 4; ++m) _Pragma("unroll") for (int k = 0; k < 2; ++k) dst[m][k] = *(const LAS bf16x8*)(lds + PG8_SA(b, h) + aoff + m * 2048 + k * 1024); } while (0)
#define PG8_LDB(dst, b, h) do { _Pragma("unroll") for (int n = 0; n < 2; ++n) _Pragma("unroll") for (int k = 0; k < 2; ++k) dst[n][k] = *(const LAS bf16x8*)(lds + PG8_SB(b, h) + boff + n * 2048 + k * 1024); } while (0)
#define PG8_MMA(ai, bj, At, Bt) do { __builtin_amdgcn_s_setprio(1); _Pragma("unroll") for (int m = 0; m < 4; ++m) _Pragma("unroll") for (int n = 0; n < 2; ++n) _Pragma("unroll") for (int k = 0; k < 2; ++k) \
        acc[ai][bj][m][n] = __builtin_amdgcn_mfma_f32_16x16x32_bf16(Bt[n][k], At[m][k], acc[ai][bj][m][n], 0, 0, 0); __builtin_amdgcn_s_setprio(0); } while (0)
#define PG8_WAIT_V(n) asm volatile("s_waitcnt vmcnt(" #n ")" ::: "memory")
#define PG8_WAIT_L(n) asm volatile("s_waitcnt lgkmcnt(" #n ")" ::: "memory")
#define PG8_BAR __builtin_amdgcn_s_barrier()
#define PG8_SCHED __builtin_amdgcn_sched_barrier(0)
    struct MSched { int G, c; bool lo; DI bool next(int i, Unit& u) const { const int Lx = i * G + (i < 2 ? xcd_vc(G, c) : c); if (Lx >= (lo ? 64 : NTILE_M) * 8) return false; const int rh = Lx >> 2, pt = rh >> 1; unit_defaults(u); u.pm = lo ? pt + 1 + (pt >= 32) : pt; u.pn = Lx & 3; u.part = rh & 1; return true; } } S{G_, c_, latOnly};
    Unit cur, nxt; int ui = 0;
    if (!S.next(0, cur)) return;
    f32x4 acc[1][2][4][2], fin[2][4][2];
#pragma unroll
    for (int a = 0; a < 2; ++a)
#pragma unroll
        for (int m = 0; m < 4; ++m)
#pragma unroll
            for (int n = 0; n < 2; ++n) { acc[0][a][m][n] = (f32x4){0.f, 0.f, 0.f, 0.f}; fin[a][m][n] = (f32x4){0.f, 0.f, 0.f, 0.f}; }
    bf16x8 At[4][2], B0[2][2], B1[2][2]; u32x4 gt[4];
    const char* cA = (const char*)g.A + (size_t)cur.pm * tstepA + (size_t)cur.part * hstepA; const char* cB = (const char*)g.Bt + (size_t)cur.pn * tstepB;
    PG8_STAGE(PG8_SA(0, 0), cA, voffA); PG8_STAGE(PG8_SB(0, 0), cB, voffB); PG8_STAGE(PG8_SB(0, 1), cB + hstepB, voffB);
    if (wr == 1) PG8_BAR;
    PG8_WAIT_V(2); PG8_BAR;
    PG8_STAGE(PG8_SA(1, 0), cA + kstep, voffA); PG8_STAGE(PG8_SB(1, 0), cB + kstep, voffB);
    PG8_WAIT_V(4); PG8_BAR;
    for (;;) {
        const bool has_next = S.next(ui + 1, nxt);
        const char* nA = has_next ? (const char*)g.A + (size_t)nxt.pm * tstepA + (size_t)nxt.part * hstepA : cA; const char* nB = has_next ? (const char*)g.Bt + (size_t)nxt.pn * tstepB : cB;
        for (int tb = 0; tb < nt; tb += 4) {
#pragma unroll
            for (int hh = 0; hh < 2; ++hh) { const int t = tb + 2 * hh; const bool last = (t == nt - 2);
            if (hh == 1) {
                const int gtile = (tb >> 2) * 4 + cur.pn; int frl = fr, fql = fq; asm volatile("" : "+v"(frl), "+v"(fql));
#pragma unroll
                for (int mm = 0; mm < 4; ++mm) { const size_t blk = ((((size_t)(cur.pm * 16 + gtile) * 2 + cur.part) * 4 + mm) * 2 + wr) * 4 + wc; asm volatile("global_load_dwordx4 %0, %1, off" : "=v"(gt[mm]) : "v"((const unsigned char*)Pg + blk * 1024 + (fql * 16 + frl) * 16) : "memory"); }
            }
            const char* b1 = cB + (size_t)(t + 1) * kstep;
            const char* a2 = last ? nA : cA + (size_t)(t + 2) * kstep; const char* b2 = last ? nB : cB + (size_t)(t + 2) * kstep;
            const char* a3 = a2 + kstep; const char* b3 = b2 + kstep;
            PG8_LDA(At, 0, 0); PG8_SCHED; PG8_LDB(B0, 0, 0); PG8_STAGE(PG8_SB(1, 1), b1 + hstepB, voffB);
            PG8_WAIT_V(6); PG8_WAIT_L(0); PG8_BAR; PG8_MMA(0, 0, At, B0); PG8_BAR; PG8_SCHED;
            PG8_LDB(B1, 0, 1); PG8_STAGE(PG8_SA(0, 0), a2, voffA); PG8_STAGE(PG8_SB(0, 0), b2, voffB);
            PG8_WAIT_V(6); PG8_WAIT_L(0); PG8_BAR; PG8_MMA(0, 1, At, B1); PG8_BAR; PG8_SCHED;
            PG8_LDA(At, 1, 0); PG8_SCHED; PG8_LDB(B0, 1, 0); PG8_STAGE(PG8_SB(0, 1), b2 + hstepB, voffB);
            PG8_WAIT_V(6); PG8_WAIT_L(0); PG8_BAR; PG8_MMA(0, 0, At, B0); PG8_BAR; PG8_SCHED;
            PG8_LDB(B1, 1, 1); PG8_STAGE(PG8_SA(1, 0), a3, voffA); PG8_STAGE(PG8_SB(1, 0), b3, voffB);
            PG8_WAIT_V(6); PG8_WAIT_L(0); PG8_BAR; PG8_MMA(0, 1, At, B1); PG8_BAR; PG8_SCHED;
            }
            {
                asm volatile("s_waitcnt vmcnt(12)" : "+v"(gt[0]), "+v"(gt[1]), "+v"(gt[2]), "+v"(gt[3]) :: "memory");
#pragma unroll
                for (int mm = 0; mm < 4; ++mm) { const u32x4 q = gt[mm]; const unsigned qq[4] = {q.x, q.y, q.z, q.w};
#pragma unroll
                    for (int bj = 0; bj < 2; ++bj)
#pragma unroll
                        for (int n = 0; n < 2; ++n) { const unsigned w = qq[bj * 2 + n]; const f32x4 sv = {(float)(w & 0xffu), (float)((w >> 8) & 0xffu), (float)((w >> 16) & 0xffu), (float)(w >> 24)};
                            fin[bj][mm][n] += sv * acc[0][bj][mm][n]; acc[0][bj][mm][n] = (f32x4){0.f, 0.f, 0.f, 0.f}; } }
            }
        }
        if constexpr (ALIGN_EPI) { if (wr == 0) PG8_BAR; }
        { int frl = fr, fql = fq; asm volatile("" : "+v"(frl), "+v"(fql));
          bf16_t* op = Out + (size_t)(cur.pm * BM + cur.part * HALF + wr * 64 + frl) * DM + cur.pn * BM + wc * 32 + 8 * fql;
#pragma unroll
          for (int bj = 0; bj < 2; ++bj)
#pragma unroll
              for (int mm = 0; mm < 4; ++mm) { const f32x4 v0 = fin[bj][mm][0] * (1.f / 255.f), v1 = fin[bj][mm][1] * (1.f / 255.f);
                  u32x4 w; w.x = cvt_pk_bf16(v0[0], v0[1]); w.y = cvt_pk_bf16(v0[2], v0[3]); w.z = cvt_pk_bf16(v1[0], v1[1]); w.w = cvt_pk_bf16(v1[2], v1[3]);
                  *(u32x4*)(op + (size_t)(mm * 16) * DM + bj * HALF) = w; fin[bj][mm][0] = (f32x4){0.f, 0.f, 0.f, 0.f}; fin[bj][mm][1] = (f32x4){0.f, 0.f, 0.f, 0.f}; } }
        if (!has_next) break;
        cur = nxt; cA = nA; cB = nB; ++ui;
        if constexpr (ALIGN_EPI) { if (wr == 1) PG8_BAR; }
    }
    PG8_WAIT_V(0);
    if constexpr (!ALIGN_EPI) { if (wr == 0) PG8_BAR; }
    PG8_BAR;
#undef PG8_SA
#undef PG8_SB
#undef PG8_STAGE
#undef PG8_LDA
#undef PG8_LDB
#undef PG8_MMA
#undef PG8_WAIT_V
#undef PG8_WAIT_L
#undef PG8_BAR
#undef PG8_SCHED
}
}

#define XB_TMO      128
#define XB_XCNT(j)  (256  + 64 * (j))
#define XB_XSUB(j)  (1280 + 64 * (j))
#define XB_XGEN(j)  (2304 + 64 * (j))
#define XB_TOP      3328
#define XB_TOPGEN   3392
#define XCD_BAR_WORDS 3456
#define XB_SPIN_CAP (1u << 18)
DI unsigned xb_ld(unsigned* p)              { return __hip_atomic_load(p, __ATOMIC_RELAXED, __HIP_MEMORY_SCOPE_AGENT); }
DI unsigned xb_add(unsigned* p, unsigned v) { return __hip_atomic_fetch_add(p, v, __ATOMIC_RELAXED, __HIP_MEMORY_SCOPE_AGENT); }
DI unsigned xb_xcc_id() { return (unsigned)__builtin_amdgcn_s_getreg((3 << 11) | 20) & 0xFu; }
#define XB_SPIN(cond, bar) do { unsigned _sp = 0; while (cond) { __builtin_amdgcn_s_sleep(1); \
    if ((++_sp & 255u) == 0u) { if (xb_ld(&(bar)[XB_TMO])) break; if (_sp > XB_SPIN_CAP) { atomicAdd(&(bar)[XB_TMO], 1u); break; } } } } while (0)
struct XcdBarrier { unsigned* bar; unsigned x; volatile LAS unsigned* st; };
DI XcdBarrier xcd_barrier_post(unsigned* bar, volatile LAS unsigned* st) {
    XcdBarrier b; b.bar = bar; b.x = xb_xcc_id(); b.st = st;
    if (threadIdx.x == 0) (void)xb_add(&bar[XB_XCNT(b.x)], 1u);
    return b;
}
DI void xcd_barrier_complete(unsigned* bar, unsigned x, unsigned& nloc, unsigned& nx) {
    const unsigned G = gridDim.x * gridDim.y * gridDim.z;
    unsigned sum, cnt, mine, sp = 0u;
    for (;;) {
        sum = 0u; cnt = 0u; mine = 0u;
#pragma unroll
        for (unsigned j = 0; j < 16; ++j) { const unsigned c = xb_ld(&bar[XB_XCNT(j)]); sum += c; cnt += (c > 0u) ? 1u : 0u; mine = (j == x) ? c : mine; }
        if (sum == G) break;
        __builtin_amdgcn_s_sleep(1);
        if ((++sp & 255u) == 0u) { if (xb_ld(&bar[XB_TMO])) break; if (sp > XB_SPIN_CAP) { atomicAdd(&bar[XB_TMO], 1u); break; } }
    }
    nloc = mine > 0u ? mine : 1u; nx = cnt > 0u ? cnt : 1u;
}
__device__ __attribute__((noinline)) void xcd_barrier_fn(unsigned* bar_, unsigned x_, unsigned st_off, unsigned tid_) {
    XcdBarrier b; { const unsigned hi_ = (unsigned)__builtin_amdgcn_readfirstlane((int)((unsigned long long)bar_ >> 32)), lo_ = (unsigned)__builtin_amdgcn_readfirstlane((int)(unsigned)(unsigned long long)bar_);
      b.bar = (unsigned*)(((unsigned long long)hi_ << 32) | (unsigned long long)lo_); }
    b.x = (unsigned)__builtin_amdgcn_readfirstlane((int)x_); b.st = (volatile LAS unsigned*)(unsigned long long)(unsigned)__builtin_amdgcn_readfirstlane((int)st_off);
    asm volatile("s_waitcnt vmcnt(0)" ::: "memory");
    __syncthreads();
    if (tid_ == 0u) {
        unsigned* bar = b.bar;
        __builtin_amdgcn_s_waitcnt(0);
        unsigned nloc = b.st[0], nx = b.st[1];
        if (nloc == 0u) { xcd_barrier_complete(bar, b.x, nloc, nx); b.st[0] = nloc; b.st[1] = nx; }
        const unsigned old = xb_add(&bar[XB_XSUB(b.x)], 1u);
        const unsigned gen = old / nloc;
        if (old + 1u == (gen + 1u) * nloc) {
            __builtin_amdgcn_fence(__ATOMIC_RELEASE, "agent");
            asm volatile("s_waitcnt vmcnt(0)" ::: "memory");
            (void)xb_add(&bar[XB_TOP], 1u);
        }
        XB_SPIN(xb_ld(&bar[XB_TOP]) < (gen + 1u) * nx, bar);
        __builtin_amdgcn_fence(__ATOMIC_ACQUIRE, "agent");
        asm volatile("s_waitcnt vmcnt(0)" ::: "memory");
    }
    __syncthreads();
}

#include <hip/hip_bf16.h>
#include <cmath>
namespace attn_body {
using bf16=__hip_bfloat16;
using bf16x8=__attribute__((ext_vector_type(8)))short;
using s16x4=__attribute__((ext_vector_type(4)))short;
using f32x16=__attribute__((ext_vector_type(16)))float;
using u32x4=__attribute__((ext_vector_type(4)))unsigned;
constexpr int D=64,PQ=2560,PO=1024,TPBA=8448,NKT=TPBA/64;
constexpr int NW=8,QBLK=32,QB=QBLK*NW,KVBLK=64;
__device__ __forceinline__ int crow(int r,int hi){return (r&3)+8*(r>>2)+4*hi;}
#define SBAR() __builtin_amdgcn_sched_barrier(0)
__device__ __forceinline__ void cmask(f32x16&p0,f32x16&p1,int jb,int qrel,int hi){
  const float NEG=-INFINITY; int kb=64*jb+4*hi;
  #pragma unroll
  for(int r=0;r<16;++r){int kv=kb+(r&3)+8*(r>>2); if(kv>qrel)p0[r]=NEG; if(kv+32>qrel)p1[r]=NEG;}
}

constexpr int NSLOT=3, SLOTB=8192;
constexpr int LDS_K=0, LDS_V=NSLOT*SLOTB, LDS_WS=2*NSLOT*SLOTB, LDS_OST=LDS_WS+NW*64*4, LDS_BYTES=LDS_OST+NW*4096;
constexpr float C2=0.125f*1.4426950408889634f;
__device__ __forceinline__ void glds16(const void*gsrc,unsigned lds_dst){unsigned keep;
  asm volatile("s_mov_b32 %0, m0\n\ts_mov_b32 m0, %2\n\ts_nop 0\n\tglobal_load_lds_dwordx4 %1, off\n\ts_mov_b32 m0, %0":"=&s"(keep):"v"(gsrc),"s"(lds_dst):"memory");}
__device__ __forceinline__ float max3f(float a,float b,float c){float r;asm("v_max3_f32 %0, %1, %2, %3":"=v"(r):"v"(a),"v"(b),"v"(c));return r;}
__device__ __forceinline__ float max2f(float a,float b){float r;asm("v_max_f32_e32 %0, %1, %2":"=v"(r):"v"(a),"v"(b));return r;}
__device__ __forceinline__ float fadd_s(float a,float b){float r;asm("v_add_f32_e32 %0, %1, %2":"=v"(r):"v"(a),"v"(b));return r;}
__device__ __forceinline__ float fsub_s(float a,float b){float r;asm("v_sub_f32_e32 %0, %1, %2":"=v"(r):"v"(a),"v"(b));return r;}
typedef float f32x2_t __attribute__((ext_vector_type(2))); typedef __bf16 bf16x2_t __attribute__((ext_vector_type(2)));
__device__ __forceinline__ unsigned cvtpk_s(float lo,float hi){f32x2_t v={lo,hi};bf16x2_t b=__builtin_convertvector(v,bf16x2_t);return __builtin_bit_cast(unsigned,b);}
#define WAIT_BAR(N) asm volatile("s_waitcnt vmcnt(" #N ") lgkmcnt(0)\n\ts_barrier":::"memory")

__device__ __forceinline__ void qkt(f32x16&p0,f32x16&p1,const char*Kslot,const bf16x8*qr,const f32x16&negm,int r32,int hi){
  const char*kb=Kslot+hi*1024+r32*16;
  #pragma unroll
  for(int d0=0;d0<4;++d0){
    const bf16x8 b0=*reinterpret_cast<const bf16x8*>(kb+d0*2048);
    const bf16x8 b1=*reinterpret_cast<const bf16x8*>(kb+d0*2048+512);
    if(d0==0){p0=__builtin_amdgcn_mfma_f32_32x32x16_bf16(b0,qr[0],negm,0,0,0);p1=__builtin_amdgcn_mfma_f32_32x32x16_bf16(b1,qr[0],negm,0,0,0);}
    else{p0=__builtin_amdgcn_mfma_f32_32x32x16_bf16(b0,qr[d0],p0,0,0,0);p1=__builtin_amdgcn_mfma_f32_32x32x16_bf16(b1,qr[d0],p1,0,0,0);}}
}
typedef __attribute__((address_space(3))) const char* lds_cptr;
typedef short v4i16_t __attribute__((ext_vector_type(4)));
__device__ __forceinline__ void kload8(bf16x8*kf,lds_cptr kp){
  kf[0]=*(const __attribute__((address_space(3))) bf16x8*)(kp);      kf[1]=*(const __attribute__((address_space(3))) bf16x8*)(kp+512);
  kf[2]=*(const __attribute__((address_space(3))) bf16x8*)(kp+2048); kf[3]=*(const __attribute__((address_space(3))) bf16x8*)(kp+2560);
  kf[4]=*(const __attribute__((address_space(3))) bf16x8*)(kp+4096); kf[5]=*(const __attribute__((address_space(3))) bf16x8*)(kp+4608);
  kf[6]=*(const __attribute__((address_space(3))) bf16x8*)(kp+6144); kf[7]=*(const __attribute__((address_space(3))) bf16x8*)(kp+6656);
}
__device__ __forceinline__ void kload2(bf16x8*kf,lds_cptr kp,int j){ kf[2*j]=*(const __attribute__((address_space(3))) bf16x8*)(kp+j*2048); kf[2*j+1]=*(const __attribute__((address_space(3))) bf16x8*)(kp+j*2048+512); }
__device__ __forceinline__ s16x4 vtr(lds_cptr p){ return __builtin_bit_cast(s16x4,__builtin_amdgcn_ds_read_tr16_b64_v4i16((__attribute__((address_space(3))) v4i16_t*)p)); }
__device__ __forceinline__ float rowmax(const f32x16&p0,const f32x16&p1){
  float a=max3f(p0[0],p0[1],p1[0]),b=max3f(p0[2],p0[3],p1[1]);a=max3f(a,p1[2],p1[3]);
  #pragma unroll
  for(int r=4;r<16;r+=4){a=max3f(a,p0[r],p0[r+1]);b=max3f(b,p0[r+2],p0[r+3]);a=max3f(a,p1[r],p1[r+1]);b=max3f(b,p1[r+2],p1[r+3]);}
  const float m=max2f(a,b);
  auto rr=__builtin_amdgcn_permlane32_swap(__float_as_uint(m),__float_as_uint(m),false,false);
  return max2f(__uint_as_float(rr[0]),__uint_as_float(rr[1]));
}
__device__ __forceinline__ void pv(f32x16*o,int vb,bf16x8 pa0,bf16x8 pa1,bf16x8 pa2,bf16x8 pa3){
  #pragma unroll
  for(int d0=0;d0<2;++d0){s16x4 lo[4],hi[4];
    #pragma unroll
    for(int ks=0;ks<4;++ks){
      asm volatile("ds_read_b64_tr_b16 %0,%1 offset:%c2":"=&v"(lo[ks]):"v"(vb),"i"(d0*4096+ks*1024):"memory");
      asm volatile("ds_read_b64_tr_b16 %0,%1 offset:%c2":"=&v"(hi[ks]):"v"(vb),"i"(d0*4096+ks*1024+512):"memory");}
    asm volatile("s_waitcnt lgkmcnt(0)":::"memory");SBAR();
    #define PK(k) (bf16x8){lo[k][0],lo[k][1],lo[k][2],lo[k][3],hi[k][0],hi[k][1],hi[k][2],hi[k][3]}
    o[d0]=__builtin_amdgcn_mfma_f32_32x32x16_bf16(pa0,PK(0),o[d0],0,0,0);
    o[d0]=__builtin_amdgcn_mfma_f32_32x32x16_bf16(pa1,PK(1),o[d0],0,0,0);
    o[d0]=__builtin_amdgcn_mfma_f32_32x32x16_bf16(pa2,PK(2),o[d0],0,0,0);
    o[d0]=__builtin_amdgcn_mfma_f32_32x32x16_bf16(pa3,PK(3),o[d0],0,0,0);
    #undef PK
  }
}

#ifndef ATTN_STORE16
#define ATTN_STORE16(p,v) (*(u32x4*)(p)=(v))
#endif
template<int THRL> __device__ __forceinline__ void attn_unit(long qrow0,long krow0,int qcol,int kcol,int vcol,int ocol,const bf16*Pb,bf16*Ob,char*shm,const int tid,const float zf){
  const int lane=tid&63,r32=lane&31,hi=lane>>5; const int wid=__builtin_amdgcn_readfirstlane(tid>>6);
  const bf16*Qw=Pb+(qrow0+wid*QBLK)*PQ+qcol;
  const bf16*Kh=Pb+krow0*PQ+kcol,*Vh=Pb+krow0*PQ+vcol;
  const unsigned lds0=(unsigned)(uintptr_t)shm;
  float*wsf=(float*)(shm+LDS_WS)+wid*64;
  const bf16*ksrc=Kh+(long)lane*PQ+wid*8;
  const bf16*vsrc=Vh+(long)(16*(wid&3)+(lane>>2))*PQ+(wid>>2)*32+(lane&3)*8;
  const unsigned kdst=lds0+LDS_K+wid*1024, vdst=lds0+LDS_V+wid*1024;
  #define DMA_K(t,slot) glds16(ksrc+(long)(t)*KVBLK*PQ,(unsigned)__builtin_amdgcn_readfirstlane(kdst+(slot)))
  #define DMA_V(t,slot) glds16(vsrc+(long)(t)*KVBLK*PQ,(unsigned)__builtin_amdgcn_readfirstlane(vdst+(slot)))
  const int vb0=(int)(lds0+LDS_V)+((lane>>4)&1)*32+(lane&3)*8+(4*hi+((lane&15)>>2))*64;
  const char*Kbase=shm+LDS_K; bf16x8 kf[8];
  const lds_cptr shm3=(lds_cptr)shm; const lds_cptr kp0=shm3+LDS_K+hi*1024+r32*16; const lds_cptr vp0=shm3+LDS_V+((lane>>4)&1)*32+(lane&3)*8+(4*hi+((lane&15)>>2))*64;
  const int NT=NKT;
  DMA_K(0,0);DMA_V(0,0);DMA_K(1,SLOTB);
  bf16x8 qr[4];
  #pragma unroll
  for(int d0=0;d0<4;++d0)qr[d0]=*reinterpret_cast<const bf16x8*>(&Qw[(long)r32*PQ+d0*16+hi*8]);
  float mhat=0.f,l_reg=0.f;f32x16 o[2];f32x16 negm;
  _Pragma("unroll") for(int r=0;r<16;++r){o[0][r]=zf;o[1][r]=zf;negm[r]=zf;} asm volatile("":"+v"(negm));
  #define CMASK(P0,P1,t) do{}while(0)
  bool resc=false;
  #define START(P0,P1) do{ const float rm=rowmax(P0,P1); resc=false; \
    { const float dl=rm; mhat=fadd_s(mhat,dl); \
      _Pragma("unroll") for(int r=0;r<16;++r){P0[r]=fsub_s(P0[r],dl);P1[r]=fsub_s(P1[r],dl);} \
      _Pragma("unroll") for(int r=0;r<16;++r)negm[r]=-mhat; asm volatile("":"+v"(negm)); } \
    _Pragma("unroll") for(int r=0;r<16;++r)P0[r]=__builtin_amdgcn_exp2f(P0[r]); }while(0)
  #define RESC() do{ if(resc){ asm volatile("s_waitcnt lgkmcnt(0)":::"memory"); \
      _Pragma("unroll") for(int d_=0;d_<2;++d_) _Pragma("unroll") for(int r=0;r<16;++r)o[d_][r]*=wsf[crow(r,hi)]; } }while(0)
  f32x16 pA0,pA1,pB0,pB1;
  int sl_prev=0,sl_cur=0,sl_next=SLOTB;
  #define ROT() do{sl_prev=sl_cur;sl_cur=sl_next;sl_next=(sl_next==(NSLOT-1)*SLOTB)?0:sl_next+SLOTB;}while(0)
  DMA_K(2,2*SLOTB);
  WAIT_BAR(3);
  qkt(pA0,pA1,Kbase,qr,negm,r32,hi);asm volatile("s_nop 15\n\ts_nop 7":"+v"(pA0),"+v"(pA1));CMASK(pA0,pA1,0);
  START(pA0,pA1);
  _Pragma("unroll") for(int r=0;r<16;++r)pA1[r]=__builtin_amdgcn_exp2f(pA1[r]);
  WAIT_BAR(0);
  DMA_K(3,0);DMA_V(1,SLOTB);
  ROT();
  kload8(kf,kp0+sl_cur);
  WAIT_BAR(2);
  s16x4 vlo[8],vhi[8]; u32x4 pw0,pw1,pw2,pw3;
  #define PKW(P,B) cvtpk_s(P[B],P[B+1])
  #define PAF(k) __builtin_bit_cast(bf16x8,pw##k)
  #define VFR(i) (bf16x8){vlo[i][0],vlo[i][1],vlo[i][2],vlo[i][3],vhi[i][0],vhi[i][1],vhi[i][2],vhi[i][3]}
  #define PIN(x) asm volatile("":"+v"(x))
  #define MX3(a,b,c) __builtin_fmaxf(__builtin_fmaxf((a),(b)),(c))
  #define GAPA(MF,A0,A1,A2,A3,W0,W1,PW) do{ MF; sacc+=A0; sacc+=A1; sacc+=A2; sacc+=A3; PIN(sacc); W0; W1; PIN(PW); SBAR(); }while(0)
  #define EX(v) __builtin_amdgcn_exp2f(v)
  #define GAPB(MF,X,B) do{ MF; X[B]=EX(X[B]); X[B+1]=EX(X[B+1]); X[B+2]=EX(X[B+2]); X[B+3]=EX(X[B+3]); PIN(X); SBAR(); }while(0)
  #define VRD(i) do{ vlo[i]=vtr(vp_+(((i)>>2)*4096+((i)&3)*1024)); vhi[i]=vtr(vp_+(((i)>>2)*4096+((i)&3)*1024+512)); }while(0)
  #define KRD(G,j) do{ if(G){ kload2(kf,kp0+sl_next,j); SBAR(); } }while(0)
  #define STEP(C0,C1,P0,P1,t,GK,GV,GL) do{ SBAR(); \
    const lds_cptr vp_=vp0+sl_prev; \
    VRD(0); SBAR(); float sacc=(P0[0]+P0[1]); \
    GAPA(C0=__builtin_amdgcn_mfma_f32_32x32x16_bf16(kf[0],qr[0],negm,0,0,0), P0[2],P0[3],P0[4],P0[5],     pw0[0]=PKW(P0,0), pw0[1]=PKW(P0,2), pw0); \
    VRD(4); SBAR(); GAPA(C1=__builtin_amdgcn_mfma_f32_32x32x16_bf16(kf[1],qr[0],negm,0,0,0), P0[6],P0[7],P0[8],P0[9],     pw0[2]=PKW(P0,4), pw0[3]=PKW(P0,6), pw0); \
    VRD(1); SBAR(); GAPA(C0=__builtin_amdgcn_mfma_f32_32x32x16_bf16(kf[2],qr[1],C0,0,0,0),   P0[10],P0[11],P0[12],P0[13], pw1[0]=PKW(P0,8), pw1[1]=PKW(P0,10), pw1); \
    VRD(5); SBAR(); GAPA(C1=__builtin_amdgcn_mfma_f32_32x32x16_bf16(kf[3],qr[1],C1,0,0,0),   P0[14],P0[15],P1[0],P1[1],   pw1[2]=PKW(P0,12),pw1[3]=PKW(P0,14), pw1); \
    VRD(2); SBAR(); GAPA(C0=__builtin_amdgcn_mfma_f32_32x32x16_bf16(kf[4],qr[2],C0,0,0,0),   P1[2],P1[3],P1[4],P1[5],     pw2[0]=PKW(P1,0), pw2[1]=PKW(P1,2), pw2); \
    VRD(6); SBAR(); GAPA(C1=__builtin_amdgcn_mfma_f32_32x32x16_bf16(kf[5],qr[2],C1,0,0,0),   P1[6],P1[7],P1[8],P1[9],     pw2[2]=PKW(P1,4), pw2[3]=PKW(P1,6), pw2); \
    VRD(3); SBAR(); GAPA(C0=__builtin_amdgcn_mfma_f32_32x32x16_bf16(kf[6],qr[3],C0,0,0,0),   P1[10],P1[11],P1[12],P1[13], pw3[0]=PKW(P1,8), pw3[1]=PKW(P1,10), pw3); \
    VRD(7); SBAR(); GAPA(C1=__builtin_amdgcn_mfma_f32_32x32x16_bf16(kf[7],qr[3],C1,0,0,0),   P1[14],P1[15],0.f,0.f,       pw3[2]=PKW(P1,12),pw3[3]=PKW(P1,14), pw3); \
    l_reg+=sacc; \
    if(GK){DMA_K((t)+3,sl_cur);} if(GV){DMA_V((t)+1,sl_next);} \
    CMASK(C0,C1,t); \
    { float a=MX3(C0[0],C0[1],C1[0]),b=MX3(C0[2],C0[3],C1[1]); a=MX3(a,C1[2],C1[3]); \
      _Pragma("unroll") for(int r=4;r<16;r+=4){a=MX3(a,C0[r],C0[r+1]);b=MX3(b,C0[r+2],C0[r+3]);a=MX3(a,C1[r],C1[r+1]);b=MX3(b,C1[r+2],C1[r+3]);} \
      float rm=__builtin_fmaxf(a,b); { auto rr=__builtin_amdgcn_permlane32_swap(__float_as_uint(rm),__float_as_uint(rm),false,false); rm=__builtin_fmaxf(__uint_as_float(rr[0]),__uint_as_float(rr[1])); } \
      resc=false; \
      if(__builtin_expect(__any(rm>(float)THRL),0)){ const float dl=__builtin_fmaxf(rm,0.f); mhat+=dl; \
        _Pragma("unroll") for(int r=0;r<16;++r){C0[r]-=dl;C1[r]-=dl;} \
        _Pragma("unroll") for(int r=0;r<16;++r)negm[r]=-mhat; asm volatile("":"+v"(negm)); \
        const float f=__builtin_amdgcn_exp2f(-dl); l_reg*=f; if(hi==0)wsf[r32]=f; resc=true; } } \
    SBAR(); \
    GAPB(o[0]=__builtin_amdgcn_mfma_f32_32x32x16_bf16(PAF(0),VFR(0),o[0],0,0,0), C0,0); \
    GAPB(o[1]=__builtin_amdgcn_mfma_f32_32x32x16_bf16(PAF(0),VFR(4),o[1],0,0,0), C0,4); \
    KRD(GL,0); GAPB(o[0]=__builtin_amdgcn_mfma_f32_32x32x16_bf16(PAF(1),VFR(1),o[0],0,0,0), C0,8); \
    KRD(GL,1); GAPB(o[1]=__builtin_amdgcn_mfma_f32_32x32x16_bf16(PAF(1),VFR(5),o[1],0,0,0), C0,12); \
    KRD(GL,2); GAPB(o[0]=__builtin_amdgcn_mfma_f32_32x32x16_bf16(PAF(2),VFR(2),o[0],0,0,0), C1,0); \
    KRD(GL,3); GAPB(o[1]=__builtin_amdgcn_mfma_f32_32x32x16_bf16(PAF(2),VFR(6),o[1],0,0,0), C1,4); \
    GAPB(o[0]=__builtin_amdgcn_mfma_f32_32x32x16_bf16(PAF(3),VFR(3),o[0],0,0,0), C1,8); \
    GAPB(o[1]=__builtin_amdgcn_mfma_f32_32x32x16_bf16(PAF(3),VFR(7),o[1],0,0,0), C1,12); \
    }while(0)
  int t=1;
  #undef CMASK
  #define CMASK(P0,P1,t) do{}while(0)
  _Pragma("nounroll") for(;t+5<NT;t+=2){
    STEP(pB0,pB1,pA0,pA1,t,true,true,true);     WAIT_BAR(2); RESC(); ROT();
    STEP(pA0,pA1,pB0,pB1,t+1,true,true,true);   WAIT_BAR(2); RESC(); ROT();
  }
  #undef CMASK
  #define CMASK(P0,P1,t) do{}while(0)
  #define ENDW(tt) do{ if((tt)+3<NT){WAIT_BAR(2);} else if((tt)+2<NT){WAIT_BAR(1);} else {WAIT_BAR(0);} }while(0)
  _Pragma("nounroll") for(;t+1<NT;t+=2){
    STEP(pB0,pB1,pA0,pA1,t,(t+3<NT),(t+1<NT),(t+1<NT));       ENDW(t);   RESC(); ROT();
    STEP(pA0,pA1,pB0,pB1,t+1,(t+4<NT),(t+2<NT),(t+2<NT));     ENDW(t+1); RESC(); ROT();
  }
  STEP(pB0,pB1,pA0,pA1,NT-1,false,false,false); RESC();
  { float sacc=pB0[0]+pB0[1]; _Pragma("unroll") for(int r=2;r<16;++r)sacc+=pB0[r]; _Pragma("unroll") for(int r=0;r<16;++r)sacc+=pB1[r]; l_reg+=sacc;
    pw0=(u32x4){PKW(pB0,0),PKW(pB0,2),PKW(pB0,4),PKW(pB0,6)};pw1=(u32x4){PKW(pB0,8),PKW(pB0,10),PKW(pB0,12),PKW(pB0,14)};pw2=(u32x4){PKW(pB1,0),PKW(pB1,2),PKW(pB1,4),PKW(pB1,6)};pw3=(u32x4){PKW(pB1,8),PKW(pB1,10),PKW(pB1,12),PKW(pB1,14)};
    SBAR(); pv(o,vb0+sl_cur,PAF(0),PAF(1),PAF(2),PAF(3)); }
  #undef PKW
  #undef PAF
  #undef VFR
  #undef PIN
  #undef MX3
  #undef GAPA
  #undef GAPB
  #undef EX
  #undef VRD
  #undef KRD
  #undef STEP
  #undef ENDW
  {auto rr=__builtin_amdgcn_permlane32_swap(__float_as_uint(l_reg),__float_as_uint(l_reg),false,false);l_reg=__uint_as_float(rr[0])+__uint_as_float(rr[1]);}
  if(hi==0)wsf[32+r32]=l_reg;asm volatile("s_waitcnt lgkmcnt(0)":::"memory");
  float rli[16];
  #pragma unroll
  for(int r=0;r<16;++r)rli[r]=__builtin_amdgcn_rcpf(wsf[32+crow(r,hi)]);
  bf16*Ow=Ob+(qrow0+wid*QBLK)*PO+ocol;
  { bf16*stg=(bf16*)(shm+LDS_OST)+wid*2048;
    #pragma unroll
    for(int r=0;r<16;++r){const int orow=crow(r,hi);
      #pragma unroll
      for(int d0=0;d0<2;++d0)stg[orow*64+d0*32+r32]=__float2bfloat16(o[d0][r]*rli[r]);}
    asm volatile("s_waitcnt lgkmcnt(0)":::"memory");
    #pragma unroll
    for(int i=0;i<4;++i){const int row=i*8+(lane>>3),ch=lane&7; const u32x4 v=*(const u32x4*)(stg+row*64+ch*8); ATTN_STORE16(Ow+(long)row*PO+ch*8,v);} }
  asm volatile("s_waitcnt lgkmcnt(0)\n\ts_barrier":::"memory");
  #undef DMA_K
  #undef DMA_V
  #undef CMASK
  #undef START
  #undef RESC
  #undef ROT
}
constexpr int ATTN_LDS_BYTES=LDS_BYTES;
#undef SBAR
#undef WAIT_BAR
}

constexpr int NWAVES = 8, NTHREADS = 512;
constexpr int RING_BYTES = 131072, MISC_OFF = RING_BYTES + 320, LDS_BYTES = 147456;

struct Ctx {
    LAS unsigned char* lds; int tid, lane, wave, G, bid, z;
    float* out; unsigned char* ws;
};
#define WSP(T_, off) ((T_*)(C.ws + (off)))

DI float log2_sigmoid(float x) { return -log1pf(expf(-x)) * LOG2E; }
DI void phase_modgemv(const Params& a, const Ctx& C, int L, int skip) {
    if (skip >= C.G) skip = 0;
    if (C.bid < skip) return;
    const float* cvec = a.in[C.z + 1]; const float* cctx = a.in[C.z + 3]; const float* w_mod = a.in[C.z + 4] + (size_t)L * DM * 6144; const float* b_mod = a.in[C.z + 5] + L * 6144;
    float* mod = WSP(float, WS_MOD) + (size_t)L * 3 * 6144;
    LAS f32x4* red = (LAS f32x4*)C.lds;
    const int kq = C.lane >> 3, c4 = C.lane & 7, kb = C.wave * 128 + kq;
    for (int u = C.bid - skip; u < 192; u += C.G - skip) {
        const float* w = w_mod + (size_t)kb * 6144 + u * 32 + 4 * c4;
        f32x4 wv[16];
#pragma unroll
        for (int i = 0; i < 16; ++i) wv[i] = *(const f32x4*)(w + (size_t)(8 * i) * 6144);
        f32x4 a0 = {0.f, 0.f, 0.f, 0.f}, a1 = a0, a2 = a0;
#pragma unroll
        for (int i = 0; i < 16; ++i) { const int k = kb + 8 * i; a0 += wv[i] * siluf_(cvec[k]); a1 += wv[i] * siluf_(cvec[DM + k]); a2 += wv[i] * siluf_(cctx[k]); }
#pragma unroll
        for (int o = 8; o < 64; o <<= 1)
#pragma unroll
            for (int e = 0; e < 4; ++e) { a0[e] += shx(a0[e], o, C.lane); a1[e] += shx(a1[e], o, C.lane); a2[e] += shx(a2[e], o, C.lane); }
        if (kq == 0) { red[(C.wave * 3 + 0) * 8 + c4] = a0; red[(C.wave * 3 + 1) * 8 + c4] = a1; red[(C.wave * 3 + 2) * 8 + c4] = a2; }
        __syncthreads();
        if (C.tid < 24) { const int st = C.tid >> 3, cc = C.tid & 7; f32x4 sacc = {0.f, 0.f, 0.f, 0.f};
#pragma unroll
            for (int w8 = 0; w8 < 8; ++w8) sacc += red[(w8 * 3 + st) * 8 + cc];
            *(f32x4*)(mod + (size_t)st * 6144 + u * 32 + 4 * cc) = sacc + *(const f32x4*)(b_mod + u * 32 + 4 * cc); }
        __syncthreads();
    }
}
DI void phase_g0(const Params& a, const Ctx& C) {
    phase_modgemv(a, C, 0, 0);
    const int gt = C.bid * NTHREADS + C.tid, GT = C.G * NTHREADS;
    float* tab = WSP(float, WS_TAB);
    for (int i = gt; i < SEQ * 32; i += GT) { const int t = i >> 5, f = i & 31; const float pos = (f < 16) ? (float)(t >> 6) : (float)(t & 63);
        const float inv = exp2f(-(float)(f & 15) * (13.287712379549449f / 16.f)); const float ang = pos * inv; float s, c; sincosf(ang, &s, &c);
        tab[TAB_AXC / 4 + i] = c; tab[TAB_AXS / 4 + i] = s; }
    for (int i = gt; i < TPB * 32; i += GT) { const int p = i >> 5, f = i & 31;
        const float inv = exp2f(-(float)f * (13.287712379549449f / 32.f)); const float ang = (float)p * inv; float s, c; sincosf(ang, &s, &c);
        tab[TAB_SQC / 4 + i] = c; tab[TAB_SQS / 4 + i] = s; }
    if (gt < DEPTH * 8) WSP(float, WS_L2G)[gt] = log2_sigmoid(a.in[C.z + 17][gt]);
    const float* ws_in = a.in[C.z + 10]; bf16_t* wsb = WSP(bf16_t, WS_WSB);
    for (int i = gt; i < DEPTH * 4 * 128 * 128; i += GT) wsb[i] = (bf16_t)f2bf(ws_in[i]);
}

struct CvtJob { const float* W; bf16_t* WT; int K, N, mode, row_off, item, ldw, koff; };
DI int cvt_row0(const CvtJob& j, int n0) {
    return (j.mode == 0) ? j.row_off + n0 : (j.mode == 3) ? ((n0 >= 256 && n0 < 2304) ? (n0 & ~255) + 128 * ((n0 & 63) >> 5) + 32 * ((n0 & 255) >> 6) : n0)
                                          : j.row_off + 256 * (n0 >> 7) + (n0 & 127) + (j.mode == 2 ? 128 : 0);
}
DI void cvt_load(const CvtJob& j, int lane, f32x4 (&v)[8]) {
    const int nblk = j.N / 32, kb = j.item / nblk, nb = j.item - kb * nblk, k0 = 64 * kb, n0 = 32 * nb;
    const float* src = j.W + (size_t)(k0 + 2 * (lane >> 3)) * j.N + n0 + 4 * (lane & 7);
#pragma unroll
    for (int i = 0; i < 4; ++i) { v[2 * i] = *(const f32x4*)(src + (size_t)(16 * i) * j.N); v[2 * i + 1] = *(const f32x4*)(src + (size_t)(16 * i + 1) * j.N); }
}
DI void cvt_store(const CvtJob& j, int lane, const f32x4 (&v)[8], LAS unsigned* scr) {
    const int nblk = j.N / 32, kb = j.item / nblk, nb = j.item - kb * nblk, k0 = 64 * kb, n0 = 32 * nb;
#pragma unroll
    for (int i = 0; i < 4; ++i) { const int kp = (lane >> 3) + 8 * i, nn = 4 * (lane & 7);
#pragma unroll
        for (int e = 0; e < 4; ++e) scr[kp * 33 + nn + e] = pk2(v[2 * i][e], v[2 * i + 1][e]); }
    asm volatile("s_waitcnt lgkmcnt(0)" ::: "memory");
    const int r0 = cvt_row0(j, n0), c = lane & 7;
#pragma unroll
    for (int q = 0; q < 4; ++q) { const int n = (lane >> 3) + 8 * q; const LAS unsigned* sp = scr + (4 * c) * 33 + n;
        u32x4 o; o.x = sp[0]; o.y = sp[33]; o.z = sp[66]; o.w = sp[99];
        *(u32x4*)(j.WT + (size_t)(r0 + n) * j.ldw + j.koff + k0 + 8 * c) = o; }
    asm volatile("s_waitcnt lgkmcnt(0)" ::: "memory");
}
DI void phase_cvt(const Params& a, const Ctx& C, int L, int f_lo, int f_hi, int skip) {
    LAS unsigned* scr = (LAS unsigned*)(C.lds + C.wave * 16384);
    if (skip >= C.G) skip = 0;
    if (C.bid < skip) return;
    const int gw = (C.bid - skip) * NWAVES + C.wave, NGW = (C.G - skip) * NWAVES;
    const size_t wb = WS_W + (size_t)(L & 1) * W_BUF;
    bf16_t* win_t = WSP(bf16_t, wb + W_IN); bf16_t* wbr_t = WSP(bf16_t, wb + W_BR); bf16_t* wout_t = WSP(bf16_t, wb + W_OUT);
    bf16_t* w13_t = WSP(bf16_t, wb + W_13); bf16_t* w2_t = WSP(bf16_t, wb + W_2);
    const int jl = L >> 1; const bool moe = L & 1;
    constexpr int I_IN = 16 * 208, I_BR = 4 * 32, I_OUT = 16 * 32, I_F13 = 16 * 88, I_F2 = 44 * 32, I_M13 = 16 * 56, I_M2 = 28 * 32;
    const int nitems = I_IN + 4 * I_BR + I_OUT + (moe ? NEXP * (2 * I_M13 + I_M2) : 2 * I_F13 + I_F2);
    auto decode = [&](int it) -> CvtJob {
        int r = it;
        if (r < I_IN) return CvtJob{a.in[C.z + 8] + (size_t)L * DM * INW, win_t, DM, INW, 3, 0, r, DM, 0}; r -= I_IN;
        if (r < 4 * I_BR) { const int i = r / I_BR; return CvtJob{a.in[C.z + 19] + (size_t)(L * 4 + i) * 256 * DM, wbr_t, 256, DM, 0, 0, r - i * I_BR, DM, i * 256}; } r -= 4 * I_BR;
        if (r < I_OUT) return CvtJob{a.in[C.z + 20] + (size_t)L * DM * DM, wout_t, DM, DM, 0, 0, r, DM, 0}; r -= I_OUT;
        if (!moe) {
            if (r < I_F13) return CvtJob{a.in[C.z + 21] + (size_t)jl * DM * DFF, w13_t, DM, DFF, 1, 0, r, DM, 0}; r -= I_F13;
            if (r < I_F13) return CvtJob{a.in[C.z + 22] + (size_t)jl * DM * DFF, w13_t, DM, DFF, 2, 0, r, DM, 0}; r -= I_F13;
            return CvtJob{a.in[C.z + 23] + (size_t)jl * DFF * DM, w2_t, DFF, DM, 0, 0, r, DFF, 0};
        }
        const int e = r / (2 * I_M13 + I_M2); r -= e * (2 * I_M13 + I_M2);
        const size_t eo = (size_t)(jl * NEXP + e) * DM * DFE;
        if (r < I_M13) return CvtJob{a.in[C.z + 26] + eo, w13_t, DM, DFE, 1, e * 2 * DFE, r, DM, 0}; r -= I_M13;
        if (r < I_M13) return CvtJob{a.in[C.z + 27] + eo, w13_t, DM, DFE, 2, e * 2 * DFE, r, DM, 0}; r -= I_M13;
        return CvtJob{a.in[C.z + 28] + eo, w2_t, DFE, DM, 0, e * DM, r, DFE, 0};
    };
    const int it_lo = (int)((long)nitems * f_lo / 64), it_hi = (int)((long)nitems * f_hi / 64);
    for (int it = it_lo + gw; it < it_hi; it += 2 * NGW) {
        const bool two = it + NGW < it_hi;
        const CvtJob ja = decode(it), jb = decode(two ? it + NGW : it);
        f32x4 va[8], vb[8];
        cvt_load(ja, C.lane, va); cvt_load(jb, C.lane, vb);
        cvt_store(ja, C.lane, va, scr);
        if (two) cvt_store(jb, C.lane, vb, scr + 2048);
    }
}

DI void unpack8(const u32x4 q, f32x4& a, f32x4& b) {
    a = (f32x4){__uint_as_float(q.x << 16), __uint_as_float(q.x & 0xffff0000u), __uint_as_float(q.y << 16), __uint_as_float(q.y & 0xffff0000u)};
    b = (f32x4){__uint_as_float(q.z << 16), __uint_as_float(q.z & 0xffff0000u), __uint_as_float(q.w << 16), __uint_as_float(q.w & 0xffff0000u)};
}
DI u32x4 pack8(const f32x4 a, const f32x4 b) { return (u32x4){pk2(a[0], a[1]), pk2(a[2], a[3]), pk2(b[0], b[1]), pk2(b[2], b[3])}; }
DI void y2_add8(const bf16_t* Y, const bf16_t* YP, int row, int c, f32x4& a, f32x4& b) {
    if (row < MOE2_FULL_RT * 256) { f32x4 x, y; unpack8(*(const u32x4*)(Y + (size_t)row * DM + c), x, y); a += x; b += y; return; }
    u32x4 q[MOE2_NP];
#pragma unroll
    for (int p = 0; p < MOE2_NP; ++p) q[p] = *(const u32x4*)(YP + ((size_t)p * MOE2_PROWS + row - MOE2_FULL_RT * 256) * DM + c);
#pragma unroll
    for (int p = 0; p < MOE2_NP; ++p) { f32x4 x, y; unpack8(q[p], x, y); a += x; b += y; }
}
DI void y2_pair8(const bf16_t* Y, const bf16_t* YP, int r0, int r1, int c, f32x4& a, f32x4& b) {
    if (r0 < MOE2_FULL_RT * 256 && r1 < MOE2_FULL_RT * 256) { const u32x4 q0 = *(const u32x4*)(Y + (size_t)r0 * DM + c), q1 = *(const u32x4*)(Y + (size_t)r1 * DM + c);
        f32x4 x0, y0, x1, y1; unpack8(q0, x0, y0); unpack8(q1, x1, y1); a = x0 + x1; b = y0 + y1; return; }
    a = (f32x4){0.f, 0.f, 0.f, 0.f}; b = a; y2_add8(Y, YP, r0, c, a, b); y2_add8(Y, YP, r1, c, a, b);
}
template <bool ROUTE, bool COMB>
DI void norm_rows(const Params& a, const Ctx& C, int L, int which, const bool skipCtx, const int ctxNP, const float* ctxGate) {
    bf16_t* XS = WSP(bf16_t, WS_XS);
    const float* inLat = a.in[C.z + 0]; const float* inCtx = a.in[C.z + 2];
    const float* gn = a.in[C.z + (which ? 7 : 6)] + (size_t)L * DM;
    const float* mod = WSP(float, WS_MOD) + (size_t)L * 3 * 6144;
    bf16_t* H = WSP(bf16_t, WS_H);
    const float* rw = a.in[C.z + 24] + (size_t)(L >> 1) * DM * NEXP; const float* rb = a.in[C.z + 25] + (size_t)(L >> 1) * NEXP;
    int* rt_i = WSP(int, WS_ROUTE); float* rt_f = WSP(float, WS_ROUTE);
    const int lane = C.lane, gw = C.bid * NWAVES + C.wave, NGW = C.G * NWAVES;
#define NCOL(jj) (8 * lane + 512 * ((jj) >> 1) + 4 * ((jj) & 1))
    f32x4 gq[4];
#pragma unroll
    for (int jj = 0; jj < 4; ++jj) gq[jj] = *(const f32x4*)(gn + NCOL(jj));
    LAS f32x4* rwl = (LAS f32x4*)(C.lds + 1024);
    if (ROUTE) {
#pragma unroll
        for (int i = 0; i < 4; ++i) { const int idx = C.tid + NTHREADS * i, jq = idx >> 7, hf = (idx >> 6) & 1, l = idx & 63; const int col = 8 * l + 512 * (jq >> 3) + 4 * ((jq >> 2) & 1) + (jq & 3);
            rwl[idx] = *(const f32x4*)(rw + (size_t)col * 8 + 4 * hf); }
        __syncthreads();
    }
    const bool b5 = lane & 32, b4 = lane & 16, b3 = lane & 8;
    const bf16_t* Y = WSP(bf16_t, WS_HG); const float* modp = WSP(float, WS_MOD) + (size_t)(L - 1) * 3 * 6144 + 5 * DM;
    LAS int* lw = (LAS int*)C.lds;
    int wcnt[NEXP];
#pragma unroll
    for (int e = 0; e < NEXP; ++e) wcnt[e] = 0;
    f32x4 shc[4], scc[4]; int mrc = -1;
    const bool f32src = L == 0 && which == 0;
    u32x4 nq[2][2];
    int nrow[2][2];
    constexpr bool PREF = true;
    if (PREF && !f32src) {
#pragma unroll
        for (int k = 0; k < 2; ++k) { const int r = (gw + k * NGW < T) ? gw + k * NGW : gw;
#pragma unroll
            for (int j = 0; j < 2; ++j) nq[k][j] = *(const u32x4*)(XS + (size_t)r * DM + 8 * lane + 512 * j);
            if (COMB) { nrow[k][0] = rt_i[RT_POS + 2 * r]; nrow[k][1] = rt_i[RT_POS + 2 * r + 1]; } } }
    int se1 = 0, se2 = 0, sq1 = 0, sq2 = 0;
    for (int r0 = gw, it = 0; r0 < T; r0 += 2 * NGW, ++it) {
        const int r1 = r0 + NGW; const bool two = r1 < T; const int rr[2] = {r0, two ? r1 : r0};
        f32x4 v[2][4]; float ss[2]; int yrow[2][2];
#pragma unroll
        for (int k = 0; k < 2; ++k) { const int r = rr[k];
            if (f32src) { const float* xr = xrow_c(inLat, inCtx, r);
#pragma unroll
                for (int jj = 0; jj < 4; ++jj) v[k][jj] = *(const f32x4*)(xr + NCOL(jj));
#pragma unroll
                for (int j = 0; j < 2; ++j) *(u32x4*)(XS + (size_t)r * DM + 8 * lane + 512 * j) = pack8(v[k][2 * j], v[k][2 * j + 1]); }
            else {
#pragma unroll
                for (int j = 0; j < 2; ++j) unpack8(PREF ? nq[k][j] : *(const u32x4*)(XS + (size_t)r * DM + 8 * lane + 512 * j), v[k][2 * j], v[k][2 * j + 1]);
                if (COMB) { yrow[k][0] = nrow[k][0]; yrow[k][1] = nrow[k][1]; } } }
        if (PREF && !f32src && r0 + 2 * NGW < T) {
#pragma unroll
            for (int k = 0; k < 2; ++k) { const int rn = r0 + 2 * NGW, r = (rn + k * NGW < T) ? rn + k * NGW : rn;
#pragma unroll
                for (int j = 0; j < 2; ++j) nq[k][j] = *(const u32x4*)(XS + (size_t)r * DM + 8 * lane + 512 * j);
                if (COMB) { nrow[k][0] = rt_i[RT_POS + 2 * r]; nrow[k][1] = rt_i[RT_POS + 2 * r + 1]; } } }
        if (ctxNP) {
            const bf16_t* part = WSP(bf16_t, WS_BR);
#pragma unroll
            for (int k = 0; k < 2; ++k) { const int t = rr[k]; const int bb = t / TPB, pp = t - bb * TPB;
                if (pp < CTXL && (k == 0 || two)) {
                    f32x4 sum[4];
#pragma unroll
                    for (int jj = 0; jj < 4; ++jj) sum[jj] = (f32x4){0.f, 0.f, 0.f, 0.f};
                    constexpr int PIF = ROUTE ? 2 : 6;
                    for (int pc0 = 0; pc0 < ctxNP; pc0 += PIF) {
                        u32x4 tq[PIF][2];
#pragma unroll
                        for (int q = 0; q < PIF; ++q) { const int pc = pc0 + q < ctxNP ? pc0 + q : pc0; const bf16_t* pr = part + ((size_t)(pc * 2 + bb) * 256 + pp) * DM + 8 * lane;
#pragma unroll
                            for (int j = 0; j < 2; ++j) tq[q][j] = *(const u32x4*)(pr + 512 * j); }
#pragma unroll
                        for (int q = 0; q < PIF; ++q) if (pc0 + q < ctxNP) {
#pragma unroll
                            for (int j = 0; j < 2; ++j) { f32x4 x, y; unpack8(tq[q][j], x, y); sum[2 * j] += x; sum[2 * j + 1] += y; } } }
#pragma unroll
                    for (int jj = 0; jj < 4; ++jj) v[k][jj] += *(const f32x4*)(ctxGate + NCOL(jj)) * sum[jj];
#pragma unroll
                    for (int j = 0; j < 2; ++j) *(u32x4*)(XS + (size_t)t * DM + 8 * lane + 512 * j) = pack8(v[k][2 * j], v[k][2 * j + 1]); } }
        }
        if (COMB) {
#pragma unroll
            for (int k = 0; k < 2; ++k) { const int t = rr[k];
                const float* gt = modp + (size_t)modrow(t) * 6144;
#pragma unroll
                for (int j = 0; j < 2; ++j) { f32x4 ya, yb; const int c = 8 * lane + 512 * j;
                    y2_pair8(Y, WSP(bf16_t, WS_Y2P), yrow[k][0], yrow[k][1], c, ya, yb);
                    v[k][2 * j] += *(const f32x4*)(gt + c) * ya; v[k][2 * j + 1] += *(const f32x4*)(gt + c + 4) * yb;
                    if (k == 0 || two) *(u32x4*)(XS + (size_t)t * DM + c) = pack8(v[k][2 * j], v[k][2 * j + 1]); } }
        }
#pragma unroll
        for (int k = 0; k < 2; ++k) { float s = 0.f;
#pragma unroll
            for (int jj = 0; jj < 4; ++jj) s += (v[k][jj].x * v[k][jj].x + v[k][jj].y * v[k][jj].y) + (v[k][jj].z * v[k][jj].z + v[k][jj].w * v[k][jj].w);
            ss[k] = s; }
#pragma unroll
        for (int o = 1; o < 64; o <<= 1) { ss[0] += shx(ss[0], o, lane); ss[1] += shx(ss[1], o, lane); }
#pragma unroll
        for (int k = 0; k < 2; ++k) {
            if (k == 1 && !two) break;
            const int r = rr[k]; const int mr = modrow(r);
            if (skipCtx && mr == 2) continue;
            const float* shp = mod + (size_t)mr * 6144 + (which ? 3 : 0) * DM;
            if (mr != mrc) { mrc = mr;
#pragma unroll
                for (int jj = 0; jj < 4; ++jj) { shc[jj] = *(const f32x4*)(shp + NCOL(jj)); scc[jj] = *(const f32x4*)(shp + DM + NCOL(jj)); } }
            const float rs = __builtin_amdgcn_rsqf(ss[k] * (1.f / DM) + EPS);
            LAS f32x4* rwl_i = rwl; asm volatile("" : "+v"(rwl_i));
            float lg[8];
#pragma unroll
            for (int e = 0; e < 8; ++e) lg[e] = 0.f;
#pragma unroll
            for (int j = 0; j < 2; ++j) { f32x4 hp[2];
#pragma unroll
                for (int q2 = 0; q2 < 2; ++q2) { const int jj = 2 * j + q2; const int cc = 8 * lane + 512 * j + 4 * q2;
                    const f32x4 s4 = scc[jj], h4 = shc[jj];
                    const f32x4 h = v[k][jj] * rs * gq[jj] * (s4 + 1.f) + h4; hp[q2] = h;
                    if (ROUTE) {
#pragma unroll
                        for (int q = 0; q < 4; ++q) { const f32x4 w0 = rwl_i[((jj * 4 + q) * 2 + 0) * 64 + lane], w1 = rwl_i[((jj * 4 + q) * 2 + 1) * 64 + lane]; const float hv = h[q];
                            lg[0] += hv * w0.x; lg[1] += hv * w0.y; lg[2] += hv * w0.z; lg[3] += hv * w0.w; lg[4] += hv * w1.x; lg[5] += hv * w1.y; lg[6] += hv * w1.z; lg[7] += hv * w1.w; } } }
                *(u32x4*)(H + (size_t)r * DM + 8 * lane + 512 * j) = pack8(hp[0], hp[1]); }
            if (ROUTE) {
                float v4[4], v2[2], v1;
#pragma unroll
                for (int e = 0; e < 4; ++e) { const float keep = b5 ? lg[4 + e] : lg[e], send = b5 ? lg[e] : lg[4 + e]; v4[e] = keep + shx(send, 32, lane); }
#pragma unroll
                for (int e = 0; e < 2; ++e) { const float keep = b4 ? v4[2 + e] : v4[e], send = b4 ? v4[e] : v4[2 + e]; v2[e] = keep + shx(send, 16, lane); }
                { const float keep = b3 ? v2[1] : v2[0], send = b3 ? v2[0] : v2[1]; v1 = keep + shx(send, 8, lane); }
                v1 += shx(v1, 4, lane); v1 += shx(v1, 2, lane); v1 += shx(v1, 1, lane);
                float lf[8];
#pragma unroll
                for (int e = 0; e < 8; ++e) lf[e] = __int_as_float(__builtin_amdgcn_readlane(__float_as_int(v1), 8 * e)) + rb[e];
                int e1 = 0; float t1 = lf[0];
#pragma unroll
                for (int e = 1; e < 8; ++e) if (lf[e] > t1) { t1 = lf[e]; e1 = e; }
                int e2 = -1; float t2 = -3.0e38f;
#pragma unroll
                for (int e = 0; e < 8; ++e) if (e != e1 && lf[e] > t2) { t2 = lf[e]; e2 = e; }
                { int q1 = 0, q2 = 0;
#pragma unroll
                  for (int e = 0; e < NEXP; ++e) { if (e == e1) q1 = wcnt[e]; if (e == e2) q2 = wcnt[e]; }
                  if (lane == 2 * it + k) { se1 = e1; se2 = e2; sq1 = q1; sq2 = q2; } }
                if (lane == 0) { const float p1 = rcpf_(1.f + ex2((t2 - t1) * LOG2E));
                    rt_i[RT_E + 2 * r] = e1; rt_i[RT_E + 2 * r + 1] = e2;
                    rt_f[RT_PW + 2 * r] = p1; rt_f[RT_PW + 2 * r + 1] = 1.f - p1; }
#pragma unroll
                for (int e = 0; e < NEXP; ++e) wcnt[e] += (e == e1 || e == e2) ? 1 : 0;
            }
        }
    }
#undef NCOL
    if (ROUTE) {
        if (lane == 0) {
#pragma unroll
            for (int e = 0; e < NEXP; ++e) lw[C.wave * 8 + e] = wcnt[e]; }
        __syncthreads();
        int wb[NEXP];
#pragma unroll
        for (int e = 0; e < NEXP; ++e) { int acc = 0;
#pragma unroll
            for (int w = 0; w < NWAVES; ++w) acc += (w < C.wave) ? lw[w * 8 + e] : 0;
            wb[e] = acc; }
        if (C.tid < NEXP) { int tot = 0;
#pragma unroll
            for (int w = 0; w < NWAVES; ++w) tot += lw[w * 8 + C.tid];
            rt_i[RT_BLK + ((L >> 1) * 1024 + C.bid) * 8 + C.tid] = tot; }
        { const int r = gw + lane * NGW;
          if (r < T && !(skipCtx && modrow(r) == 2)) { int oa = 0, ob = 0;
#pragma unroll
            for (int e = 0; e < NEXP; ++e) { if (e == se1) oa = wb[e]; if (e == se2) ob = wb[e]; }
            rt_i[RT_POS + 2 * r] = sq1 + oa; rt_i[RT_POS + 2 * r + 1] = sq2 + ob; } }
    }
}
DI void phase_norm(const Params& a, const Ctx& C, int L, int which) {
    const bool skipCtx = which && (L == DEPTH - 1);
    const int ctxNP = which ? (L == DEPTH - 1 ? 0 : 4) : ((L & 1) ? 11 : 0);
    const float* ctxGate = WSP(float, WS_MOD) + (size_t)((which ? L : L - 1) * 3 + 2) * 6144 + (which ? 2 : 5) * DM;
    if (which && (L & 1)) norm_rows<true, false>(a, C, L, which, skipCtx, ctxNP, ctxGate);
    else if (!which && L > 0 && !(L & 1)) norm_rows<false, true>(a, C, L, which, false, 0, ctxGate);
    else norm_rows<false, false>(a, C, L, which, skipCtx, ctxNP, ctxGate);
}

DI void phase_prep(const Params& a, const Ctx& C, int L) {
    bf16_t* P = WSP(bf16_t, WS_P); bf16_t* VT = WSP(bf16_t, WS_VT);
    const float* tab = WSP(float, WS_TAB);
    const float* gvv = a.in[C.z + 9] + (size_t)L * 256; const float* wqn = a.in[C.z + 12] + L * 64; const float* wkn = a.in[C.z + 13] + L * 64; const float* gqn = a.in[C.z + 15] + L * 64; const float* gkn = a.in[C.z + 16] + L * 64;
    const int lane = C.lane, hs = lane >> 3, j = lane & 7, i0 = (8 * j) & 31; const bool hiH = j >= 4;
    for (int u = C.bid; u < T / 64; u += C.G) {
        const int row0 = u * 64;
        for (int rr = 0; rr < 8; ++rr) {
            const int r = row0 + C.wave * 8 + rr; const int b = r / TPB, p = r - b * TPB; const bool lat = p >= CTXL; const int t = p - CTXL;
            bf16_t* pr = P + (size_t)r * PW + C_V;
            u32x4 raws[4];
#pragma unroll
            for (int op = 0; op < 4; ++op) raws[op] = *(const u32x4*)(pr + 64 * (8 * op + hs) + 8 * j);
            const int ta = lat ? t : 0;
            const float* ca = tab + TAB_AXC / 4 + (size_t)ta * 32 + i0; const float* sa = tab + TAB_AXS / 4 + (size_t)ta * 32 + i0;
            const float* cs = tab + TAB_SQC / 4 + (size_t)p * 32 + i0; const float* sq = tab + TAB_SQS / 4 + (size_t)p * 32 + i0;
            const f32x4 tca0 = *(const f32x4*)ca, tca1 = *(const f32x4*)(ca + 4), tsa0 = *(const f32x4*)sa, tsa1 = *(const f32x4*)(sa + 4);
            const f32x4 tcs0 = *(const f32x4*)cs, tcs1 = *(const f32x4*)(cs + 4), tss0 = *(const f32x4*)sq, tss1 = *(const f32x4*)(sq + 4);
#pragma unroll
            for (int op = 0; op < 4; ++op) {
                const int H = 8 * op + hs;
                int kind; const float* g = gvv + 64 * (H & 3); float scale = 1.f;
                if (H < 4) kind = 1;
                else if (H < 8) { kind = 2; g = wqn; scale = QSCALE; }
                else if (H < 10) { kind = 2; g = wkn; }
                else if (H < 12) kind = 0;
                else if (H < 16) { kind = 2; g = gqn; scale = QSCALE; }
                else if (H < 18) { kind = 2; g = gkn; }
                else if (H < 20) kind = 0;
                else if (H < 24) kind = 3;
                else if (H < 28) { kind = 3; scale = 0.125f; }
                else kind = 0;
                const u32x4 raw = raws[op];
                float x[8]; x[0] = __uint_as_float(raw.x << 16); x[1] = __uint_as_float(raw.x & 0xffff0000u); x[2] = __uint_as_float(raw.y << 16); x[3] = __uint_as_float(raw.y & 0xffff0000u);
                x[4] = __uint_as_float(raw.z << 16); x[5] = __uint_as_float(raw.z & 0xffff0000u); x[6] = __uint_as_float(raw.w << 16); x[7] = __uint_as_float(raw.w & 0xffff0000u);
                if (kind == 1 || kind == 2) {
                    float ss = 0.f;
#pragma unroll
                    for (int e = 0; e < 8; ++e) ss += x[e] * x[e];
                    ss += shx(ss, 1, lane); ss += shx(ss, 2, lane); ss += shx(ss, 4, lane);
                    const float rs = __builtin_amdgcn_rsqf(ss * (1.f / 64.f) + EPS);
                    const f32x4 g0 = *(const f32x4*)(g + 8 * j), g1 = *(const f32x4*)(g + 8 * j + 4);
                    x[0] *= rs * g0[0]; x[1] *= rs * g0[1]; x[2] *= rs * g0[2]; x[3] *= rs * g0[3]; x[4] *= rs * g1[0]; x[5] *= rs * g1[1]; x[6] *= rs * g1[2]; x[7] *= rs * g1[3];
                }
                float o[8];
#pragma unroll
                for (int e = 0; e < 8; ++e) o[e] = shx(x[e], 4, lane);
                if ((kind == 2 && lat) || kind == 3) {
                    const bool ax = kind == 2;
                    const f32x4 c0 = ax ? tca0 : tcs0, c1 = ax ? tca1 : tcs1, s0 = ax ? tsa0 : tss0, s1 = ax ? tsa1 : tss1;
                    const float cc[8] = {c0[0], c0[1], c0[2], c0[3], c1[0], c1[1], c1[2], c1[3]}, sn[8] = {s0[0], s0[1], s0[2], s0[3], s1[0], s1[1], s1[2], s1[3]};
#pragma unroll
                    for (int e = 0; e < 8; ++e) x[e] = hiH ? (o[e] * sn[e] + x[e] * cc[e]) : (x[e] * cc[e] - o[e] * sn[e]);
                }
                if (kind != 0) { u32x4 w; w.x = pk2(x[0] * scale, x[1] * scale); w.y = pk2(x[2] * scale, x[3] * scale); w.z = pk2(x[4] * scale, x[5] * scale); w.w = pk2(x[6] * scale, x[7] * scale);
                    *(u32x4*)(pr + 64 * H + 8 * j) = w; }
            }
        }
        { const int hh = C.tid >> 7, d = (C.tid >> 1) & 63, tg = C.tid & 1; const int kind = hh >> 1, kvh = hh & 1;
          const int b = row0 / TPB, p0 = row0 - b * TPB + 32 * tg; const int col = (kind ? C_GV : C_WV) + 64 * kvh + d;
          const bf16_t* src = P + (size_t)(row0 + 32 * tg) * PW + col;
          bf16_t* dst = VT + ((size_t)((kind * 2 + b) * 2 + kvh) * 64 + d) * TPB + p0;
#pragma unroll
          for (int q = 0; q < 4; ++q) { unsigned w[4];
#pragma unroll
              for (int e = 0; e < 4; ++e) { const unsigned lo = src[(size_t)(8 * q + 2 * e) * PW], hi = src[(size_t)(8 * q + 2 * e + 1) * PW]; w[e] = lo | (hi << 16); }
              *(u32x4*)(dst + 8 * q) = (u32x4){w[0], w[1], w[2], w[3]}; } }
    }
}

DI void mixA_pair(const Params& a, const Ctx& C, int L, int uidx) {
    const bf16_t* P = WSP(bf16_t, WS_P); bf16_t* BR = WSP(bf16_t, WS_BR);
    const int half = C.wave >> 2, w4 = C.wave & 3, t256 = C.tid & 255;
    const int un = (2 * uidx + half < 528) ? 2 * uidx + half : 527; const int cg = un >> 2, g = un & 3;
    const bf16_t* W = WSP(bf16_t, WS_WSB) + (size_t)(L * 4 + g) * 128 * 128; const float* bs = a.in[C.z + 11] + (size_t)(L * 4 + g) * 128;
    LAS bf16_t* vnT = (LAS bf16_t*)C.lds + half * 64 * 136;
    const int row0 = cg * 128, lane = C.lane, l15 = lane & 15, quad = lane >> 4;
    u32x4 vq[4];
#pragma unroll
    for (int it = 0; it < 4; ++it) { const int idx = t256 + 256 * it, j = idx >> 3, ch = idx & 7; vq[it] = *(const u32x4*)(P + (size_t)(row0 + j) * PW + C_V + 64 * g + 8 * ch); }
    u32x2 uq[2][4]; float bsv[2];
#pragma unroll
    for (int mt = 0; mt < 2; ++mt) { const int iw = 32 * w4 + 16 * mt + l15; bsv[mt] = bs[iw];
#pragma unroll
        for (int dt = 0; dt < 4; ++dt) uq[mt][dt] = *(const u32x2*)(P + (size_t)(row0 + iw) * PW + C_U + 64 * g + 16 * dt + 4 * quad); }
#pragma unroll
    for (int it = 0; it < 4; ++it) { const int idx = t256 + 256 * it, j = idx >> 3, ch = idx & 7; const unsigned w[4] = {vq[it].x, vq[it].y, vq[it].z, vq[it].w};
#pragma unroll
        for (int e = 0; e < 4; ++e) { vnT[(8 * ch + 2 * e) * 136 + j] = (bf16_t)(w[e] & 0xffffu); vnT[(8 * ch + 2 * e + 1) * 136 + j] = (bf16_t)(w[e] >> 16); } }
    __syncthreads();
#pragma unroll
    for (int mt = 0; mt < 2; ++mt) { const int iw = 32 * w4 + 16 * mt + l15;
        f32x4 acc[4];
#pragma unroll
        for (int dt = 0; dt < 4; ++dt) acc[dt] = (f32x4){0.f, 0.f, 0.f, 0.f};
#pragma unroll
        for (int ks = 0; ks < 4; ++ks) { const bf16x8 bw = *(const bf16x8*)(W + (size_t)iw * 128 + 32 * ks + 8 * quad);
#pragma unroll
            for (int dt = 0; dt < 4; ++dt) { const bf16x8 av = *(const LAS bf16x8*)(vnT + (16 * dt + l15) * 136 + 32 * ks + 8 * quad); acc[dt] = MFMA16(av, bw, acc[dt]); } }
#pragma unroll
        for (int dt = 0; dt < 4; ++dt) { const u32x2 uu = uq[mt][dt];
            const float o0 = __uint_as_float(uu.x << 16) * (acc[dt][0] + bsv[mt]), o1 = __uint_as_float(uu.x & 0xffff0000u) * (acc[dt][1] + bsv[mt]);
            const float o2 = __uint_as_float(uu.y << 16) * (acc[dt][2] + bsv[mt]), o3 = __uint_as_float(uu.y & 0xffff0000u) * (acc[dt][3] + bsv[mt]);
            u32x2 w; w.x = pk2(o0, o1); w.y = pk2(o2, o3); *(u32x2*)(BR + (size_t)(row0 + iw) * DM + 64 * g + 16 * dt + 4 * quad) = w; } }
    __syncthreads();
}

DI void attn_unit(const Params& a, const Ctx& C, int L, int kind, int b, int kvh, int qrow0, int ntile0, int krow0, int ntile1, int krow1, bool masked, bool has_sink) {
    const bf16_t* P = WSP(bf16_t, WS_P); bf16_t* BR = WSP(bf16_t, WS_BR);
    const int Qcol = kind ? C_GQ : C_WQ, Kcol = (kind ? C_GK : C_WK) + 64 * kvh, Vcol = (kind ? C_GV : C_WV) + 64 * kvh, Ocol = kind ? 512 : 256;
    LAS bf16_t* Kb = (LAS bf16_t*)C.lds;
    LAS bf16_t* Vb = (LAS bf16_t*)(C.lds + 2 * 64 * 144);
    const int lane = C.lane, r32 = lane & 31, hi = lane >> 5, w = C.wave, hq = 2 * kvh + (w >> 2);
    const int q = qrow0 + 32 * (w & 3) + r32;
    bf16x8 qr[4];
#pragma unroll
    for (int d0 = 0; d0 < 4; ++d0) qr[d0] = *(const bf16x8*)(P + (size_t)q * PW + Qcol + 64 * hq + 16 * d0 + 8 * hi);
    float m = has_sink ? a.in[C.z + 14][L * 4 + hq] * LOG2E : 0.f, l = (has_sink && hi == 0) ? 1.f : 0.f;
    f32x16 o0, o1, negm;
#pragma unroll
    for (int i = 0; i < 16; ++i) { o0[i] = 0.f; o1[i] = 0.f; negm[i] = -m; }
    const int nt = ntile0 + ntile1; const int lr = C.tid >> 3, lc = C.tid & 7;
    const int qpos = q - (b * TPB + CTXL);
#define VT_STORE2(buf, vr) do { const unsigned vw_[4] = {vr.x, vr.y, vr.z, vr.w}; _Pragma("unroll") for (int e_ = 0; e_ < 4; ++e_) { (buf)[(8 * lc + 2 * e_) * 72 + lr] = (bf16_t)(vw_[e_] & 0xffffu); (buf)[(8 * lc + 2 * e_ + 1) * 72 + lr] = (bf16_t)(vw_[e_] >> 16); } } while (0)
#define TILE_ROW(tn) ((tn) < ntile0 ? krow0 + 64 * (tn) : krow1 + 64 * ((tn) - ntile0))
#define TILE_LOAD(kr_, kq, vq) do { kq = *(const u32x4*)(P + (size_t)((kr_) + lr) * PW + Kcol + 8 * lc); vq = *(const u32x4*)(P + (size_t)((kr_) + lr) * PW + Vcol + 8 * lc); } while (0)
    u32x4 kA, vA, kB, vB;
    TILE_LOAD(TILE_ROW(0), kA, vA); TILE_LOAD(TILE_ROW(1), kB, vB);
    *(LAS u32x4*)(Kb + lr * 72 + 8 * lc) = kA; VT_STORE2(Vb, vA);
    __syncthreads();
    const int qlo = qrow0 + 32 * (w & 3) - (b * TPB + CTXL);
    auto tile = [&](const int t, const LAS bf16_t* Kc, const LAS bf16_t* Vc) {
        const int kt0 = krow1 + 64 * (t - ntile0) - (b * TPB + CTXL);
        const bool need_mask = masked && t >= ntile0 && !(kt0 >= qlo + 31 - 128 && kt0 + 63 <= qlo + 128);
        f32x16 p0, p1;
#pragma unroll
        for (int d0 = 0; d0 < 4; ++d0) { const bf16x8 k0 = *(const LAS bf16x8*)(Kc + r32 * 72 + 16 * d0 + 8 * hi), k1 = *(const LAS bf16x8*)(Kc + (32 + r32) * 72 + 16 * d0 + 8 * hi);
            if (d0 == 0) { p0 = MFMA32(k0, qr[0], negm); p1 = MFMA32(k1, qr[0], negm); } else { p0 = MFMA32(k0, qr[d0], p0); p1 = MFMA32(k1, qr[d0], p1); } }
        if (need_mask) { const int kp0 = kt0;
#pragma unroll
            for (int i = 0; i < 16; ++i) { const int kp = kp0 + crow(i, hi); int d = qpos - kp; d = d < 0 ? -d : d; if (d > 128) p0[i] = -1e30f; int d2 = qpos - (kp + 32); d2 = d2 < 0 ? -d2 : d2; if (d2 > 128) p1[i] = -1e30f; } }
        float mx = p0[0];
#pragma unroll
        for (int i = 1; i < 16; ++i) mx = fmaxf(mx, p0[i]);
#pragma unroll
        for (int i = 0; i < 16; ++i) mx = fmaxf(mx, p1[i]);
        mx = fmaxf(mx, shx(mx, 32, lane));
        const float dm = (!has_sink && t == 0) ? mx : ((mx > 8.f) ? mx : 0.f);
        if (__builtin_amdgcn_ballot_w64(dm != 0.f) != 0ull) { const float alpha = ex2(-dm); m += dm; l *= alpha;
#pragma unroll
            for (int i = 0; i < 16; ++i) { o0[i] *= alpha; o1[i] *= alpha; p0[i] -= dm; p1[i] -= dm; negm[i] = -m; } }
        float ps = 0.f;
#pragma unroll
        for (int i = 0; i < 16; ++i) { p0[i] = ex2(p0[i]); p1[i] = ex2(p1[i]); ps += p0[i] + p1[i]; }
        l += ps;
        bf16x8 pw[4];
        { u32x4 t0 = {pk2(p0[0], p0[1]), pk2(p0[2], p0[3]), pk2(p0[4], p0[5]), pk2(p0[6], p0[7])}; pw[0] = __builtin_bit_cast(bf16x8, t0);
          u32x4 t1 = {pk2(p0[8], p0[9]), pk2(p0[10], p0[11]), pk2(p0[12], p0[13]), pk2(p0[14], p0[15])}; pw[1] = __builtin_bit_cast(bf16x8, t1);
          u32x4 t2 = {pk2(p1[0], p1[1]), pk2(p1[2], p1[3]), pk2(p1[4], p1[5]), pk2(p1[6], p1[7])}; pw[2] = __builtin_bit_cast(bf16x8, t2);
          u32x4 t3 = {pk2(p1[8], p1[9]), pk2(p1[10], p1[11]), pk2(p1[12], p1[13]), pk2(p1[14], p1[15])}; pw[3] = __builtin_bit_cast(bf16x8, t3); }
#pragma unroll
        for (int s = 0; s < 4; ++s) {
            const u32x2 a0 = *(const LAS u32x2*)(Vc + r32 * 72 + 16 * s + 4 * hi), a1 = *(const LAS u32x2*)(Vc + r32 * 72 + 16 * s + 8 + 4 * hi);
            const u32x2 c0 = *(const LAS u32x2*)(Vc + (32 + r32) * 72 + 16 * s + 4 * hi), c1 = *(const LAS u32x2*)(Vc + (32 + r32) * 72 + 16 * s + 8 + 4 * hi);
            const u32x4 va = {a0.x, a0.y, a1.x, a1.y}, vc = {c0.x, c0.y, c1.x, c1.y};
            o0 = MFMA32(__builtin_bit_cast(bf16x8, va), pw[s], o0); o1 = MFMA32(__builtin_bit_cast(bf16x8, vc), pw[s], o1); }
    };
    for (int t = 0; t < nt; t += 2) {
        if (t + 2 < nt) TILE_LOAD(TILE_ROW(t + 2), kA, vA);
        tile(t, Kb, Vb);
        *(LAS u32x4*)(Kb + 64 * 72 + lr * 72 + 8 * lc) = kB; VT_STORE2(Vb + 64 * 72, vB);
        __syncthreads();
        if (t + 3 < nt) TILE_LOAD(TILE_ROW(t + 3), kB, vB);
        tile(t + 1, Kb + 64 * 72, Vb + 64 * 72);
        if (t + 2 < nt) { *(LAS u32x4*)(Kb + lr * 72 + 8 * lc) = kA; VT_STORE2(Vb, vA); }
        __syncthreads();
    }
#undef VT_STORE2
#undef TILE_ROW
#undef TILE_LOAD
    l += shx(l, 32, lane);
    const float inv = rcpf_(l);
    bf16_t* orow = BR + (size_t)q * DM + Ocol + 64 * hq;
#pragma unroll
    for (int g = 0; g < 4; ++g) { const int d = 8 * g + 4 * hi;
        u32x2 w0 = {pk2(o0[4 * g] * inv, o0[4 * g + 1] * inv), pk2(o0[4 * g + 2] * inv, o0[4 * g + 3] * inv)}; *(u32x2*)(orow + d) = w0;
        u32x2 w1 = {pk2(o1[4 * g] * inv, o1[4 * g + 1] * inv), pk2(o1[4 * g + 2] * inv, o1[4 * g + 3] * inv)}; *(u32x2*)(orow + 32 + d) = w1; }
}

DI void ret_kv_pair(const Params& a, const Ctx& C, int L, int uidx) {
    const bf16_t* P = WSP(bf16_t, WS_P); float* KVT = WSP(float, WS_KVT);
    const int half = C.wave >> 2, w4 = C.wave & 3, t256 = C.tid & 255;
    const int un = (2 * uidx + half < 528) ? 2 * uidx + half : 527; const int cg = un >> 2, h = un & 3;
    const float l2f = WSP(float, WS_L2G)[(L * 2 + 0) * 4 + h], l2b = WSP(float, WS_L2G)[(L * 2 + 1) * 4 + h];
    LAS bf16_t* VTs = (LAS bf16_t*)C.lds + half * 3 * 64 * 136; LAS bf16_t* KTf = VTs + 64 * 136; LAS bf16_t* KTb = KTf + 64 * 136;
    const int row0 = cg * 128, lane = C.lane, l15 = lane & 15, quad = lane >> 4;
    u32x4 kq[4], vq[4];
#pragma unroll
    for (int it = 0; it < 4; ++it) { const int idx = t256 + 256 * it, j = idx >> 3, ch = idx & 7;
        kq[it] = *(const u32x4*)(P + (size_t)(row0 + j) * PW + C_RK + 64 * h + 8 * ch); vq[it] = *(const u32x4*)(P + (size_t)(row0 + j) * PW + C_RV + 64 * h + 8 * ch); }
#pragma unroll
    for (int it = 0; it < 4; ++it) { const int idx = t256 + 256 * it, j = idx >> 3, ch = idx & 7;
        const float wf = ex2((float)(127 - j) * l2f), wb = ex2((float)j * l2b);
        const unsigned kw[4] = {kq[it].x, kq[it].y, kq[it].z, kq[it].w}, vw[4] = {vq[it].x, vq[it].y, vq[it].z, vq[it].w};
#pragma unroll
        for (int e = 0; e < 4; ++e) { const float k0 = __uint_as_float(kw[e] << 16), k1 = __uint_as_float(kw[e] & 0xffff0000u);
            KTf[(8 * ch + 2 * e) * 136 + j] = (bf16_t)f2bf(k0 * wf); KTf[(8 * ch + 2 * e + 1) * 136 + j] = (bf16_t)f2bf(k1 * wf);
            KTb[(8 * ch + 2 * e) * 136 + j] = (bf16_t)f2bf(k0 * wb); KTb[(8 * ch + 2 * e + 1) * 136 + j] = (bf16_t)f2bf(k1 * wb);
            VTs[(8 * ch + 2 * e) * 136 + j] = (bf16_t)(vw[e] & 0xffffu); VTs[(8 * ch + 2 * e + 1) * 136 + j] = (bf16_t)(vw[e] >> 16); } }
    __syncthreads();
    const int b = cg / NCHUNK, c = cg - b * NCHUNK;
#pragma unroll
    for (int dir = 0; dir < 2; ++dir) { const int vt = w4; const LAS bf16_t* KT = dir ? KTb : KTf;
        f32x4 acc[4];
#pragma unroll
        for (int dt = 0; dt < 4; ++dt) acc[dt] = (f32x4){0.f, 0.f, 0.f, 0.f};
#pragma unroll
        for (int ks = 0; ks < 4; ++ks) { const bf16x8 bv = *(const LAS bf16x8*)(VTs + (16 * vt + l15) * 136 + 32 * ks + 8 * quad);
#pragma unroll
            for (int dt = 0; dt < 4; ++dt) { const bf16x8 ak = *(const LAS bf16x8*)(KT + (16 * dt + l15) * 136 + 32 * ks + 8 * quad); acc[dt] = MFMA16(ak, bv, acc[dt]); } }
        float* dst = KVT + ((size_t)((dir * 2 + b) * 4 + h) * NCHUNK + c) * 4096 + (16 * vt + l15) * 64 + 4 * quad;
#pragma unroll
        for (int dt = 0; dt < 4; ++dt) *(f32x4*)(dst + 16 * dt) = acc[dt]; }
    __syncthreads();
}
DI void phase_ret_scan(const Params& a, const Ctx& C, int L) {
    const float* KVT = WSP(float, WS_KVT); bf16_t* SIN = WSP(bf16_t, WS_SIN);
    const int gt = C.bid * NTHREADS + C.tid;
    if (gt < 2 * 2 * 4 * 4096) {
        const int e = gt & 4095, bh = (gt >> 12) & 7, dir = gt >> 15, h = bh & 3;
        const float cd = ex2(128.f * WSP(float, WS_L2G)[(L * 2 + dir) * 4 + h]);
        const size_t base = (size_t)((dir * 2 + (bh >> 2)) * 4 + h) * NCHUNK * 4096 + e;
        float kv[NCHUNK];
#pragma unroll
        for (int c = 0; c < NCHUNK; ++c) kv[c] = KVT[base + (size_t)c * 4096];
        float st = 0.f;
        if (dir == 0) {
#pragma unroll
            for (int c = 0; c < NCHUNK; ++c) { SIN[base + (size_t)c * 4096] = (bf16_t)f2bf(st); st = cd * st + kv[c]; }
        } else {
            SIN[base + (size_t)1 * 4096] = (bf16_t)f2bf(st); st = cd * st + kv[1];
            SIN[base + (size_t)0 * 4096] = (bf16_t)f2bf(st); st = cd * st + kv[0];
#pragma unroll
            for (int c = NCHUNK - 1; c >= 2; --c) { SIN[base + (size_t)c * 4096] = (bf16_t)f2bf(st); st = cd * st + kv[c]; }
        }
    }
}
struct RetIn { u32x2 rg[4]; u32x4 q[2], k[2], v[2], sf, sb; };
DI void ret_out_load(const Params& a, const Ctx& C, int cg, int h, RetIn& R) {
    const bf16_t* P = WSP(bf16_t, WS_P); const bf16_t* SIN = WSP(bf16_t, WS_SIN);
    const int row0 = cg * 128, l15 = C.lane & 15, quad = C.lane >> 4; const int b = cg / NCHUNK, c = cg - b * NCHUNK;
#pragma unroll
    for (int vt = 0; vt < 4; ++vt) R.rg[vt] = *(const u32x2*)(P + (size_t)(row0 + 16 * C.wave + l15) * PW + C_RG + 64 * h + 16 * vt + 4 * quad);
#pragma unroll
    for (int it = 0; it < 2; ++it) { const int idx = C.tid + 512 * it, j = idx >> 3, ch = idx & 7; const bf16_t* pr = P + (size_t)(row0 + j) * PW + 64 * h + 8 * ch;
        R.q[it] = *(const u32x4*)(pr + C_RQ); R.k[it] = *(const u32x4*)(pr + C_RK); R.v[it] = *(const u32x4*)(pr + C_RV); }
    { const int v = C.tid >> 3, ch = C.tid & 7;
      R.sf = *(const u32x4*)(SIN + ((size_t)((0 * 2 + b) * 4 + h) * NCHUNK + c) * 4096 + v * 64 + 8 * ch);
      R.sb = *(const u32x4*)(SIN + ((size_t)((1 * 2 + b) * 4 + h) * NCHUNK + c) * 4096 + v * 64 + 8 * ch); }
}
DI void ret_out_compute(const Params& a, const Ctx& C, int L, int cg, int h, const RetIn& R) {
    bf16_t* BR = WSP(bf16_t, WS_BR);
    const float l2f = WSP(float, WS_L2G)[(L * 2 + 0) * 4 + h], l2b = WSP(float, WS_L2G)[(L * 2 + 1) * 4 + h];
    const float* gn = a.in[C.z + 18] + (size_t)(L * 4 + h) * 64;
    LAS bf16_t* Qs = (LAS bf16_t*)C.lds;
    LAS bf16_t* Ks = Qs + 128 * 72;
    LAS bf16_t* VTs = Ks + 128 * 72;
    LAS bf16_t* Wd = VTs + 64 * 136;
    LAS bf16_t* SfT = Wd + 128 * 136;
    LAS bf16_t* SbT = SfT + 64 * 72;
    const int row0 = cg * 128, lane = C.lane, l15 = lane & 15, quad = lane >> 4;
    f32x4 g4q[4];
#pragma unroll
    for (int vt = 0; vt < 4; ++vt) g4q[vt] = *(const f32x4*)(gn + 16 * vt + 4 * quad);
#pragma unroll
    for (int it = 0; it < 2; ++it) { const int idx = C.tid + 512 * it, j = idx >> 3, ch = idx & 7;
        *(LAS u32x4*)(Qs + j * 72 + 8 * ch) = R.q[it]; *(LAS u32x4*)(Ks + j * 72 + 8 * ch) = R.k[it];
        const u32x4 vv = R.v[it]; const unsigned vw[4] = {vv.x, vv.y, vv.z, vv.w};
#pragma unroll
        for (int e = 0; e < 4; ++e) { VTs[(8 * ch + 2 * e) * 136 + j] = (bf16_t)(vw[e] & 0xffffu); VTs[(8 * ch + 2 * e + 1) * 136 + j] = (bf16_t)(vw[e] >> 16); } }
    { const int v = C.tid >> 3, ch = C.tid & 7;
      *(LAS u32x4*)(SfT + v * 72 + 8 * ch) = R.sf; *(LAS u32x4*)(SbT + v * 72 + 8 * ch) = R.sb; }
    LDS_BARRIER();
    const int i0 = 16 * C.wave, iw = i0 + l15;
    { bf16x8 bq[2];
#pragma unroll
      for (int ks = 0; ks < 2; ++ks) bq[ks] = *(const LAS bf16x8*)(Qs + iw * 72 + 32 * ks + 8 * quad);
#pragma unroll
      for (int jt = 0; jt < 8; ++jt) { f32x4 acc = {0.f, 0.f, 0.f, 0.f};
#pragma unroll
          for (int ks = 0; ks < 2; ++ks) { const bf16x8 ak = *(const LAS bf16x8*)(Ks + (16 * jt + l15) * 72 + 32 * ks + 8 * quad); acc = MFMA16(ak, bq[ks], acc); }
          float wv[4];
#pragma unroll
          for (int r = 0; r < 4; ++r) { const int j = 16 * jt + 4 * quad + r, dl = iw - j;
              const float f = dl >= 0 ? ex2((float)dl * l2f) : ex2((float)(-dl - 1) * l2b); wv[r] = acc[r] * f; }
          u32x2 w; w.x = pk2(wv[0], wv[1]); w.y = pk2(wv[2], wv[3]); *(LAS u32x2*)(Wd + iw * 136 + 16 * jt + 4 * quad) = w; } }
    LDS_BARRIER();
    f32x4 oi[4], tf[4], tb[4];
#pragma unroll
    for (int vt = 0; vt < 4; ++vt) { oi[vt] = (f32x4){0.f, 0.f, 0.f, 0.f}; tf[vt] = oi[vt]; tb[vt] = oi[vt]; }
#pragma unroll
    for (int ks = 0; ks < 4; ++ks) { const bf16x8 bw = *(const LAS bf16x8*)(Wd + iw * 136 + 32 * ks + 8 * quad);
#pragma unroll
        for (int vt = 0; vt < 4; ++vt) { const bf16x8 av = *(const LAS bf16x8*)(VTs + (16 * vt + l15) * 136 + 32 * ks + 8 * quad); oi[vt] = MFMA16(av, bw, oi[vt]); } }
#pragma unroll
    for (int ks = 0; ks < 2; ++ks) { const bf16x8 bq = *(const LAS bf16x8*)(Qs + iw * 72 + 32 * ks + 8 * quad);
#pragma unroll
        for (int vt = 0; vt < 4; ++vt) { const bf16x8 a1 = *(const LAS bf16x8*)(SfT + (16 * vt + l15) * 72 + 32 * ks + 8 * quad), a2 = *(const LAS bf16x8*)(SbT + (16 * vt + l15) * 72 + 32 * ks + 8 * quad);
            tf[vt] = MFMA16(a1, bq, tf[vt]); tb[vt] = MFMA16(a2, bq, tb[vt]); } }
    { const float qf = ex2((float)(iw + 1) * l2f), qb = ex2((float)(127 - iw) * l2b);
      f32x4 o[4]; float sm = 0.f;
#pragma unroll
      for (int vt = 0; vt < 4; ++vt) { o[vt] = oi[vt] + tf[vt] * qf + tb[vt] * qb; sm += (o[vt][0] + o[vt][1]) + (o[vt][2] + o[vt][3]); }
      sm += shx(sm, 16, lane); sm += shx(sm, 32, lane);
      const float mean = sm * (1.f / 64.f); float q2 = 0.f;
#pragma unroll
      for (int vt = 0; vt < 4; ++vt) { o[vt] = o[vt] - mean; q2 += (o[vt][0] * o[vt][0] + o[vt][1] * o[vt][1]) + (o[vt][2] * o[vt][2] + o[vt][3] * o[vt][3]); }
      q2 += shx(q2, 16, lane); q2 += shx(q2, 32, lane);
      const float rs = __builtin_amdgcn_rsqf(q2 * (1.f / 64.f) + EPS);
#pragma unroll
      for (int vt = 0; vt < 4; ++vt) { const int v0 = 16 * vt + 4 * quad; const f32x4 g4 = g4q[vt]; const u32x2 gq = R.rg[vt];
          const float y0 = o[vt][0] * rs * g4[0] * siluf_(__uint_as_float(gq.x << 16)), y1 = o[vt][1] * rs * g4[1] * siluf_(__uint_as_float(gq.x & 0xffff0000u));
          const float y2 = o[vt][2] * rs * g4[2] * siluf_(__uint_as_float(gq.y << 16)), y3 = o[vt][3] * rs * g4[3] * siluf_(__uint_as_float(gq.y & 0xffff0000u));
          u32x2 w; w.x = pk2(y0, y1); w.y = pk2(y2, y3); *(u32x2*)(BR + (size_t)(row0 + iw) * DM + 768 + 64 * h + v0) = w; } }
    LDS_BARRIER();
}

DI void phase_attnC(const Params& a, const Ctx& C, unsigned char* lds_generic) {
    for (int r = C.bid; r < 256; r += C.G) { const int b = r >> 7, h = (r >> 5) & 3, qb = r & 31;
        attn_body::attn_unit<8>((long)b * TPB + CTXL + qb * 256, (long)b * TPB, C_GQ + 64 * h, C_GK + 64 * (h >> 1), C_GV + 64 * (h >> 1), 512 + 64 * h, (const attn_body::bf16*)WSP(bf16_t, WS_P), (attn_body::bf16*)WSP(bf16_t, WS_BR), (char*)lds_generic, C.tid, __int_as_float(C.z)); }
}
DI void phase_mix(const Params& a, const Ctx& C, int L) {
    constexpr int N_BL = 256, N_BC = 8, N_CC = 8, N_A = 264, N_KV = 264;
    constexpr int NU = N_BL + N_BC + N_CC + N_A + N_KV;
    for (int base = 0; base < NU; base += C.G) {
        int idx = C.bid; if (base + C.G > NU) { idx -= C.G - (NU - base); if (idx < 0) break; }
        const int u = base + idx; int r = u;
        if (r < N_BL) { const int b = r >> 7, kvh = (r >> 6) & 1, n = r & 63; const int ls = (n > 0 ? n - 1 : 0) * 128, le = (n < 63 ? n + 2 : 64) * 128;
            attn_unit(a, C, L, 0, b, kvh, b * TPB + CTXL + n * 128, 4, b * TPB, (le - ls) / 64, b * TPB + CTXL + ls, true, true); continue; } r -= N_BL;
        if (r < N_BC) { const int b = r >> 2, kvh = (r >> 1) & 1, cb = r & 1; attn_unit(a, C, L, 0, b, kvh, b * TPB + cb * 128, 4, b * TPB, 0, 0, false, true); continue; } r -= N_BC;
        if (r < N_CC) { const int b = r >> 2, kvh = (r >> 1) & 1, cb = r & 1; attn_unit(a, C, L, 1, b, kvh, b * TPB + cb * 128, 4, b * TPB, 0, 0, false, false); continue; } r -= N_CC;
        if (r < N_A) { mixA_pair(a, C, L, r); continue; } r -= N_A;
        ret_kv_pair(a, C, L, r);
    }
}
DI void phase_ret_out(const Params& a, const Ctx& C, int L) {
    const int NU = (L == DEPTH - 1) ? 512 : 528;
    auto chunk_of = [&](int u) { const int lc = u >> 2; return (L == DEPTH - 1) ? (lc >> 6) * NCHUNK + 2 + (lc & 63) : lc; };
    RetIn RA, RB; int u = C.bid;
    if (u < NU) ret_out_load(a, C, chunk_of(u), u & 3, RA);
    while (u < NU) {
        const int u1 = u + C.G; if (u1 < NU) ret_out_load(a, C, chunk_of(u1), u1 & 3, RB);
        ret_out_compute(a, C, L, chunk_of(u), u & 3, RA);
        if (u1 >= NU) break;
        const int u2 = u1 + C.G; if (u2 < NU) ret_out_load(a, C, chunk_of(u2), u2 & 3, RA);
        ret_out_compute(a, C, L, chunk_of(u1), u1 & 3, RB);
        u = u2;
    }
}

DI void phase_sum4(const Params& a, const Ctx& C) {
    const bf16_t* P = WSP(bf16_t, WS_P); bf16_t* A = WSP(bf16_t, WS_H);
    const int gt = C.bid * NTHREADS + C.tid, GT = C.G * NTHREADS;
    for (int i = gt; i < T * 128; i += GT) { const int r = i >> 7, c = (i & 127) * 8; const bf16_t* pr = P + (size_t)r * PW + C_GATE + c;
        float s[8];
#pragma unroll
        for (int e = 0; e < 8; ++e) s[e] = 0.f;
#pragma unroll
        for (int br = 0; br < 4; ++br) { const u32x4 v = *(const u32x4*)(pr + br * 1024); const unsigned w[4] = {v.x, v.y, v.z, v.w};
#pragma unroll
            for (int e = 0; e < 4; ++e) { s[2 * e] += __uint_as_float(w[e] << 16); s[2 * e + 1] += __uint_as_float(w[e] & 0xffff0000u); } }
        *(u32x4*)(A + (size_t)r * DM + c) = (u32x4){pk2(s[0], s[1]), pk2(s[2], s[3]), pk2(s[4], s[5]), pk2(s[6], s[7])}; }
}

DI void phase_gather(const Params& a, const Ctx& C, int L) {
    int* rt_i = WSP(int, WS_ROUTE); float* rt_f = WSP(float, WS_ROUTE);
    const bf16_t* H = WSP(bf16_t, WS_H); bf16_t* HG = WSP(bf16_t, WS_HG);
    LAS int* lt = (LAS int*)C.lds;
    { const int e = C.wave; const int* blk = rt_i + RT_BLK + (L >> 1) * 1024 * 8; int tot = 0, pre = 0;
      for (int b = C.lane; b < C.G; b += 64) { const int v = blk[b * 8 + e]; tot += v; pre += (b < C.bid) ? v : 0; }
#pragma unroll
      for (int o = 1; o < 64; o <<= 1) { tot += __builtin_amdgcn_ds_bpermute((C.lane ^ o) << 2, tot); pre += __builtin_amdgcn_ds_bpermute((C.lane ^ o) << 2, pre); }
      if (C.lane == 0) { lt[e] = tot; lt[8 + e] = pre; } }
    __syncthreads();
    int base[NEXP + 1]; int cn[NEXP]; int mybase[NEXP];
    { int acc = 0;
#pragma unroll
      for (int e = 0; e < NEXP; ++e) { cn[e] = lt[e]; base[e] = acc; mybase[e] = acc + lt[8 + e]; acc += ((cn[e] + 255) >> 8) << 8; } base[NEXP] = acc; }
    if (C.bid == 0) {
        if (C.tid == 0) { rt_i[RT_META] = base[NEXP] >> 8; }
        for (int rt = C.tid; rt < (base[NEXP] >> 8); rt += NTHREADS) { int e = 0;
#pragma unroll
            for (int k = 1; k < NEXP; ++k) if (rt * 256 >= base[k]) e = k;
            rt_i[RT_META + 16 + rt] = e; }
#pragma unroll
        for (int e = 0; e < NEXP; ++e) for (int r = base[e] + cn[e] + C.tid; r < base[e + 1]; r += NTHREADS) rt_i[RT_ROWTOK + r] = -1;
    }
    const int gw = C.bid * NWAVES + C.wave, NGW = C.G * NWAVES; const bool skipc = L == DEPTH - 1;
    { const int t = gw + C.lane * NGW;
      if (t < T && !(skipc && modrow(t) == 2)) {
          const int e0 = rt_i[RT_E + 2 * t], e1 = rt_i[RT_E + 2 * t + 1], p0 = rt_i[RT_POS + 2 * t], p1 = rt_i[RT_POS + 2 * t + 1]; const float w0 = rt_f[RT_PW + 2 * t], w1 = rt_f[RT_PW + 2 * t + 1];
#pragma unroll
          for (int k = 0; k < 2; ++k) { const int e = k ? e1 : e0, pos = k ? p1 : p0;
              int bs = 0;
#pragma unroll
              for (int q = 0; q < NEXP; ++q) if (q == e) bs = mybase[q];
              const int row = bs + pos;
              rt_i[RT_ROWTOK + row] = t; rt_f[RT_ROWP + row] = k ? w1 : w0; rt_i[RT_POS + 2 * t + k] = row; } } }
}

DI void phase_combine(const Params& a, const Ctx& C, int L) {
    const int* rt_i = WSP(int, WS_ROUTE); const bf16_t* Y = WSP(bf16_t, WS_HG); const bf16_t* XS = WSP(bf16_t, WS_XS);
    const float* mod = WSP(float, WS_MOD) + (size_t)L * 3 * 6144 + 5 * DM;
    const int lane = C.lane, gw = C.bid * NWAVES + C.wave, NGW = C.G * NWAVES;
    f32x4 gc[4]; int mrc = -1;
    int nrow0 = 0, nrow1 = 0; u32x4 nx[2];
    auto fetch = [&](int t) { nrow0 = rt_i[RT_POS + 2 * t]; nrow1 = rt_i[RT_POS + 2 * t + 1];
#pragma unroll
        for (int hf = 0; hf < 2; ++hf) nx[hf] = *(const u32x4*)(XS + (size_t)t * DM + hf * 512 + 8 * lane); };
    auto next_tok = [&](int t) { t += NGW; while (t < T && modrow(t) == 2) t += NGW; return t; };
    int t = gw; while (t < T && modrow(t) == 2) t += NGW;
    if (t < T) fetch(t);
    while (t < T) {
        const int row0 = nrow0, row1 = nrow1; const u32x4 xq0 = nx[0], xq1 = nx[1];
        const int tn = next_tok(t); if (tn < T) fetch(tn);
        const int bb = t / TPB, pp = t - bb * TPB; float* orow = C.out + (size_t)(bb * SEQ + pp - CTXL) * DM;
        if (bb != mrc) { mrc = bb; const float* gt = mod + (size_t)bb * 6144;
#pragma unroll
            for (int hf = 0; hf < 2; ++hf) { gc[2 * hf] = *(const f32x4*)(gt + hf * 512 + 8 * lane); gc[2 * hf + 1] = *(const f32x4*)(gt + hf * 512 + 8 * lane + 4); } }
        f32x4 ya[2], yb[2];
#pragma unroll
        for (int hf = 0; hf < 2; ++hf) y2_pair8(Y, WSP(bf16_t, WS_Y2P), row0, row1, hf * 512 + 8 * lane, ya[hf], yb[hf]);
#pragma unroll
        for (int hf = 0; hf < 2; ++hf) { const int c = hf * 512 + 8 * lane; f32x4 x0, x1; unpack8(hf ? xq1 : xq0, x0, x1);
            *(f32x4*)(orow + c) = x0 + gc[2 * hf] * ya[hf]; *(f32x4*)(orow + c + 4) = x1 + gc[2 * hf + 1] * yb[hf]; }
        t = tn;
    }
}

constexpr int PH_PER_LAYER = 15;
#define PHASE_CTX() Ctx C; { int z_ = 0; asm volatile("s_mov_b32 %0, 0" : "=s"(z_)); C.z = z_; C.lds = (LAS unsigned char*)lds_raw; { int t_; LANE_ID_ASM(t_); t_ += wave_s * 64; C.tid = t_; } C.lane = C.tid & 63; \
    C.wave = __builtin_amdgcn_readfirstlane(C.tid >> 6); C.G = (int)gridDim.x + z_; C.bid = (int)blockIdx.x + z_; C.out = a.out + z_; C.ws = a.ws + z_; }
template <int PHMASK, bool FUSED>
__global__ void __launch_bounds__(NTHREADS, 2) mixer_fwd(Params a) {
    extern __shared__ __attribute__((aligned(16))) unsigned char lds_raw[];
    volatile LAS unsigned* MISC = (volatile LAS unsigned*)((LAS unsigned char*)lds_raw + MISC_OFF);
    if (threadIdx.x < 32) MISC[threadIdx.x] = 0u;
    const int wave_s = __builtin_amdgcn_readfirstlane((int)(threadIdx.x >> 6));
    __syncthreads();
    XcdBarrier bar; bar.bar = (unsigned*)(a.ws + WS_CTL) + CW_BAR; bar.x = 0; bar.st = nullptr;
    if (FUSED) bar = xcd_barrier_post((unsigned*)(a.ws + WS_CTL) + CW_BAR, MISC + 8);
#define SEAM() do { if (FUSED) { unsigned l_; LANE_ID_ASM(l_); xcd_barrier_fn(bar.bar, bar.x, (unsigned)(unsigned long long)bar.st, (unsigned)(wave_s * 64) + l_); } } while (0)
#ifndef PHASE_MASK
#define PHASE_MASK 0xffff
#endif
#define RUN(k) ((((PHASE_MASK) & (PHMASK)) >> (k)) & 1)
#ifndef PROBE_MASK
#define PROBE_MASK 0
#endif
#ifndef PROBE_MULT
#define PROBE_MULT 4
#endif
    unsigned long long pr_acc = 0, pr_t0 = 0;
#define PB(k) do { if ((PROBE_MASK >> (k)) & 1) pr_t0 = __builtin_amdgcn_s_memrealtime(); } while (0)
#define PE(k) do { if ((PROBE_MASK >> (k)) & 1) pr_acc += __builtin_amdgcn_s_memrealtime() - pr_t0; } while (0)

    if (a.l_lo == 0 && RUN(0)) { PB(0); PHASE_CTX(); phase_g0(a, C); __syncthreads(); phase_cvt(a, C, 0, 0, 25, 0); __syncthreads(); SEAM(); PE(0); }
    for (int L = a.l_lo; L < a.l_hi; ++L) {
        const bool moe = L & 1;
        if (RUN(1)) { PB(1); PHASE_CTX();  phase_norm(a, C, L, 0); __syncthreads(); SEAM(); PE(1); }
        if (RUN(2)) { PB(2); PHASE_CTX(); pg8::Gemm g{WSP(bf16_t, WS_H), WSP(bf16_t, WS_W + (size_t)(L & 1) * W_BUF + W_IN), DM, DM, DM}; pg8::InOrder S{C.G, C.bid}; pg8::EpiIn E{WSP(bf16_t, WS_P), WSP(bf16_t, WS_GT), WSP(float, WS_TAB), a.in[C.z + 9] + (size_t)L * 256, a.in[C.z + 12] + L * 64, a.in[C.z + 13] + L * 64, a.in[C.z + 15] + L * 64, a.in[C.z + 16] + L * 64};
            pg8::gemm_phase(C.lds, C.tid, g, S, E); if (L == 0) phase_cvt(a, C, 0, 25, 64, 180); else if (L + 1 < DEPTH) phase_modgemv(a, C, L + 1, 180); __syncthreads(); SEAM(); PE(2); }
        if (RUN(4)) { PB(4); { PB(15); PHASE_CTX(); phase_attnC(a, C, lds_raw); __syncthreads(); PE(15); } { PB(16); PHASE_CTX(); phase_mix(a, C, L); __syncthreads(); PE(16); } SEAM(); PE(4); }
        if (RUN(5)) { PB(5); PHASE_CTX(); phase_ret_scan(a, C, L); SEAM(); PE(5); }
        if (RUN(6)) { PB(6); PHASE_CTX(); phase_ret_out(a, C, L); if (L + 1 < DEPTH) phase_cvt(a, C, L + 1, 0, (L & 1) ? 20 : 14, 16); __syncthreads(); SEAM(); PE(6); }
        if (RUN(7)) { PB(7); PHASE_CTX(); pg8::Gemm g{WSP(bf16_t, WS_BR), WSP(bf16_t, WS_W + (size_t)(L & 1) * W_BUF + W_BR), DM, DM, DM};
            pg8::gemm_merge_phase(C.lds, C.tid, g, C.G, C.bid, WSP(bf16_t, WS_GT), WSP(bf16_t, WS_H), L == DEPTH - 1); if (L + 1 < DEPTH) phase_cvt(a, C, L + 1, (L & 1) ? 20 : 14, (L & 1) ? 64 : 40, 16); __syncthreads(); SEAM(); PE(7); }
        if (RUN(9)) { PB(9); PHASE_CTX(); pg8::Gemm g{WSP(bf16_t, WS_H), WSP(bf16_t, WS_W + (size_t)(L & 1) * W_BUF + W_OUT), DM, DM, DM}; pg8::CtxSplitOrder S{C.G, C.bid, 4, L == DEPTH - 1};
            pg8::EpiResid E{WSP(bf16_t, WS_XS), WSP(float, WS_MOD) + (size_t)L * 3 * 6144 + 2 * DM, WSP(bf16_t, WS_BR)};
            pg8::gemm_phase(C.lds, C.tid, g, S, E); if (!(L & 1)) phase_cvt(a, C, L + 1, 40, 52, 32); else phase_cvt(a, C, L, 52, 64, 32);   __syncthreads(); SEAM(); PE(9); }
        if (RUN(10)) { PB(10); PHASE_CTX(); phase_norm(a, C, L, 1); SEAM(); PE(10); }
        if (!moe) {
            if (RUN(11)) { PB(11); PHASE_CTX(); pg8::Gemm g{WSP(bf16_t, WS_H), WSP(bf16_t, WS_W + (size_t)(L & 1) * W_BUF + W_13), DM, DM, DM}; pg8::RowOrder S{2 * DFF / 256, C.G, C.bid}; pg8::EpiSwiglu E{WSP(bf16_t, WS_P), DFF, 1 << 20};
                pg8::gemm_phase(C.lds, C.tid, g, S, E); if (L == 0) phase_modgemv(a, C, 1, 172); __syncthreads(); SEAM(); PE(11); }
            if (RUN(12)) { PB(12); PHASE_CTX(); pg8::Gemm g{WSP(bf16_t, WS_P), WSP(bf16_t, WS_W + (size_t)(L & 1) * W_BUF + W_2), DFF, DFF, DFF}; pg8::CtxSplitOrder S{C.G, C.bid, 11, false};
                pg8::EpiResid E{WSP(bf16_t, WS_XS), WSP(float, WS_MOD) + (size_t)L * 3 * 6144 + 5 * DM, WSP(bf16_t, WS_BR)};
                pg8::gemm_phase(C.lds, C.tid, g, S, E); SEAM(); PE(12); }
        } else {
            if (RUN(11)) { PB(11); PHASE_CTX(); phase_gather(a, C, L); SEAM(); PE(11); }
            if (RUN(12)) { PB(12); PHASE_CTX(); pg8::Gemm g{WSP(bf16_t, WS_H), WSP(bf16_t, WS_W + (size_t)(L & 1) * W_BUF + W_13), DM, DM, DM}; pg8::MoeOrder S{WSP(int, WS_ROUTE) + RT_META, 14, C.G, C.bid, WSP(int, WS_ROUTE) + RT_ROWTOK}; pg8::EpiSwiglu E{WSP(bf16_t, WS_HIDM), DFE, 14};
                pg8::gemm_phase(C.lds, C.tid, g, S, E); SEAM(); PE(12); }
            if (RUN(13)) { PB(13); PHASE_CTX(); pg8::Gemm g{WSP(bf16_t, WS_HIDM), WSP(bf16_t, WS_W + (size_t)(L & 1) * W_BUF + W_2), DFE, DFE, DFE}; pg8::Moe2Order S{WSP(int, WS_ROUTE) + RT_META, C.G, C.bid};
                pg8::EpiMoe2 E{WSP(bf16_t, WS_HG), WSP(float, WS_ROUTE) + RT_ROWP, 4, WSP(bf16_t, WS_Y2P)};
                pg8::gemm_phase(C.lds, C.tid, g, S, E); SEAM(); PE(13); }
            if (RUN(14) && L == DEPTH - 1) { PB(14); PHASE_CTX(); phase_combine(a, C, L); SEAM(); PE(14); }
        }
    }
    if (PROBE_MASK) { const unsigned long long t1 = __builtin_amdgcn_s_memrealtime(); while (__builtin_amdgcn_s_memrealtime() - t1 < (unsigned long long)PROBE_MULT * pr_acc) __builtin_amdgcn_s_sleep(8); }
#undef SEAM
#undef RUN
}

#if !MK_FUSED
typedef void (*kern_t)(Params);
template <int PH> static kern_t phase_kernel() { return mixer_fwd<(1 << PH), false>; }
static kern_t get_kernel(int ph) {
    switch (ph) {
        case 0: return phase_kernel<0>(); case 1: return phase_kernel<1>(); case 2: return phase_kernel<2>(); case 3: return phase_kernel<3>(); case 4: return phase_kernel<4>();
        case 5: return phase_kernel<5>(); case 6: return phase_kernel<6>(); case 7: return phase_kernel<7>(); case 8: return phase_kernel<8>(); case 9: return phase_kernel<9>();
        case 10: return phase_kernel<10>(); case 11: return phase_kernel<11>(); case 12: return phase_kernel<12>(); case 13: return phase_kernel<13>(); default: return phase_kernel<14>();
    }
}
#endif
extern "C" void kernel_launch(void* const* d_in, const int* in_sizes, int n_in, void* d_out, int out_size, void* d_ws, size_t ws_size, hipStream_t stream) {
    static int grid = 0;
    if (grid == 0) {
        if (n_in != 29 || out_size != NBATCH * SEQ * DM || ws_size < WS_END) { fprintf(stderr, "kernel_launch: unexpected shapes (n_in %d, out %d, ws %zu < %zu)\n", n_in, out_size, ws_size, (size_t)WS_END); grid = -1; return; }
        int dev = 0, cus = 0;
        if (hipGetDevice(&dev) != hipSuccess || hipDeviceGetAttribute(&cus, hipDeviceAttributeMultiprocessorCount, dev) != hipSuccess) { grid = -1; return; }
#if MK_FUSED
        if (hipFuncSetAttribute((const void*)mixer_fwd<0x7fff, true>, hipFuncAttributeMaxDynamicSharedMemorySize, LDS_BYTES) != hipSuccess) { grid = -1; return; }
#else
        for (int ph = 0; ph < PH_PER_LAYER; ++ph) if (hipFuncSetAttribute((const void*)get_kernel(ph), hipFuncAttributeMaxDynamicSharedMemorySize, LDS_BYTES) != hipSuccess) { grid = -1; return; }
#endif
        (void)hipGetLastError();
        grid = cus;
    }
    if (grid < 0) return;
    (void)hipMemsetAsync((char*)d_ws + WS_CTL, 0, CTL_ZERO_BYTES, stream);
    Params p{};
    for (int i = 0; i < 29; ++i) p.in[i] = (const float*)d_in[i];
    p.out = (float*)d_out; p.ws = (unsigned char*)d_ws; p.pad = 0; p.ph_lo = 0; p.ph_hi = 0;
#if MK_FUSED
    p.l_lo = 0; p.l_hi = DEPTH; p.fused = 1;
    hipLaunchKernelGGL((mixer_fwd<0x7fff, true>), dim3(grid), dim3(NTHREADS), LDS_BYTES, stream, p);
#else
    p.fused = 0; p.l_lo = 0; p.l_hi = 1;
    hipLaunchKernelGGL(get_kernel(0), dim3(grid), dim3(NTHREADS), LDS_BYTES, stream, p);
#ifndef NL_RUN
#define NL_RUN DEPTH
#endif
    for (int L = 0; L < NL_RUN; ++L)
        for (int ph = 1; ph < PH_PER_LAYER; ++ph) {
            if (!(L & 1) && ph >= 13) continue;
            p.l_lo = L; p.l_hi = L + 1;
            hipLaunchKernelGGL(get_kernel(ph), dim3(grid), dim3(NTHREADS), LDS_BYTES, stream, p);
        }
#endif
}
```
